# Optimizing an MI355X kernel written in HIP

```python
import math
import jax, jax.numpy as jnp
from jax import lax
import numpy as np

D_MODEL = 1024
BATCH = 2
SEQ = 8192
DEPTH = 1
DEC_BATCH = 32
DEC_SEQ = 4
PAST_LEN = 16384
PAGE_SIZE = 128

RWKV_HEAD_DIM = 64
RWKV_HEADS = D_MODEL // RWKV_HEAD_DIM
RWKV_WIDTH = RWKV_HEADS * RWKV_HEAD_DIM
DECAY_LORA = 64
AAA_LORA = 64
GATE_LORA = 128
LNX_EPS = 64e-5
RWKV_COLS = 3 * RWKV_WIDTH + DECAY_LORA + AAA_LORA + GATE_LORA

ATTN_HEAD_DIM = 64
HEADS_PER_GROUP = 4
WINDOWS = (128, 512, 2048)
DILATIONS = (1, 4, 16)
N_GROUPS = len(WINDOWS)
ATTN_WIDTH = N_GROUPS * HEADS_PER_GROUP * ATTN_HEAD_DIM
ATTN_OUT_WIDTH = HEADS_PER_GROUP * ATTN_HEAD_DIM
ATTN_SCALE = ATTN_HEAD_DIM ** -0.5
BLOCK = 128
NEG = -1e30

D_FF = 4 * D_MODEL
PLE_DIM = 256
NORM_EPS = 1e-6
IN_COLS = RWKV_COLS + 3 * ATTN_WIDTH + 2 * D_MODEL

kernel_name = "rwkv7_dilated_swa_hybrid_step"


def rmsnorm(x, g):
    xf = x.astype(jnp.float32)
    xf = xf * lax.rsqrt(jnp.mean(xf * xf, axis=-1, keepdims=True) + NORM_EPS)
    return (xf * g.astype(jnp.float32)).astype(x.dtype)


def wkv_scan(r, w, k, v, a, b, s0):
    xs = tuple(jnp.moveaxis(t.astype(jnp.float32), 1, 0) for t in (r, w, k, v, a, b))

    def step(s, inp):
        r_t, w_t, k_t, v_t, a_t, b_t = inp
        sa = jnp.einsum('nhvk,nhk->nhv', s, a_t)
        s = s * w_t[:, :, None, :] + sa[..., None] * b_t[:, :, None, :] + v_t[..., None] * k_t[:, :, None, :]
        return s, jnp.einsum('nhvk,nhk->nhv', s, r_t)

    s_T, ys = lax.scan(step, s0.astype(jnp.float32), xs)
    return jnp.moveaxis(ys, 0, 1), s_T


def rwkv_branch(z, z_prev, wkv0, shift_mu, decay_w0, decay_w2, aaa_a0, aaa_a2, gate_g2,
                k_k, k_a, r_k, lnx_w, lnx_b):
    N, T, _ = z.shape
    prev = jnp.concatenate([z_prev[:, None].astype(z.dtype), z[:, :-1]], axis=1)
    zs = z + (prev - z) * shift_mu
    r, k, v, xw, xa, xg = jnp.split(
        zs, [RWKV_WIDTH, 2 * RWKV_WIDTH, 3 * RWKV_WIDTH,
             3 * RWKV_WIDTH + DECAY_LORA, 3 * RWKV_WIDTH + DECAY_LORA + AAA_LORA], axis=-1)
    logw = -jax.nn.softplus(-(decay_w0 + jnp.tanh(xw) @ decay_w2)) - 0.5
    decay = jnp.exp(-jnp.exp(logw.astype(jnp.float32)))
    a = jax.nn.sigmoid(aaa_a0 + xa @ aaa_a2)
    g = jax.nn.sigmoid(xg) @ gate_g2

    def heads(t):
        return t.reshape(N, T, RWKV_HEADS, RWKV_HEAD_DIM)

    kk = heads(k * k_k).astype(jnp.float32)
    kk = kk / jnp.maximum(jnp.sqrt(jnp.sum(kk * kk, axis=-1, keepdims=True)), 1e-12)
    k = k * (1 + (a - 1) * k_a)
    r_h, k_h, v_h, a_h, w_h = heads(r), heads(k), heads(v), heads(a), heads(decay)
    y, s_T = wkv_scan(r_h, w_h, k_h, v_h, -kk, kk * a_h.astype(jnp.float32), wkv0)
    mu = jnp.mean(y, axis=-1, keepdims=True)
    var = jnp.mean(jnp.square(y - mu), axis=-1, keepdims=True)
    y = ((y - mu) * lax.rsqrt(var + LNX_EPS)).reshape(N, T, RWKV_WIDTH)
    y = y * lnx_w.astype(jnp.float32) + lnx_b.astype(jnp.float32)
    bonus = jnp.sum((r_h * k_h * r_k).astype(jnp.float32), axis=-1, keepdims=True) * v_h.astype(jnp.float32)
    out = ((y + bonus.reshape(N, T, RWKV_WIDTH)) * g.astype(jnp.float32)).astype(z.dtype)
    return out, s_T.astype(z.dtype), z[:, -1]


def dilated_attn_prompt(q, k, v, dilation, n_back):
    N, T, H, Dh = q.shape
    span = dilation * BLOCK
    Tp = -(-T // span) * span
    S = Tp // dilation
    nb = S // BLOCK

    def to_blocks(t):
        t = jnp.pad(t, ((0, 0), (0, Tp - T), (0, 0), (0, 0)))
        t = t.reshape(N, S, dilation, H, Dh).transpose(0, 2, 1, 3, 4)
        return t.reshape(N, dilation, nb, BLOCK, H, Dh).astype(jnp.float32)

    def with_prev(t):
        prev = jnp.pad(t[:, :, :-1], ((0, 0), (0, 0), (1, 0), (0, 0), (0, 0), (0, 0)))
        return jnp.concatenate([prev, t], axis=3)

    qb = to_blocks(q)
    kb = with_prev(to_blocks(k))
    vb = with_prev(to_blocks(v))
    s = jnp.einsum('ndbqhe,ndbkhe->ndbhqk', qb, kb) * ATTN_SCALE
    qi = jnp.arange(BLOCK)[:, None]
    ki = jnp.arange(2 * BLOCK)[None, :]
    dist = qi + BLOCK - ki
    band = (dist >= 0) & (dist <= n_back)
    has_prev = (jnp.arange(nb)[:, None, None] > 0) | (ki >= BLOCK)[None]
    mask = band[None] & has_prev
    s = jnp.where(mask[None, None, :, None], s, NEG)
    m = jnp.max(s, axis=-1, keepdims=True)
    e = jnp.exp(s - m)
    den = jnp.sum(e, axis=-1, keepdims=True)
    o = jnp.einsum('ndbhqk,ndbkhe->ndbqhe', e / den, vb)
    lse = (m + jnp.log(den))[..., 0].transpose(0, 1, 2, 4, 3)

    def from_blocks(t):
        rest = t.shape[4:]
        t = t.reshape(N, dilation, S, *rest).swapaxes(1, 2)
        return t.reshape(N, Tp, *rest)[:, :T]

    return from_blocks(o), from_blocks(lse)


def dilated_attn_sample(q, k, v, kv_cache, dilation, n_back):
    N, T = q.shape[:2]
    L = kv_cache.shape[1]
    keys = jnp.concatenate([kv_cache[:, :, 0], k], axis=1)
    vals = jnp.concatenate([kv_cache[:, :, 1], v], axis=1)
    idx = L + jnp.arange(T)[:, None] - dilation * jnp.arange(n_back + 1)[None, :]
    valid = idx >= 0
    idx = jnp.maximum(idx, 0)
    kg = keys[:, idx].astype(jnp.float32)
    vg = vals[:, idx].astype(jnp.float32)
    s = jnp.einsum('nthe,ntjhe->nthj', q.astype(jnp.float32), kg) * ATTN_SCALE
    s = jnp.where(valid[None, :, None, :], s, NEG)
    m = jnp.max(s, axis=-1, keepdims=True)
    e = jnp.exp(s - m)
    den = jnp.sum(e, axis=-1, keepdims=True)
    o = jnp.einsum('nthj,ntjhe->nthe', e / den, vg)
    return o, (m + jnp.log(den))[..., 0]


def decoder_layer(x, p, wkv0, shift0, kv_caches, prm):
    (norm_mix, w_in, shift_mu, decay_w0, decay_w2, aaa_a0, aaa_a2, gate_g2, k_k, k_a, r_k,
     lnx_w, lnx_b, w_branch_rwkv, w_branch_attn, w_out, norm_mlp, w_ff1, w_ff2,
     norm_ple, w_ple, w_ple_gate) = prm
    N, T, _ = x.shape
    h = rmsnorm(x, norm_mix)
    z = h @ w_in
    z_rwkv, z_q, z_k, z_v, z_gate = jnp.split(
        z, [RWKV_COLS, RWKV_COLS + ATTN_WIDTH, RWKV_COLS + 2 * ATTN_WIDTH,
            RWKV_COLS + 3 * ATTN_WIDTH], axis=-1)

    rwkv_out, wkv_T, shift_T = rwkv_branch(z_rwkv, shift0, wkv0, shift_mu, decay_w0, decay_w2,
                                           aaa_a0, aaa_a2, gate_g2, k_k, k_a, r_k, lnx_w, lnx_b)

    gshape = (N, T, N_GROUPS, HEADS_PER_GROUP, ATTN_HEAD_DIM)
    q, k, v = z_q.reshape(gshape), z_k.reshape(gshape), z_v.reshape(gshape)
    outs, lses, new_kv = [], [], []
    for gi in range(N_GROUPS):
        d = DILATIONS[gi]
        n_back = WINDOWS[gi] // d
        qg, kg, vg = q[:, :, gi], k[:, :, gi], v[:, :, gi]
        if kv_caches is None:
            o, l = dilated_attn_prompt(qg, kg, vg, d, n_back)
            keep = min(WINDOWS[gi], T)
            new_kv.append(jnp.stack([kg[:, T - keep:], vg[:, T - keep:]], axis=2))
        else:
            o, l = dilated_attn_sample(qg, kg, vg, kv_caches[gi], d, n_back)
            new_kv.append(jnp.stack([kg, vg], axis=2))
        outs.append(o)
        lses.append(l)
    alpha = jax.nn.softmax(jnp.stack(lses, axis=2), axis=2)
    attn = jnp.einsum('ntgh,ntghe->nthe', alpha, jnp.stack(outs, axis=2))
    attn = attn.reshape(N, T, ATTN_OUT_WIDTH).astype(x.dtype)

    gates = jax.nn.sigmoid(z_gate)
    mixed = gates[..., :D_MODEL] * (rwkv_out @ w_branch_rwkv) + gates[..., D_MODEL:] * (attn @ w_branch_attn)
    x = x + mixed @ w_out

    h = rmsnorm(x, norm_mlp)
    x = x + jnp.square(jax.nn.relu(h @ w_ff1)) @ w_ff2

    h = rmsnorm(x, norm_ple)
    x = x + jax.nn.sigmoid(h @ w_ple_gate) * (p @ w_ple)
    return x, new_kv, wkv_T, shift_T


def setup_inputs(seed: int = 0) -> dict:
    key = jax.random.key(seed)
    ks = iter(jax.random.split(key, 48))
    f32 = jnp.float32

    def nrm(shape, scale=1.0):
        return jax.random.normal(next(ks), shape, f32) * scale

    def gain(shape):
        return 1.0 + 0.05 * jax.random.normal(next(ks), shape, f32)

    cl = [min(w, PAST_LEN) for w in WINDOWS]
    kvs = (HEADS_PER_GROUP, ATTN_HEAD_DIM)
    return {
        "x_prompt": nrm((BATCH, SEQ, D_MODEL)),
        "x_sample": nrm((DEC_BATCH, DEC_SEQ, D_MODEL)),
        "cache_kv_g0": nrm((DEPTH, DEC_BATCH, cl[0], 2) + kvs),
        "cache_kv_g1": nrm((DEPTH, DEC_BATCH, cl[1], 2) + kvs),
        "cache_kv_g2": nrm((DEPTH, DEC_BATCH, cl[2], 2) + kvs),
        "state_wkv": nrm((DEPTH, DEC_BATCH, RWKV_HEADS, RWKV_HEAD_DIM, RWKV_HEAD_DIM), 0.5),
        "state_shift": nrm((DEPTH, DEC_BATCH, RWKV_COLS)),
        "p_prompt": nrm((DEPTH, BATCH, SEQ, PLE_DIM)),
        "p_sample": nrm((DEPTH, DEC_BATCH, DEC_SEQ, PLE_DIM)),
        "norm_mix": gain((DEPTH, D_MODEL)),
        "w_in": nrm((DEPTH, D_MODEL, IN_COLS), D_MODEL ** -0.5),
        "shift_mu": jax.random.uniform(next(ks), (DEPTH, RWKV_COLS), f32),
        "decay_w0": jax.random.uniform(next(ks), (DEPTH, RWKV_WIDTH), f32, -6.0, -1.0),
        "decay_w2": nrm((DEPTH, DECAY_LORA, RWKV_WIDTH), 0.1),
        "aaa_a0": nrm((DEPTH, RWKV_WIDTH), 0.5),
        "aaa_a2": nrm((DEPTH, AAA_LORA, RWKV_WIDTH), 0.1),
        "gate_g2": nrm((DEPTH, GATE_LORA, RWKV_WIDTH), GATE_LORA ** -0.5),
        "k_k": 0.85 + 0.05 * jax.random.normal(next(ks), (DEPTH, RWKV_WIDTH), f32),
        "k_a": gain((DEPTH, RWKV_WIDTH)),
        "r_k": nrm((DEPTH, RWKV_HEADS, RWKV_HEAD_DIM), 0.1),
        "lnx_w": gain((DEPTH, RWKV_WIDTH)),
        "lnx_b": nrm((DEPTH, RWKV_WIDTH), 0.01),
        "w_branch_rwkv": nrm((DEPTH, RWKV_WIDTH, D_MODEL), RWKV_WIDTH ** -0.5),
        "w_branch_attn": nrm((DEPTH, ATTN_OUT_WIDTH, D_MODEL), ATTN_OUT_WIDTH ** -0.5),
        "w_out": nrm((DEPTH, D_MODEL, D_MODEL), D_MODEL ** -0.5),
        "norm_mlp": gain((DEPTH, D_MODEL)),
        "w_ff1": nrm((DEPTH, D_MODEL, D_FF), D_MODEL ** -0.5),
        "w_ff2": nrm((DEPTH, D_FF, D_MODEL), D_FF ** -0.5),
        "norm_ple": gain((DEPTH, D_MODEL)),
        "w_ple": nrm((DEPTH, PLE_DIM, D_MODEL), PLE_DIM ** -0.5),
        "w_ple_gate": nrm((DEPTH, D_MODEL, D_MODEL), D_MODEL ** -0.5),
        "norm_final": gain((D_MODEL,)),
    }


def reference(x_prompt, x_sample, cache_kv_g0, cache_kv_g1, cache_kv_g2, state_wkv, state_shift,
              p_prompt, p_sample, norm_mix, w_in, shift_mu, decay_w0, decay_w2, aaa_a0, aaa_a2,
              gate_g2, k_k, k_a, r_k, lnx_w, lnx_b, w_branch_rwkv, w_branch_attn, w_out,
              norm_mlp, w_ff1, w_ff2, norm_ple, w_ple, w_ple_gate, norm_final):
    yp, ys = x_prompt, x_sample
    nb_p = x_prompt.shape[0]
    kvp = [[], [], []]
    kvs = [[], [], []]
    wkv_p, sh_p, wkv_s, sh_s = [], [], [], []
    for i in range(DEPTH):
        prm = (norm_mix[i], w_in[i], shift_mu[i], decay_w0[i], decay_w2[i], aaa_a0[i], aaa_a2[i],
               gate_g2[i], k_k[i], k_a[i], r_k[i], lnx_w[i], lnx_b[i], w_branch_rwkv[i],
               w_branch_attn[i], w_out[i], norm_mlp[i], w_ff1[i], w_ff2[i], norm_ple[i],
               w_ple[i], w_ple_gate[i])
        wkv0 = jnp.zeros((nb_p, RWKV_HEADS, RWKV_HEAD_DIM, RWKV_HEAD_DIM), x_prompt.dtype)
        shift0 = jnp.zeros((nb_p, RWKV_COLS), x_prompt.dtype)
        yp, nkv_p, w_p, s_p = decoder_layer(yp, p_prompt[i], wkv0, shift0, None, prm)
        ys, nkv_s, w_s, s_s = decoder_layer(
            ys, p_sample[i], state_wkv[i], state_shift[i],
            (cache_kv_g0[i], cache_kv_g1[i], cache_kv_g2[i]), prm)
        for gi in range(N_GROUPS):
            kvp[gi].append(nkv_p[gi])
            kvs[gi].append(nkv_s[gi])
        wkv_p.append(w_p)
        sh_p.append(s_p)
        wkv_s.append(w_s)
        sh_s.append(s_s)
    y_prompt = rmsnorm(yp, norm_final)
    y_sample = rmsnorm(ys, norm_final)
    return (y_prompt, y_sample,
            jnp.stack(kvp[0]), jnp.stack(kvp[1]), jnp.stack(kvp[2]),
            jnp.stack(wkv_p), jnp.stack(sh_p),
            jnp.stack(kvs[0]), jnp.stack(kvs[1]), jnp.stack(kvs[2]),
            jnp.stack(wkv_s), jnp.stack(sh_s))
```

```cpp
#include <hip/hip_runtime.h>
#include <cstdio>
#include <cstdint>
namespace pg8 {
#define PG8_LAS __attribute__((address_space(3)))
typedef unsigned short bf16_t;
typedef short bf16x8 __attribute__((ext_vector_type(8)));
typedef float f32x4 __attribute__((ext_vector_type(4)));
typedef unsigned u32x4 __attribute__((ext_vector_type(4)));
constexpr int BM = 256, BK = 64, HALF = 128, HTB = HALF * BK * 2  , STAGE_BYTES = 8 * HTB, NXCD = 8, WGM = 8;

__host__ __device__ __forceinline__ int lds_byte(int r, int c) { const int st = (r >> 4) * 2 + (c >> 5), rr = r & 15, cc = c & 31, ob = rr * 64 + cc * 2; return st * 1024 + (ob ^ (((ob >> 9) & 1) << 5)); }
__host__ __device__ __forceinline__ void stage_rc(int b, int& R, int& C) { const int st = b / 1024, sb = b % 1024, swz = sb ^ (((sb >> 9) & 1) << 5); R = (st >> 1) * 16 + swz / 64; C = (st & 1) * 32 + (swz % 64) / 2; }
__host__ __device__ __forceinline__ int perm32(int rho) { const int n = rho >> 4, i = rho & 15; return 8 * (i >> 2) + 4 * n + (i & 3); }

struct Unit { int pm, pn; };
struct Gemm { const bf16_t* A; const bf16_t* Bt; int M, N, K; };

struct StaticOrder {
    int nM, nN, nwg, G, c;
    __host__ __device__ void init(int M, int N, int G_, int c_) { nM = M / BM; nN = N / BM; nwg = nM * nN; G = G_; c = c_; }
    __host__ __device__ bool next(int i, Unit& u) const {
        const long L = (long)i * G + c; if (L >= nwg) return false;
        int wgid = (int)L; { const int q = nwg / NXCD, r = nwg % NXCD, xcd = wgid % NXCD, off = wgid / NXCD; wgid = (xcd < r ? xcd * (q + 1) : r * (q + 1) + (xcd - r) * q) + off; }
        const int nig = WGM * nN, gid = wgid / nig, fm = gid * WGM, gsz = (nM - fm) < WGM ? (nM - fm) : WGM;
        u.pm = fm + ((wgid % nig) % gsz); u.pn = (wgid % nig) / gsz; return true;
    }
    __device__ __forceinline__ void a_ready(const Unit&) const {}
    __device__ __forceinline__ void done(const Unit&) const {}
};

__device__ __forceinline__ unsigned cvt_pk_bf16(float lo, float hi) { unsigned r; asm volatile("v_cvt_pk_bf16_f32 %0, %1, %2" : "=v"(r) : "v"(lo), "v"(hi)); return r; }
typedef float f32x2 __attribute__((ext_vector_type(2)));
typedef unsigned u32x2 __attribute__((ext_vector_type(2)));
__device__ __forceinline__ float bf_lo(unsigned w) { return __uint_as_float(w << 16); }
__device__ __forceinline__ float bf_hi(unsigned w) { return __uint_as_float(w & 0xffff0000u); }
__device__ __forceinline__ float sigmoidf_(float x) { return __builtin_amdgcn_rcpf(1.0f + __expf(-x)); }

constexpr int NTOK_P = 16384, NTOK = 16512, MPAD = 16640, ZC = 7680;
constexpr size_t OFF_Y_P = 0, OFF_Y_S = 16777216, OFF_KVP0 = 16908288, OFF_KVP1 = 17039360, OFF_KVP2 = 17563648, OFF_WKV_P = 19660800, OFF_SHIFT_P = 19791872,
                 OFF_KVS0 = 19798528, OFF_KVS1 = 19864064, OFF_KVS2 = 19929600, OFF_WKV_S = 19995136, OFF_SHIFT_S = 22092288, OUT_TOTAL = 22198784;

struct EpiZ {
    static constexpr bool PERM = true, AFTER_DRAIN = false;
    bf16_t* Z; const float* rstd0; float* out;
    __device__ __forceinline__ void operator()(const f32x4 (&acc)[2][2][4][2], const Unit& u, int wr, int wc, int fr, int fq) const {
        const int pn = u.pn;
#pragma unroll
        for (int ai = 0; ai < 2; ++ai)
#pragma unroll
            for (int m = 0; m < 4; ++m) {
                const int row = u.pm * BM + ai * HALF + wr * 64 + m * 16 + fr;
                const float rs = rstd0[row];
                bf16_t* zrow = Z + (size_t)row * ZC;
#pragma unroll
                for (int bj = 0; bj < 2; ++bj) {
                    const int col = pn * BM + bj * HALF + wc * 32 + 8 * fq;
                    const f32x4 v0 = acc[ai][bj][m][0] * rs, v1 = acc[ai][bj][m][1] * rs;
                    u32x4 w; w.x = cvt_pk_bf16(v0[0], v0[1]); w.y = cvt_pk_bf16(v0[2], v0[3]); w.z = cvt_pk_bf16(v1[0], v1[1]); w.w = cvt_pk_bf16(v1[2], v1[3]);
                    *(u32x4*)(zrow + col) = w;
                    float* dst = nullptr;
                    if (row < NTOK) {
                        if (pn < 13) {
                            if (row < NTOK_P) { if ((row & 8191) == 8191) dst = out + OFF_SHIFT_P + (size_t)(row >> 13) * 3328 + col; }
                            else { if (((row - NTOK_P) & 3) == 3) dst = out + OFF_SHIFT_S + (size_t)((row - NTOK_P) >> 2) * 3328 + col; }
                        } else if (pn >= 16 && pn < 22) {
                            const int g = (pn - 16) % 3, kvsel = (pn - 16) / 3, cw = col - pn * BM;
                            if (row < NTOK_P) {
                                const int t = row & 8191, b = row >> 13, keep = 128 << (2 * g);
                                const size_t base = g == 0 ? OFF_KVP0 : (g == 1 ? OFF_KVP1 : OFF_KVP2);
                                if (t >= 8192 - keep) dst = out + base + ((size_t)(b * keep + t - (8192 - keep)) * 2 + kvsel) * 256 + cw;
                            } else {
                                const size_t base = g == 0 ? OFF_KVS0 : (g == 1 ? OFF_KVS1 : OFF_KVS2);
                                dst = out + base + ((size_t)(row - NTOK_P) * 2 + kvsel) * 256 + cw;
                            }
                        }
                    }
                    if (dst) { *(f32x4*)dst = v0; *(f32x4*)(dst + 4) = v1; }
                }
            }
    }
};

struct EpiLora {
    static constexpr bool PERM = true, AFTER_DRAIN = false;
    float* LW; bf16_t* AA; bf16_t* GG; const float* w0; const float* a0;
    __device__ __forceinline__ void operator()(const f32x4 (&acc)[2][2][4][2], const Unit& u, int wr, int wc, int fr, int fq) const {
        const int pn = u.pn;
        if (pn < 4) {
#pragma unroll
            for (int ai = 0; ai < 2; ++ai)
#pragma unroll
                for (int m = 0; m < 4; ++m) {
                    const int row = u.pm * BM + ai * HALF + wr * 64 + m * 16 + fr;
#pragma unroll
                    for (int bj = 0; bj < 2; ++bj) {
                        const int col = pn * BM + bj * HALF + wc * 32 + 8 * fq;
                        f32x4 v0 = acc[ai][bj][m][0], v1 = acc[ai][bj][m][1];
                        const f32x4 b0 = *(const f32x4*)(w0 + col), b1 = *(const f32x4*)(w0 + col + 4);
#pragma unroll
                        for (int i = 0; i < 4; ++i) { v0[i] = -0.60653065971f * sigmoidf_(v0[i] + b0[i]); v1[i] = -0.60653065971f * sigmoidf_(v1[i] + b1[i]); }
                        float* d = LW + (size_t)row * 1024 + col; *(f32x4*)d = v0; *(f32x4*)(d + 4) = v1;
                    }
                }
        } else if (pn < 8) {
#pragma unroll
            for (int ai = 0; ai < 2; ++ai)
#pragma unroll
                for (int m = 0; m < 4; ++m) {
                    const int row = u.pm * BM + ai * HALF + wr * 64 + m * 16 + fr;
#pragma unroll
                    for (int bj = 0; bj < 2; ++bj) {
                        const int col = (pn - 4) * BM + bj * HALF + wc * 32 + 8 * fq;
                        f32x4 v0 = acc[ai][bj][m][0], v1 = acc[ai][bj][m][1];
                        const f32x4 b0 = *(const f32x4*)(a0 + col), b1 = *(const f32x4*)(a0 + col + 4);
#pragma unroll
                        for (int i = 0; i < 4; ++i) { v0[i] = sigmoidf_(v0[i] + b0[i]); v1[i] = sigmoidf_(v1[i] + b1[i]); }
                        u32x4 w; w.x = cvt_pk_bf16(v0[0], v0[1]); w.y = cvt_pk_bf16(v0[2], v0[3]); w.z = cvt_pk_bf16(v1[0], v1[1]); w.w = cvt_pk_bf16(v1[2], v1[3]);
                        *(u32x4*)(AA + (size_t)row * 1024 + col) = w;
                    }
                }
        } else {
#pragma unroll
            for (int ai = 0; ai < 2; ++ai)
#pragma unroll
                for (int m = 0; m < 4; ++m) {
                    const int row = u.pm * BM + ai * HALF + wr * 64 + m * 16 + fr;
#pragma unroll
                    for (int bj = 0; bj < 2; ++bj) {
                        const int col = (pn - 8) * BM + bj * HALF + wc * 32 + 8 * fq;
                        const f32x4 v0 = acc[ai][bj][m][0], v1 = acc[ai][bj][m][1];
                        u32x4 w; w.x = cvt_pk_bf16(v0[0], v0[1]); w.y = cvt_pk_bf16(v0[2], v0[3]); w.z = cvt_pk_bf16(v1[0], v1[1]); w.w = cvt_pk_bf16(v1[2], v1[3]);
                        *(u32x4*)(GG + (size_t)row * 1024 + col) = w;
                    }
                }
        }
    }
};

template <bool ADD> struct EpiGate {
    static constexpr bool PERM = true, AFTER_DRAIN = false;
    bf16_t* MIX; const bf16_t* Z; int gate_off;
    __device__ __forceinline__ void operator()(const f32x4 (&acc)[2][2][4][2], const Unit& u, int wr, int wc, int fr, int fq) const {
#pragma unroll
        for (int ai = 0; ai < 2; ++ai)
#pragma unroll
            for (int m = 0; m < 4; ++m) {
                const int row = u.pm * BM + ai * HALF + wr * 64 + m * 16 + fr;
#pragma unroll
                for (int bj = 0; bj < 2; ++bj) {
                    const int col = u.pn * BM + bj * HALF + wc * 32 + 8 * fq;
                    const u32x4 gz = *(const u32x4*)(Z + (size_t)row * ZC + gate_off + col);
                    f32x4 v0 = acc[ai][bj][m][0], v1 = acc[ai][bj][m][1];
                    v0[0] *= sigmoidf_(bf_lo(gz.x)); v0[1] *= sigmoidf_(bf_hi(gz.x)); v0[2] *= sigmoidf_(bf_lo(gz.y)); v0[3] *= sigmoidf_(bf_hi(gz.y));
                    v1[0] *= sigmoidf_(bf_lo(gz.z)); v1[1] *= sigmoidf_(bf_hi(gz.z)); v1[2] *= sigmoidf_(bf_lo(gz.w)); v1[3] *= sigmoidf_(bf_hi(gz.w));
                    bf16_t* d = MIX + (size_t)row * 1024 + col;
                    if (ADD) { const u32x4 o = *(const u32x4*)d;
                        v0[0] += bf_lo(o.x); v0[1] += bf_hi(o.x); v0[2] += bf_lo(o.y); v0[3] += bf_hi(o.y);
                        v1[0] += bf_lo(o.z); v1[1] += bf_hi(o.z); v1[2] += bf_lo(o.w); v1[3] += bf_hi(o.w); }
                    u32x4 w; w.x = cvt_pk_bf16(v0[0], v0[1]); w.y = cvt_pk_bf16(v0[2], v0[3]); w.z = cvt_pk_bf16(v1[0], v1[1]); w.w = cvt_pk_bf16(v1[2], v1[3]);
                    *(u32x4*)d = w;
                }
            }
    }
};

template <int SRC> struct EpiRes {
    static constexpr bool PERM = false, AFTER_DRAIN = false;
    float* X1; bf16_t* XB; float* ss; const float* xp; const float* xs;
    __device__ __forceinline__ void operator()(const f32x4 (&acc)[2][2][4][2], const Unit& u, int wr, int wc, int fr, int fq) const {
#pragma unroll
        for (int ai = 0; ai < 2; ++ai)
#pragma unroll
            for (int m = 0; m < 4; ++m) {
                const int row = u.pm * BM + ai * HALF + wr * 64 + m * 16 + fr;
                const float* brow = SRC == 1 ? X1 + (size_t)row * 1024 : (row < NTOK_P ? xp + (size_t)row * 1024 : xs + (size_t)(row < NTOK ? row - NTOK_P : 0) * 1024);
                float q = 0.f;
#pragma unroll
                for (int bj = 0; bj < 2; ++bj)
#pragma unroll
                    for (int n = 0; n < 2; ++n) {
                        const int col = u.pn * BM + bj * HALF + wc * 32 + 16 * n + 4 * fq;
                        f32x4 b = *(const f32x4*)(brow + col);
                        if (SRC == 0 && row >= NTOK) b = (f32x4){0.f, 0.f, 0.f, 0.f};
                        const f32x4 v = b + acc[ai][bj][m][n];
                        *(f32x4*)(X1 + (size_t)row * 1024 + col) = v;
                        u32x2 w; w.x = cvt_pk_bf16(v[0], v[1]); w.y = cvt_pk_bf16(v[2], v[3]);
                        *(u32x2*)(XB + (size_t)row * 1024 + col) = w;
                        q += (v[0] * v[0] + v[1] * v[1]) + (v[2] * v[2] + v[3] * v[3]);
                    }
                q += __shfl_xor(q, 16); q += __shfl_xor(q, 32);
                if (fq == 0) atomicAdd(ss + row, q);
            }
    }
};

struct EpiFF1 {
    static constexpr bool PERM = true, AFTER_DRAIN = false;
    bf16_t* H; const float* ss;
    __device__ __forceinline__ void operator()(const f32x4 (&acc)[2][2][4][2], const Unit& u, int wr, int wc, int fr, int fq) const {
#pragma unroll
        for (int ai = 0; ai < 2; ++ai)
#pragma unroll
            for (int m = 0; m < 4; ++m) {
                const int row = u.pm * BM + ai * HALF + wr * 64 + m * 16 + fr;
                const float rs = __builtin_amdgcn_rsqf(ss[row] * (1.0f / 1024.0f) + 1e-6f);
#pragma unroll
                for (int bj = 0; bj < 2; ++bj) {
                    const int col = u.pn * BM + bj * HALF + wc * 32 + 8 * fq;
                    f32x4 v0 = acc[ai][bj][m][0] * rs, v1 = acc[ai][bj][m][1] * rs;
#pragma unroll
                    for (int i = 0; i < 4; ++i) { const float a = fmaxf(v0[i], 0.f), b = fmaxf(v1[i], 0.f); v0[i] = a * a; v1[i] = b * b; }
                    u32x4 w; w.x = cvt_pk_bf16(v0[0], v0[1]); w.y = cvt_pk_bf16(v0[2], v0[3]); w.z = cvt_pk_bf16(v1[0], v1[1]); w.w = cvt_pk_bf16(v1[2], v1[3]);
                    *(u32x4*)(H + (size_t)row * 4096 + col) = w;
                }
            }
    }
};

struct EpiT2 {
    static constexpr bool PERM = false, AFTER_DRAIN = false;
    bf16_t* T2;
    __device__ __forceinline__ void operator()(const f32x4 (&acc)[2][2][4][2], const Unit& u, int wr, int wc, int fr, int fq) const {
#pragma unroll
        for (int ai = 0; ai < 2; ++ai)
#pragma unroll
            for (int m = 0; m < 4; ++m) {
                const int row = u.pm * BM + ai * HALF + wr * 64 + m * 16 + fr;
#pragma unroll
                for (int bj = 0; bj < 2; ++bj)
#pragma unroll
                    for (int n = 0; n < 2; ++n) {
                        const int col = u.pn * BM + bj * HALF + wc * 32 + 16 * n + 4 * fq;
                        const f32x4 v = acc[ai][bj][m][n];
                        u32x2 w; w.x = cvt_pk_bf16(v[0], v[1]); w.y = cvt_pk_bf16(v[2], v[3]);
                        *(u32x2*)(T2 + (size_t)row * 1024 + col) = w;
                    }
            }
    }
};

struct EpiPle {
    static constexpr bool PERM = false, AFTER_DRAIN = false;
    float* X1; const bf16_t* T2; const float* ss2; float* ss3;
    __device__ __forceinline__ void operator()(const f32x4 (&acc)[2][2][4][2], const Unit& u, int wr, int wc, int fr, int fq) const {
#pragma unroll
        for (int ai = 0; ai < 2; ++ai)
#pragma unroll
            for (int m = 0; m < 4; ++m) {
                const int row = u.pm * BM + ai * HALF + wr * 64 + m * 16 + fr;
                const float rs = __builtin_amdgcn_rsqf(ss2[row] * (1.0f / 1024.0f) + 1e-6f);
                float q = 0.f;
#pragma unroll
                for (int bj = 0; bj < 2; ++bj)
#pragma unroll
                    for (int n = 0; n < 2; ++n) {
                        const int col = u.pn * BM + bj * HALF + wc * 32 + 16 * n + 4 * fq;
                        const u32x2 t = *(const u32x2*)(T2 + (size_t)row * 1024 + col);
                        const f32x4 b = *(const f32x4*)(X1 + (size_t)row * 1024 + col);
                        const f32x4 a = acc[ai][bj][m][n] * rs;
                        f32x4 v;
                        v[0] = b[0] + sigmoidf_(a[0]) * bf_lo(t.x); v[1] = b[1] + sigmoidf_(a[1]) * bf_hi(t.x);
                        v[2] = b[2] + sigmoidf_(a[2]) * bf_lo(t.y); v[3] = b[3] + sigmoidf_(a[3]) * bf_hi(t.y);
                        *(f32x4*)(X1 + (size_t)row * 1024 + col) = v;
                        q += (v[0] * v[0] + v[1] * v[1]) + (v[2] * v[2] + v[3] * v[3]);
                    }
                q += __shfl_xor(q, 16); q += __shfl_xor(q, 32);
                if (fq == 0) atomicAdd(ss3 + row, q);
            }
    }
};

template <class Epi, class Sched, bool ALIGN_EPI = false, bool SP2 = false>
__device__ __forceinline__ void gemm_phase(PG8_LAS unsigned char* lds, const Gemm g, const Sched& S, const Epi& E) {
    int tid_ = threadIdx.x; asm volatile("" : "+v"(tid_));
    const int tid = tid_, wid = __builtin_amdgcn_readfirstlane(tid >> 6), lane = tid & 63, wr = wid >> 2, wc = wid & 3, fr = lane & 15, fq = lane >> 4;
    int K_ = g.K; asm volatile("" : "+s"(K_));
    const int K = K_, nt = K / BK;
    unsigned voffA[2], voffB[2];
#pragma unroll
    for (int i = 0; i < 2; ++i) { int R, C; stage_rc(tid * 16 + i * 8192, R, C); const int Rb = Epi::PERM ? ((R & ~31) + perm32(R & 31)) : R;
        voffA[i] = (unsigned)(R * K + C) * 2u; voffB[i] = (unsigned)(Rb * K + C) * 2u; }
    const size_t kstep = (size_t)(BK * 2);
    const size_t hstep = (size_t)HALF * K * 2;
    const size_t tstep = 2 * hstep;
    const unsigned ldsw = (unsigned)wid * 1024u;
    const int aoff = lds_byte(wr * 64 + fr, fq * 8), boff = lds_byte(wc * 32 + fr, fq * 8);
#define PG8_SA(b, h) (((b) * 2 + (h)) * HTB)
#define PG8_SB(b, h) ((4 + (b) * 2 + (h)) * HTB)
#define PG8_STAGE(bufoff, gbase, voff) do { _Pragma("unroll") for (int _i = 0; _i < 2; ++_i) \
        __builtin_amdgcn_global_load_lds((const unsigned*)((const char*)(gbase) + (voff)[_i]), (PG8_LAS unsigned*)(lds + (bufoff) + ldsw + _i * 8192), 16, 0, 0); } while (0)
#define PG8_LDA(dst, b, h) do { _Pragma("unroll") for (int m = 0; m < 4; ++m) _Pragma("unroll") for (int k = 0; k < 2; ++k) dst[m][k] = *(const PG8_LAS bf16x8*)(lds + PG8_SA(b, h) + aoff + m * 2048 + k * 1024); } while (0)
#define PG8_LDB(dst, b, h) do { _Pragma("unroll") for (int n = 0; n < 2; ++n) _Pragma("unroll") for (int k = 0; k < 2; ++k) dst[n][k] = *(const PG8_LAS bf16x8*)(lds + PG8_SB(b, h) + boff + n * 2048 + k * 1024); } while (0)
#define PG8_MMA(ai, bj, At, Bt) do { __builtin_amdgcn_s_setprio(1); _Pragma("unroll") for (int m = 0; m < 4; ++m) _Pragma("unroll") for (int n = 0; n < 2; ++n) _Pragma("unroll") for (int k = 0; k < 2; ++k) \
        acc[ai][bj][m][n] = __builtin_amdgcn_mfma_f32_16x16x32_bf16(Bt[n][k], At[m][k], acc[ai][bj][m][n], 0, 0, 0); __builtin_amdgcn_s_setprio(0); } while (0)
#define PG8_WAIT_V(n) asm volatile("s_waitcnt vmcnt(" #n ")" ::: "memory")
#define PG8_WAIT_L(n) asm volatile("s_waitcnt lgkmcnt(" #n ")" ::: "memory")
#define PG8_BAR __builtin_amdgcn_s_barrier()
#define PG8_SCHED __builtin_amdgcn_sched_barrier(0)
    Unit cur, nxt; int ui = 0;
    if (!S.next(0, cur)) return;
    f32x4 acc[2][2][4][2];
#pragma unroll
    for (int a = 0; a < 2; ++a)
#pragma unroll
        for (int b = 0; b < 2; ++b)
#pragma unroll
            for (int m = 0; m < 4; ++m)
#pragma unroll
                for (int n = 0; n < 2; ++n) acc[a][b][m][n] = (f32x4){0.f, 0.f, 0.f, 0.f};
    bf16x8 At[4][2], B0[2][2], B1[2][2];
    const char* cA = (const char*)g.A + (size_t)cur.pm * tstep; const char* cB = (const char*)g.Bt + (size_t)cur.pn * tstep;
    S.a_ready(cur);
    if constexpr (SP2) {
        PG8_STAGE(PG8_SB(0, 0), cB, voffB); PG8_STAGE(PG8_SB(0, 1), cB + hstep, voffB); PG8_STAGE(PG8_SA(0, 0), cA, voffA); PG8_STAGE(PG8_SA(0, 1), cA + hstep, voffA);
        if (wr == 1) PG8_BAR;
        PG8_WAIT_V(2); PG8_BAR;
        PG8_STAGE(PG8_SB(1, 0), cB + kstep, voffB); PG8_STAGE(PG8_SA(1, 0), cA + kstep, voffA); PG8_STAGE(PG8_SB(1, 1), cB + hstep + kstep, voffB);
        PG8_WAIT_V(6); PG8_BAR;
    } else {
        PG8_STAGE(PG8_SB(0, 0), cB, voffB); PG8_STAGE(PG8_SA(0, 0), cA, voffA); PG8_STAGE(PG8_SB(0, 1), cB + hstep, voffB); PG8_STAGE(PG8_SA(0, 1), cA + hstep, voffA);
        if (wr == 1) PG8_BAR;
        PG8_WAIT_V(4); PG8_BAR;
        PG8_STAGE(PG8_SB(1, 0), cB + kstep, voffB); PG8_STAGE(PG8_SA(1, 0), cA + kstep, voffA); PG8_STAGE(PG8_SB(1, 1), cB + hstep + kstep, voffB);
        PG8_WAIT_V(6); PG8_BAR;
    }
    for (;;) {
        const bool has_next = S.next(ui + 1, nxt);
        const char* nA = has_next ? (const char*)g.A + (size_t)nxt.pm * tstep : cA; const char* nB = has_next ? (const char*)g.Bt + (size_t)nxt.pn * tstep : cB;
        for (int t = 0; t < nt; t += 2) {
            const bool last = (t == nt - 2);
            const char* a1 = cA + (size_t)(t + 1) * kstep;
            const char* a2 = last ? nA : cA + (size_t)(t + 2) * kstep; const char* b2 = last ? nB : cB + (size_t)(t + 2) * kstep;
            const char* a3 = a2 + kstep; const char* b3 = b2 + kstep;
            if (last && has_next) S.a_ready(nxt);
            if constexpr (SP2) {
            PG8_LDB(B0, 0, 0); PG8_LDB(B1, 0, 1); PG8_SCHED; PG8_LDA(At, 0, 0); PG8_STAGE(PG8_SA(1, 1), a1 + hstep, voffA);
            PG8_WAIT_V(8); PG8_WAIT_L(0); PG8_BAR; PG8_MMA(0, 0, At, B0); PG8_MMA(0, 1, At, B1); PG8_BAR; PG8_SCHED;
            PG8_LDA(At, 0, 1); PG8_STAGE(PG8_SB(0, 0), b2, voffB); PG8_STAGE(PG8_SB(0, 1), b2 + hstep, voffB); PG8_STAGE(PG8_SA(0, 0), a2, voffA);
            PG8_WAIT_V(8); PG8_WAIT_L(0); PG8_BAR; PG8_MMA(1, 0, At, B0); PG8_MMA(1, 1, At, B1); PG8_BAR; PG8_SCHED;
            PG8_LDB(B0, 1, 0); PG8_LDB(B1, 1, 1); PG8_SCHED; PG8_LDA(At, 1, 0); PG8_STAGE(PG8_SA(0, 1), a2 + hstep, voffA);
            PG8_WAIT_V(8); PG8_WAIT_L(0); PG8_BAR; PG8_MMA(0, 0, At, B0); PG8_MMA(0, 1, At, B1); PG8_BAR; PG8_SCHED;
            PG8_LDA(At, 1, 1); PG8_STAGE(PG8_SB(1, 0), b3, voffB); PG8_STAGE(PG8_SB(1, 1), b3 + hstep, voffB); PG8_STAGE(PG8_SA(1, 0), a3, voffA);
            PG8_WAIT_V(8); PG8_WAIT_L(0); PG8_BAR; PG8_MMA(1, 0, At, B0); PG8_MMA(1, 1, At, B1); PG8_BAR; PG8_SCHED;
            } else {
            PG8_LDB(B0, 0, 0); PG8_SCHED; PG8_LDA(At, 0, 0); PG8_STAGE(PG8_SA(1, 1), a1 + hstep, voffA);
            PG8_WAIT_L(8); PG8_BAR; PG8_WAIT_L(0); PG8_MMA(0, 0, At, B0); PG8_BAR; PG8_SCHED;
            PG8_LDB(B1, 0, 1); PG8_STAGE(PG8_SB(0, 0), b2, voffB);
            PG8_BAR; PG8_WAIT_L(0); PG8_MMA(0, 1, At, B1); PG8_BAR;
            PG8_LDA(At, 0, 1); PG8_STAGE(PG8_SA(0, 0), a2, voffA);
            PG8_BAR; PG8_WAIT_L(0); PG8_MMA(1, 0, At, B0); PG8_BAR; PG8_SCHED;
            PG8_STAGE(PG8_SB(0, 1), b2 + hstep, voffB);
            PG8_WAIT_V(6); PG8_BAR; PG8_MMA(1, 1, At, B1); PG8_BAR;
            PG8_LDB(B0, 1, 0); PG8_SCHED; PG8_LDA(At, 1, 0); PG8_STAGE(PG8_SA(0, 1), a2 + hstep, voffA);
            PG8_WAIT_L(8); PG8_BAR; PG8_WAIT_L(0); PG8_MMA(0, 0, At, B0); PG8_BAR; PG8_SCHED;
            PG8_LDB(B1, 1, 1); PG8_STAGE(PG8_SB(1, 0), b3, voffB);
            PG8_BAR; PG8_WAIT_L(0); PG8_MMA(0, 1, At, B1); PG8_BAR;
            PG8_LDA(At, 1, 1); PG8_STAGE(PG8_SA(1, 0), a3, voffA);
            PG8_BAR; PG8_WAIT_L(0); PG8_MMA(1, 0, At, B0); PG8_BAR; PG8_SCHED;
            PG8_STAGE(PG8_SB(1, 1), b3 + hstep, voffB);
            PG8_WAIT_V(6); PG8_BAR; PG8_MMA(1, 1, At, B1); PG8_BAR;
            }
        }
        if constexpr (ALIGN_EPI) { if (wr == 0) PG8_BAR; }
        if constexpr (!Epi::AFTER_DRAIN) { E(acc, cur, wr, wc, fr, fq); S.done(cur); }
        if (!has_next) break;
#pragma unroll
        for (int a = 0; a < 2; ++a)
#pragma unroll
            for (int b = 0; b < 2; ++b)
#pragma unroll
                for (int m = 0; m < 4; ++m)
#pragma unroll
                    for (int n = 0; n < 2; ++n) acc[a][b][m][n] = (f32x4){0.f, 0.f, 0.f, 0.f};
        cur = nxt; cA = nA; cB = nB; ++ui;
        if constexpr (ALIGN_EPI) { if (wr == 1) PG8_BAR; }
    }
    PG8_WAIT_V(0);
    if constexpr (!ALIGN_EPI) { if (wr == 0) PG8_BAR; }
    PG8_BAR;
    if constexpr (Epi::AFTER_DRAIN) { E.fused(acc, cur, wr, wc, fr, fq, lds, wid, lane); S.done(cur); }
#undef PG8_SA
#undef PG8_SB
#undef PG8_STAGE
#undef PG8_LDA
#undef PG8_LDB
#undef PG8_MMA
#undef PG8_WAIT_V
#undef PG8_WAIT_L
#undef PG8_BAR
#undef PG8_SCHED
}
}
#define GAS __attribute__((address_space(1)))
#define LAS __attribute__((address_space(3)))
typedef unsigned short bf16;
typedef unsigned v4u __attribute__((ext_vector_type(4)));
typedef float f32x4 __attribute__((ext_vector_type(4)));
typedef short bf16x8 __attribute__((ext_vector_type(8)));
typedef GAS unsigned gu32;
typedef GAS unsigned long long gu64;
#define RLX_AGENT __ATOMIC_RELAXED, __HIP_MEMORY_SCOPE_AGENT
#define LDS_WAIT() asm volatile("s_waitcnt lgkmcnt(0)" ::: "memory")
#define VM_WAIT() asm volatile("s_waitcnt vmcnt(0)" ::: "memory")
__device__ __forceinline__ unsigned long long rt() { return __builtin_amdgcn_s_memrealtime(); }
__device__ __forceinline__ unsigned f2bf(float f) { unsigned u = __builtin_bit_cast(unsigned, f); return (u + 0x7fffu + ((u >> 16) & 1u)) >> 16; }
__device__ __forceinline__ unsigned pk2(float lo, float hi) { return f2bf(lo) | (f2bf(hi) << 16); }

#define XB_TMO      128
#define XB_XCNT(j)  (256  + 64 * (j))
#define XB_XSUB(j)  (1280 + 64 * (j))
#define XB_XGEN(j)  (2304 + 64 * (j))
#define XB_TOP      3328
#define XB_TOPGEN   3392
#define XCD_BAR_WORDS 3456
#define XB_SPIN_CAP (1u << 18)

__device__ __forceinline__ unsigned xb_ld(unsigned* p)              { return __hip_atomic_load(p, __ATOMIC_RELAXED, __HIP_MEMORY_SCOPE_AGENT); }
__device__ __forceinline__ unsigned xb_add(unsigned* p, unsigned v) { return __hip_atomic_fetch_add(p, v, __ATOMIC_RELAXED, __HIP_MEMORY_SCOPE_AGENT); }
__device__ __forceinline__ unsigned xb_xcc_id() { return (unsigned)__builtin_amdgcn_s_getreg((3 << 11) | 20) & 0xFu; }
#define XB_SPIN(cond, bar) do { unsigned _sp = 0; while (cond) { __builtin_amdgcn_s_sleep(1); \
    if ((++_sp & 255u) == 0u) { if (xb_ld(&(bar)[XB_TMO])) break; if (_sp > XB_SPIN_CAP) { atomicAdd(&(bar)[XB_TMO], 1u); break; } } } } while (0)

struct XcdBarrier {
    unsigned* bar; unsigned x;
    volatile LAS unsigned* st;
};

__device__ __forceinline__ XcdBarrier xcd_barrier_post(unsigned* bar, volatile LAS unsigned* st) {
    XcdBarrier b; b.bar = bar; b.x = xb_xcc_id(); b.st = st;
    if (threadIdx.x == 0) (void)xb_add(&bar[XB_XCNT(b.x)], 1u);
    return b;
}
__device__ __forceinline__ void xcd_barrier_complete(unsigned* bar, unsigned x, unsigned& nloc, unsigned& nx) {
    const unsigned G = gridDim.x * gridDim.y * gridDim.z;
    unsigned sum, cnt, mine, sp = 0u;
    for (;;) {
        sum = 0u; cnt = 0u; mine = 0u;
#pragma unroll
        for (unsigned j = 0; j < 16; ++j) { const unsigned c = xb_ld(&bar[XB_XCNT(j)]); sum += c; cnt += (c > 0u) ? 1u : 0u; mine = (j == x) ? c : mine; }
        if (sum == G) break;
        __builtin_amdgcn_s_sleep(1);
        if ((++sp & 255u) == 0u) { if (xb_ld(&bar[XB_TMO])) break; if (sp > XB_SPIN_CAP) { atomicAdd(&bar[XB_TMO], 1u); break; } }
    }
    nloc = mine > 0u ? mine : 1u; nx = cnt > 0u ? cnt : 1u;
}

__device__ __forceinline__ void xcd_barrier(const XcdBarrier& b) {
    asm volatile("s_waitcnt vmcnt(0)" ::: "memory");
    __syncthreads();
    if (threadIdx.x == 0) {
        unsigned* bar = b.bar;
        __builtin_amdgcn_s_waitcnt(0);
        unsigned nloc = b.st[0], nx = b.st[1];
        if (nloc == 0u) { xcd_barrier_complete(bar, b.x, nloc, nx); b.st[0] = nloc; b.st[1] = nx; }
        const unsigned old = xb_add(&bar[XB_XSUB(b.x)], 1u);
        const unsigned gen = old / nloc;
        if (old + 1u == (gen + 1u) * nloc) {
            __builtin_amdgcn_fence(__ATOMIC_RELEASE, "agent");
            asm volatile("s_waitcnt vmcnt(0)" ::: "memory");
            const unsigned og = xb_add(&bar[XB_TOP], 1u);
            const unsigned tg = og / nx;
            if (og + 1u == (tg + 1u) * nx) xb_add(&bar[XB_TOPGEN], 1u);
            else XB_SPIN(xb_ld(&bar[XB_TOPGEN]) == tg, bar);
            __builtin_amdgcn_fence(__ATOMIC_ACQUIRE, "agent");
            xb_add(&bar[XB_XGEN(b.x)], 1u);
            asm volatile("s_waitcnt vmcnt(0)" ::: "memory");
        } else {
            XB_SPIN(xb_ld(&bar[XB_XGEN(b.x)]) == gen, bar);
            __builtin_amdgcn_fence(__ATOMIC_ACQUIRE, "agent");
            asm volatile("s_waitcnt vmcnt(0)" ::: "memory");
        }
    }
    __syncthreads();
}
typedef unsigned u32x2_t __attribute__((ext_vector_type(2)));
typedef unsigned u32x4_t __attribute__((ext_vector_type(4)));

constexpr int NWAVES = 8;
constexpr int NTOK_P = pg8::NTOK_P, NTOK = pg8::NTOK, MPAD = pg8::MPAD, ZC = pg8::ZC;
constexpr int DM = 1024, DFF = 4096, SEQ = 8192;
constexpr int ZQ = 3328, ZK = 4096, ZV = 4864, ZGA = 5632, ZGB = 6656;
using pg8::OFF_Y_P; using pg8::OFF_Y_S; using pg8::OFF_WKV_P; using pg8::OFF_WKV_S; using pg8::OUT_TOTAL;

constexpr size_t MiB = 1u << 20;
constexpr size_t WS_CTL = 0, CTL_ZERO_BYTES = 1 * MiB;
constexpr size_t WS_WIN = 1 * MiB, WS_WLORA = 16 * MiB, WS_WBR = 18 * MiB, WS_WBA = 20 * MiB, WS_WOUT = 21 * MiB, WS_WFF1 = 23 * MiB, WS_WFF2 = 31 * MiB, WS_WPG = 39 * MiB, WS_WPLE = 41 * MiB;
constexpr size_t WS_STAT = 42 * MiB;
constexpr size_t WS_LSE = 43 * MiB;
constexpr size_t WS_XB = 44 * MiB;
constexpr size_t WS_OBUF = 44 * MiB;
constexpr size_t WS_Z = 77 * MiB;
constexpr size_t WS_X1 = 77 * MiB, WS_X1B = 142 * MiB, WS_HDN = 175 * MiB, WS_T2 = 175 * MiB;
constexpr size_t WS_ALORA = 321 * MiB;
constexpr size_t WS_ATTN = 321 * MiB;
constexpr size_t WS_LW = 330 * MiB;
constexpr size_t WS_MIX = 330 * MiB;
constexpr size_t WS_AA = 395 * MiB, WS_GG = 428 * MiB, WS_RO = 461 * MiB, WS_PB = 494 * MiB, WS_END = 503 * MiB;
static_assert(WS_Z + (size_t)MPAD * ZC * 2 <= WS_ALORA && WS_HDN + (size_t)MPAD * DFF * 2 <= WS_ALORA && WS_X1 + (size_t)MPAD * DM * 4 <= WS_X1B && WS_X1B + (size_t)MPAD * DM * 2 <= WS_HDN, "ws map");
static_assert(WS_LW + (size_t)MPAD * DM * 4 <= WS_AA && WS_AA + (size_t)MPAD * DM * 2 <= WS_GG && WS_GG + (size_t)MPAD * DM * 2 <= WS_RO && WS_RO + (size_t)MPAD * DM * 2 <= WS_PB && WS_PB + (size_t)MPAD * 256 * 2 <= WS_END, "ws map 2");
static_assert(WS_XB + (size_t)MPAD * DM * 2 <= WS_Z && WS_ALORA + (size_t)MPAD * 256 * 2 <= WS_LW && WS_LSE + (size_t)MPAD * 12 * 4 <= WS_XB && WS_STAT + (size_t)MPAD * 16 <= WS_LSE, "ws map 3");
constexpr int CW_TMO = 0, CW_CODE = 1, CW_BAR = 4096, CW_QUEUE = 8192;

constexpr int RING_OFF = 0, RING_BYTES = 131072;
constexpr int LDSCTL_OFF = RING_BYTES, MISC_OFF = LDSCTL_OFF + 320;
constexpr int LDS_BYTES = 147456;

struct Frame {
    LAS unsigned char* lds;
    volatile LAS unsigned* MISC;
    gu32* ctl;
    int tid, lane, wave;
    int vcu, G;
};

__device__ __forceinline__ float wave_sum(float v) {
#pragma unroll
    for (int o = 1; o < 64; o <<= 1) v += __shfl_xor(v, o);
    return v;
}
__device__ __forceinline__ float wave_max(float v) {
#pragma unroll
    for (int o = 1; o < 64; o <<= 1) v = fmaxf(v, __shfl_xor(v, o));
    return v;
}
__device__ __forceinline__ float bf2f(bf16 h) { return __uint_as_float((unsigned)h << 16); }
__device__ __forceinline__ float bflo(unsigned w) { return __uint_as_float(w << 16); }
__device__ __forceinline__ float bfhi(unsigned w) { return __uint_as_float(w & 0xffff0000u); }
__device__ __forceinline__ float sigm(float x) { return 1.0f / (1.0f + __expf(-x)); }

__device__ __forceinline__ void p0_transpose_item(const float* W, int K, int N, bf16* WT, const float* gain, LAS float* scr, int item, int lane) {
    const int nblk = N / 32, kb = item / nblk, nb = item % nblk, k0 = 64 * kb, n0 = 32 * nb;
#pragma unroll 8
    for (int i = 0; i < 32; ++i) { const int kk = 2 * i + (lane >> 5); float v = W[(size_t)(k0 + kk) * N + n0 + (lane & 31)]; if (gain) v *= gain[k0 + kk]; scr[kk * 33 + (lane & 31)] = v; }
    LDS_WAIT(); asm volatile("" ::: "memory");
    const int c = lane & 7;
#pragma unroll
    for (int j = 0; j < 4; ++j) { const int n = (lane >> 3) + 8 * j; const LAS float* s = scr + (8 * c) * 33 + n;
        v4u o; o.x = pk2(s[0 * 33], s[1 * 33]); o.y = pk2(s[2 * 33], s[3 * 33]); o.z = pk2(s[4 * 33], s[5 * 33]); o.w = pk2(s[6 * 33], s[7 * 33]);
        *(GAS v4u*)(WT + (size_t)(n0 + n) * K + k0 + 8 * c) = o; }
    LDS_WAIT(); asm volatile("" ::: "memory");
}

struct In {
    const float *x_prompt, *x_sample, *cache0, *cache1, *cache2, *state_wkv, *state_shift, *p_prompt, *p_sample, *norm_mix, *w_in, *shift_mu, *decay_w0, *decay_w2, *aaa_a0, *aaa_a2,
                *gate_g2, *k_k, *k_a, *r_k, *lnx_w, *lnx_b, *w_br, *w_ba, *w_out, *norm_mlp, *w_ff1, *w_ff2, *norm_ple, *w_ple, *w_pg, *norm_final;
};
struct Args { In in; float* out; unsigned char* ws; };

__device__ __forceinline__ void p0_prologue(Frame& F, const In& I, unsigned char* ws) {
    LAS float* scr = (LAS float*)(F.lds + RING_OFF + F.wave * 16384);
    const int gw = F.vcu * NWAVES + F.wave, NGW = F.G * NWAVES, lane = F.lane;
    constexpr int I_IN = (1024 / 64) * (7680 / 32), I_SQ = (1024 / 64) * (1024 / 32), I_BA = (256 / 64) * (1024 / 32), I_F1 = (1024 / 64) * (4096 / 32), I_F2 = (4096 / 64) * (1024 / 32);
    constexpr int NITEMS = I_IN + 3 * I_SQ + 2 * I_BA + I_F1 + I_F2;
    for (int it = gw; it < NITEMS; it += NGW) {
        int r = it;
        if (r < I_IN) { p0_transpose_item(I.w_in, 1024, 7680, (bf16*)(ws + WS_WIN), I.norm_mix, scr, r, lane); continue; } r -= I_IN;
        if (r < I_SQ) { p0_transpose_item(I.w_br, 1024, 1024, (bf16*)(ws + WS_WBR), nullptr, scr, r, lane); continue; } r -= I_SQ;
        if (r < I_SQ) { p0_transpose_item(I.w_out, 1024, 1024, (bf16*)(ws + WS_WOUT), nullptr, scr, r, lane); continue; } r -= I_SQ;
        if (r < I_SQ) { p0_transpose_item(I.w_pg, 1024, 1024, (bf16*)(ws + WS_WPG), I.norm_ple, scr, r, lane); continue; } r -= I_SQ;
        if (r < I_BA) { p0_transpose_item(I.w_ba, 256, 1024, (bf16*)(ws + WS_WBA), nullptr, scr, r, lane); continue; } r -= I_BA;
        if (r < I_BA) { p0_transpose_item(I.w_ple, 256, 1024, (bf16*)(ws + WS_WPLE), nullptr, scr, r, lane); continue; } r -= I_BA;
        if (r < I_F1) { p0_transpose_item(I.w_ff1, 1024, 4096, (bf16*)(ws + WS_WFF1), I.norm_mlp, scr, r, lane); continue; } r -= I_F1;
        p0_transpose_item(I.w_ff2, 4096, 1024, (bf16*)(ws + WS_WFF2), nullptr, scr, r, lane);
    }
    {
        bf16* WL = (bf16*)(ws + WS_WLORA);
        const int gt = gw * 64 + lane, NGT = NGW * 64;
        for (int idx = gt; idx < 3072 * 32; idx += NGT) {
            const int n = idx >> 5, kc = (idx & 31) * 8, blk = n >> 10, nn = n & 1023;
            float v[8];
#pragma unroll
            for (int j = 0; j < 8; ++j) { const int k = kc + j; float x = 0.f;
                if (blk == 0) { if (k < 64) x = I.decay_w2[(size_t)k * 1024 + nn]; }
                else if (blk == 1) { if (k >= 64 && k < 128) x = I.aaa_a2[(size_t)(k - 64) * 1024 + nn]; }
                else { if (k >= 128) x = I.gate_g2[(size_t)(k - 128) * 1024 + nn]; }
                v[j] = x; }
            v4u o; o.x = pk2(v[0], v[1]); o.y = pk2(v[2], v[3]); o.z = pk2(v[4], v[5]); o.w = pk2(v[6], v[7]);
            *(GAS v4u*)(WL + (size_t)n * 256 + kc) = o;
        }
    }
    bf16* XB = (bf16*)(ws + WS_XB); bf16* PB = (bf16*)(ws + WS_PB); float* stat = (float*)(ws + WS_STAT);
    for (int m = gw; m < MPAD; m += NGW) {
        GAS unsigned long long* o8 = (GAS unsigned long long*)(XB + (size_t)m * DM) + lane;
        GAS unsigned long long* p8 = (GAS unsigned long long*)(PB + (size_t)m * 256) + lane;
        if (m < NTOK) {
            const float* xrow = m < NTOK_P ? I.x_prompt + (size_t)m * DM : I.x_sample + (size_t)(m - NTOK_P) * DM;
            const GAS f32x4* xr = (const GAS f32x4*)xrow + lane;
            f32x4 v[4]; float s = 0.f;
#pragma unroll
            for (int j = 0; j < 4; ++j) { v[j] = xr[64 * j]; s += (v[j].x * v[j].x + v[j].y * v[j].y) + (v[j].z * v[j].z + v[j].w * v[j].w); }
            s = wave_sum(s);
            if (lane == 0) stat[m] = 1.0f / sqrtf(s * (1.0f / DM) + 1e-6f);
#pragma unroll
            for (int j = 0; j < 4; ++j) o8[64 * j] = (unsigned long long)pk2(v[j].x, v[j].y) | ((unsigned long long)pk2(v[j].z, v[j].w) << 32);
            const float* prow = m < NTOK_P ? I.p_prompt + (size_t)m * 256 : I.p_sample + (size_t)(m - NTOK_P) * 256;
            const f32x4 pv = ((const GAS f32x4*)prow)[lane];
            p8[0] = (unsigned long long)pk2(pv.x, pv.y) | ((unsigned long long)pk2(pv.z, pv.w) << 32);
        } else {
            if (lane == 0) stat[m] = 0.f;
#pragma unroll
            for (int j = 0; j < 4; ++j) o8[64 * j] = 0ull;
            p8[0] = 0ull;
        }
        if (lane < 3) stat[(size_t)(1 + lane) * MPAD + m] = 0.f;
    }
}

__device__ __forceinline__ void p2a_lora_prep(Frame& F, const In& I, unsigned char* ws) {
    const int gw = F.vcu * NWAVES + F.wave, NGW = F.G * NWAVES, lane = F.lane;
    const bf16* Z = (const bf16*)(ws + WS_Z); bf16* AL = (bf16*)(ws + WS_ALORA);
    const int c = 4 * lane;
    const f32x4 mu = *(const f32x4*)(I.shift_mu + 3072 + c);
    for (int m = gw; m < MPAD; m += NGW) {
        unsigned long long o = 0ull;
        if (m < NTOK) {
            const u32x2_t zc = *(const u32x2_t*)(Z + (size_t)m * ZC + 3072 + c);
            float z0 = bflo(zc.x), z1 = bfhi(zc.x), z2 = bflo(zc.y), z3 = bfhi(zc.y);
            float p0 = 0.f, p1 = 0.f, p2 = 0.f, p3 = 0.f;
            const bool first = m < NTOK_P ? ((m & (SEQ - 1)) == 0) : (((m - NTOK_P) & 3) == 0);
            if (!first) { const u32x2_t zp = *(const u32x2_t*)(Z + (size_t)(m - 1) * ZC + 3072 + c); p0 = bflo(zp.x); p1 = bfhi(zp.x); p2 = bflo(zp.y); p3 = bfhi(zp.y); }
            else if (m >= NTOK_P) { const f32x4 sp = *(const f32x4*)(I.state_shift + (size_t)((m - NTOK_P) >> 2) * 3328 + 3072 + c); p0 = sp.x; p1 = sp.y; p2 = sp.z; p3 = sp.w; }
            z0 += (p0 - z0) * mu.x; z1 += (p1 - z1) * mu.y; z2 += (p2 - z2) * mu.z; z3 += (p3 - z3) * mu.w;
            if (c < 64) { z0 = tanhf(z0); z1 = tanhf(z1); z2 = tanhf(z2); z3 = tanhf(z3); }
            else if (c >= 128) { z0 = sigm(z0); z1 = sigm(z1); z2 = sigm(z2); z3 = sigm(z3); }
            o = (unsigned long long)pk2(z0, z1) | ((unsigned long long)pk2(z2, z3) << 32);
        }
        *(GAS unsigned long long*)(AL + (size_t)m * 256 + c) = o;
    }
}

constexpr int SCAN_TB = 8;
__device__ __forceinline__ void scan_wave(Frame& F, const In& I, unsigned char* ws, float* out, int seq, LAS float* wl) {
    const int lane = F.lane;
    const bool samp = seq >= 32;
    const int q = samp ? seq - 32 : seq, bn = q >> 4, h = q & 15;
    const int row0 = samp ? NTOK_P + bn * 4 : bn * SEQ, T = samp ? 4 : SEQ;
    const int col = h * 64 + lane;
    const bf16* Z = (const bf16*)(ws + WS_Z); const float* LW = (const float*)(ws + WS_LW); const bf16* AA = (const bf16*)(ws + WS_AA); const bf16* GG = (const bf16*)(ws + WS_GG);
    bf16* RO = (bf16*)(ws + WS_RO);
    const float mu_r = I.shift_mu[col], mu_k = I.shift_mu[1024 + col], mu_v = I.shift_mu[2048 + col];
    const float kk_c = I.k_k[col], ka_c = I.k_a[col], rk_c = I.r_k[col], lnw_c = I.lnx_w[col], lnb_c = I.lnx_b[col];
    float s[64];
    if (samp) { const f32x4* sp = (const f32x4*)(I.state_wkv + ((size_t)(bn * 16 + h) * 64 + lane) * 64);
#pragma unroll
        for (int j = 0; j < 16; ++j) { const f32x4 v = sp[j]; s[4 * j] = v.x; s[4 * j + 1] = v.y; s[4 * j + 2] = v.z; s[4 * j + 3] = v.w; } }
    else {
#pragma unroll
        for (int j = 0; j < 64; ++j) s[j] = 0.f; }
    float pr = 0.f, pk = 0.f, pv = 0.f;
    if (samp) { const float* sp = I.state_shift + (size_t)bn * 3328; pr = sp[col]; pk = sp[1024 + col]; pv = sp[2048 + col]; }
    LAS float* LA = wl; LAS float* LWv = wl + SCAN_TB * 64; LAS float* LB = wl + 2 * SCAN_TB * 64; LAS float* LK = wl + 3 * SCAN_TB * 64; LAS float* LR = wl + 4 * SCAN_TB * 64; LAS float* LV = wl + 5 * SCAN_TB * 64;
    LAS float* LS = wl + 6 * SCAN_TB * 64;
    for (int t0 = 0; t0 < T; t0 += SCAN_TB) {
        const int nb = (T - t0) < SCAN_TB ? (T - t0) : SCAN_TB;
        for (int tt = 0; tt < nb; ++tt) {
            const size_t m = (size_t)(row0 + t0 + tt);
            const float zr = bf2f(Z[m * ZC + col]), zk = bf2f(Z[m * ZC + 1024 + col]), zv = bf2f(Z[m * ZC + 2048 + col]);
            const float r = zr + (pr - zr) * mu_r, k = zk + (pk - zk) * mu_k, v = zv + (pv - zv) * mu_v;
            pr = zr; pk = zk; pv = zv;
            const float lw = LW[m * 1024 + col], aa = bf2f(AA[m * 1024 + col]);
            const float w = __expf(lw);
            const float kkv = k * kk_c;
            const float nrm = sqrtf(wave_sum(kkv * kkv));
            const float kk = kkv / fmaxf(nrm, 1e-12f);
            const float kp = k * (1.0f + (aa - 1.0f) * ka_c);
            const float rk = wave_sum(r * kp * rk_c);
            LA[tt * 64 + lane] = -kk; LWv[tt * 64 + lane] = w; LB[tt * 64 + lane] = kk * aa; LK[tt * 64 + lane] = kp; LR[tt * 64 + lane] = r; LV[tt * 64 + lane] = v;
            if (lane == 0) LS[tt] = rk;
        }
        LDS_WAIT(); asm volatile("" ::: "memory");
        for (int tt = 0; tt < nb; ++tt) {
            const size_t m = (size_t)(row0 + t0 + tt);
            const float vv = LV[tt * 64 + lane];
            const LAS f32x4* a4 = (const LAS f32x4*)(LA + tt * 64); const LAS f32x4* w4 = (const LAS f32x4*)(LWv + tt * 64); const LAS f32x4* b4 = (const LAS f32x4*)(LB + tt * 64);
            const LAS f32x4* k4 = (const LAS f32x4*)(LK + tt * 64); const LAS f32x4* r4 = (const LAS f32x4*)(LR + tt * 64);
            float sa0 = 0.f, sa1 = 0.f, sa2 = 0.f, sa3 = 0.f;
#pragma unroll
            for (int j = 0; j < 16; ++j) { const f32x4 a = a4[j]; sa0 += s[4 * j] * a.x; sa1 += s[4 * j + 1] * a.y; sa2 += s[4 * j + 2] * a.z; sa3 += s[4 * j + 3] * a.w; }
            const float sa = (sa0 + sa1) + (sa2 + sa3);
            float y0 = 0.f, y1 = 0.f, y2 = 0.f, y3 = 0.f;
#pragma unroll
            for (int j = 0; j < 16; ++j) { const f32x4 w = w4[j], b = b4[j], kq = k4[j], r = r4[j];
                s[4 * j]     = s[4 * j]     * w.x + (sa * b.x + vv * kq.x); y0 += s[4 * j] * r.x;
                s[4 * j + 1] = s[4 * j + 1] * w.y + (sa * b.y + vv * kq.y); y1 += s[4 * j + 1] * r.y;
                s[4 * j + 2] = s[4 * j + 2] * w.z + (sa * b.z + vv * kq.z); y2 += s[4 * j + 2] * r.z;
                s[4 * j + 3] = s[4 * j + 3] * w.w + (sa * b.w + vv * kq.w); y3 += s[4 * j + 3] * r.w; }
            const float y = (y0 + y1) + (y2 + y3);
            const float mean = wave_sum(y) * (1.0f / 64.0f), d = y - mean;
            const float var = wave_sum(d * d) * (1.0f / 64.0f);
            const float yn = d * (1.0f / sqrtf(var + 64e-5f)) * lnw_c + lnb_c;
            const float g = bf2f(GG[m * 1024 + col]);
            const float o = (yn + LS[tt] * vv) * g;
            RO[m * 1024 + col] = (bf16)f2bf(o);
        }
        LDS_WAIT(); asm volatile("" ::: "memory");
    }
    float* dst = out + (samp ? OFF_WKV_S : OFF_WKV_P) + ((size_t)(bn * 16 + h) * 64 + lane) * 64;
#pragma unroll
    for (int j = 0; j < 16; ++j) *(f32x4*)(dst + 4 * j) = (f32x4){s[4 * j], s[4 * j + 1], s[4 * j + 2], s[4 * j + 3]};
}

__device__ __forceinline__ void attn_sample_item(Frame& F, const In& I, unsigned char* ws, int item, LAS float* wl) {
    const int lane = F.lane;
    const int h = item & 3, g = (item >> 2) % 3, nt = item / 12, n = nt >> 2, t = nt & 3;
    const int d = g == 0 ? 1 : (g == 1 ? 4 : 16), L = g == 0 ? 128 : (g == 1 ? 512 : 2048);
    const float* cache = g == 0 ? I.cache0 : (g == 1 ? I.cache1 : I.cache2);
    const bf16* Z = (const bf16*)(ws + WS_Z);
    const size_t mq = (size_t)(NTOK_P + nt);
    const int hc = g * 256 + h * 64;
    wl[lane] = bf2f(Z[mq * ZC + ZQ + hc + lane]) * 0.125f;
    LDS_WAIT(); asm volatile("" ::: "memory");
    float sc[3];
#pragma unroll
    for (int jj = 0; jj < 3; ++jj) {
        const int j = lane + 64 * jj;
        float s = -1e30f;
        if (j <= 128) {
            const int idx = L + t - d * j;
            float acc = 0.f;
            if (idx >= L) { const bf16* kr = Z + (size_t)(NTOK_P + n * 4 + idx - L) * ZC + ZK + hc;
#pragma unroll
                for (int e8 = 0; e8 < 8; ++e8) { const v4u kv = *(const v4u*)(kr + 8 * e8); const LAS f32x4* qq = (const LAS f32x4*)(wl + 8 * e8); const f32x4 q0 = qq[0], q1 = qq[1];
                    acc += bflo(kv.x) * q0.x + bfhi(kv.x) * q0.y + bflo(kv.y) * q0.z + bfhi(kv.y) * q0.w + bflo(kv.z) * q1.x + bfhi(kv.z) * q1.y + bflo(kv.w) * q1.z + bfhi(kv.w) * q1.w; } }
            else { const float* kr = cache + (((size_t)n * L + idx) * 2 + 0) * 256 + h * 64;
#pragma unroll
                for (int e4 = 0; e4 < 16; ++e4) { const f32x4 kv = *(const f32x4*)(kr + 4 * e4); const f32x4 q0 = ((const LAS f32x4*)wl)[e4];
                    acc += kv.x * q0.x + kv.y * q0.y + kv.z * q0.z + kv.w * q0.w; } }
            s = acc;
        }
        sc[jj] = s;
    }
    const float mx = wave_max(fmaxf(fmaxf(sc[0], sc[1]), sc[2]));
    float den = 0.f;
#pragma unroll
    for (int jj = 0; jj < 3; ++jj) { const int j = lane + 64 * jj; const float p = (j <= 128) ? __expf(sc[jj] - mx) : 0.f; den += p; if (j <= 128) wl[64 + j] = p; }
    den = wave_sum(den);
    LDS_WAIT(); asm volatile("" ::: "memory");
    float o = 0.f;
    for (int j = 0; j <= 128; ++j) {
        const int idx = L + t - d * j;
        float v;
        if (idx >= L) v = bf2f(Z[(size_t)(NTOK_P + n * 4 + idx - L) * ZC + ZV + hc + lane]);
        else v = cache[(((size_t)n * L + idx) * 2 + 1) * 256 + h * 64 + lane];
        o += wl[64 + j] * v;
    }
    bf16* OB = (bf16*)(ws + WS_OBUF); float* LSE = (float*)(ws + WS_LSE);
    OB[mq * 768 + hc + lane] = (bf16)f2bf(o / den);
    if (lane == 0) LSE[mq * 12 + g * 4 + h] = mx + __logf(den);
    LDS_WAIT(); asm volatile("" ::: "memory");
}

constexpr int AQ_PITCH = 144, AK_PITCH = 144, AV_PITCH = 528;
constexpr int A_QS = 0, A_KS = 128 * AQ_PITCH, A_VT = A_KS + 256 * AK_PITCH, A_END = A_VT + 64 * AV_PITCH;
static_assert(A_END <= RING_BYTES, "attention LDS");
typedef short s16x4 __attribute__((ext_vector_type(4)));
__device__ __forceinline__ void attn_prompt_unit(Frame& F, unsigned char* ws, int unit) {
    const int tid = F.tid, lane = F.lane, w = F.wave;
    const int sub = unit & 63, bgh = unit >> 6, h = bgh & 3, g = (bgh >> 2) % 3, b = bgh / 12;
    const int dsh = 2 * g, d = 1 << dsh, nblk = 64 >> dsh;
    const int r = sub / nblk, blk = sub % nblk;
    const bf16* Z = (const bf16*)(ws + WS_Z);
    const int hc = g * 256 + h * 64;
    LAS unsigned char* lds = F.lds + RING_OFF;
    const size_t rowb = (size_t)b * SEQ;
    for (int ch = tid; ch < 128 * 8; ch += 512) { const int i = ch >> 3, c8 = ch & 7; const int pos = r + d * (128 * blk + i);
        const v4u v = *(const v4u*)(Z + (rowb + pos) * ZC + ZQ + hc + 8 * c8); *(LAS v4u*)(lds + A_QS + i * AQ_PITCH + 16 * c8) = v; }
    for (int ch = tid; ch < 256 * 8; ch += 512) { const int j = ch >> 3, c8 = ch & 7; const int pos = r + d * (128 * (blk - 1) + j);
        v4u kv = (v4u){0u, 0u, 0u, 0u}, vv = (v4u){0u, 0u, 0u, 0u};
        if (pos >= 0) { kv = *(const v4u*)(Z + (rowb + pos) * ZC + ZK + hc + 8 * c8); vv = *(const v4u*)(Z + (rowb + pos) * ZC + ZV + hc + 8 * c8); }
        *(LAS v4u*)(lds + A_KS + j * AK_PITCH + 16 * c8) = kv;
        LAS unsigned short* vt = (LAS unsigned short*)(lds + A_VT) + j;
        const int e0 = 8 * c8;
        vt[(e0 + 0) * (AV_PITCH / 2)] = (unsigned short)(vv.x & 0xffffu); vt[(e0 + 1) * (AV_PITCH / 2)] = (unsigned short)(vv.x >> 16);
        vt[(e0 + 2) * (AV_PITCH / 2)] = (unsigned short)(vv.y & 0xffffu); vt[(e0 + 3) * (AV_PITCH / 2)] = (unsigned short)(vv.y >> 16);
        vt[(e0 + 4) * (AV_PITCH / 2)] = (unsigned short)(vv.z & 0xffffu); vt[(e0 + 5) * (AV_PITCH / 2)] = (unsigned short)(vv.z >> 16);
        vt[(e0 + 6) * (AV_PITCH / 2)] = (unsigned short)(vv.w & 0xffffu); vt[(e0 + 7) * (AV_PITCH / 2)] = (unsigned short)(vv.w >> 16); }
    __syncthreads();
    const int l15 = lane & 15, lq = lane >> 4;
    bf16x8 qf[2];
#pragma unroll
    for (int es = 0; es < 2; ++es) qf[es] = *(const LAS bf16x8*)(lds + A_QS + (16 * w + l15) * AQ_PITCH + es * 64 + 16 * lq);
    f32x4 sacc[9];
#pragma unroll
    for (int kt = 0; kt < 9; ++kt) {
        f32x4 a = (f32x4){0.f, 0.f, 0.f, 0.f};
#pragma unroll
        for (int es = 0; es < 2; ++es) { const bf16x8 kf = *(const LAS bf16x8*)(lds + A_KS + (16 * (w + kt) + l15) * AK_PITCH + es * 64 + 16 * lq);
            a = __builtin_amdgcn_mfma_f32_16x16x32_bf16(kf, qf[es], a, 0, 0, 0); }
        sacc[kt] = a;
    }
    const int qi = 16 * w + l15;
    float mx = -1e30f;
#pragma unroll
    for (int kt = 0; kt < 9; ++kt)
#pragma unroll
        for (int rg = 0; rg < 4; ++rg) { const int kj = 16 * (w + kt) + 4 * lq + rg; const int dist = qi + 128 - kj;
            const bool ok = (dist >= 0) && (dist <= 128) && (blk > 0 || kj >= 128);
            const float sv = ok ? sacc[kt][rg] * 0.125f : -1e30f; sacc[kt][rg] = sv; mx = fmaxf(mx, sv); }
    mx = fmaxf(mx, __shfl_xor(mx, 16)); mx = fmaxf(mx, __shfl_xor(mx, 32));
    float den = 0.f;
#pragma unroll
    for (int kt = 0; kt < 9; ++kt)
#pragma unroll
        for (int rg = 0; rg < 4; ++rg) { const float p = __expf(sacc[kt][rg] - mx); sacc[kt][rg] = p; den += p; }
    den += __shfl_xor(den, 16); den += __shfl_xor(den, 32);
    f32x4 oacc[4];
#pragma unroll
    for (int et = 0; et < 4; ++et) oacc[et] = (f32x4){0.f, 0.f, 0.f, 0.f};
#pragma unroll
    for (int ks = 0; ks < 5; ++ks) {
        const int k0 = 2 * ks, k1 = 2 * ks + 1;
        u32x4_t pw;
        pw.x = pk2(sacc[k0][0], sacc[k0][1]); pw.y = pk2(sacc[k0][2], sacc[k0][3]);
        if (k1 < 9) { pw.z = pk2(sacc[k1 < 9 ? k1 : 8][0], sacc[k1 < 9 ? k1 : 8][1]); pw.w = pk2(sacc[k1 < 9 ? k1 : 8][2], sacc[k1 < 9 ? k1 : 8][3]); } else { pw.z = 0u; pw.w = 0u; }
        const bf16x8 pf = __builtin_bit_cast(bf16x8, pw);
#pragma unroll
        for (int et = 0; et < 4; ++et) {
            const LAS unsigned char* vrow = lds + A_VT + (16 * et + l15) * AV_PITCH;
            const s16x4 lo = *(const LAS s16x4*)(vrow + (16 * (w + k0) + 4 * lq) * 2);
            s16x4 hi = (s16x4){0, 0, 0, 0};
            if (k1 < 9) hi = *(const LAS s16x4*)(vrow + (16 * (w + (k1 < 9 ? k1 : 8)) + 4 * lq) * 2);
            const bf16x8 vf = (bf16x8){lo[0], lo[1], lo[2], lo[3], hi[0], hi[1], hi[2], hi[3]};
            oacc[et] = __builtin_amdgcn_mfma_f32_16x16x32_bf16(vf, pf, oacc[et], 0, 0, 0);
        }
    }
    const float rden = 1.0f / den;
    const size_t mq = rowb + (size_t)(r + d * (128 * blk + qi));
    bf16* OB = (bf16*)(ws + WS_OBUF); float* LSE = (float*)(ws + WS_LSE);
#pragma unroll
    for (int et = 0; et < 4; ++et) { const f32x4 o = oacc[et] * rden;
        *(GAS unsigned long long*)(OB + mq * 768 + hc + 16 * et + 4 * lq) = (unsigned long long)pk2(o[0], o[1]) | ((unsigned long long)pk2(o[2], o[3]) << 32); }
    if (lq == 0) LSE[mq * 12 + g * 4 + h] = mx + __logf(den);
    __syncthreads();
}

__device__ __forceinline__ void p2d_attn_merge(Frame& F, unsigned char* ws) {
    const int gw = F.vcu * NWAVES + F.wave, NGW = F.G * NWAVES, lane = F.lane;
    const bf16* OB = (const bf16*)(ws + WS_OBUF); const float* LSE = (const float*)(ws + WS_LSE); bf16* AT = (bf16*)(ws + WS_ATTN);
    const int c = 4 * lane, h = lane >> 4;
    for (int m = gw; m < MPAD; m += NGW) {
        unsigned long long o = 0ull;
        if (m < NTOK) {
            const float l0 = LSE[(size_t)m * 12 + h], l1 = LSE[(size_t)m * 12 + 4 + h], l2 = LSE[(size_t)m * 12 + 8 + h];
            const float mx = fmaxf(fmaxf(l0, l1), l2);
            float a0 = __expf(l0 - mx), a1 = __expf(l1 - mx), a2 = __expf(l2 - mx);
            const float rs = 1.0f / (a0 + a1 + a2); a0 *= rs; a1 *= rs; a2 *= rs;
            const u32x2_t o0 = *(const u32x2_t*)(OB + (size_t)m * 768 + c), o1 = *(const u32x2_t*)(OB + (size_t)m * 768 + 256 + c), o2 = *(const u32x2_t*)(OB + (size_t)m * 768 + 512 + c);
            const float v0 = a0 * bflo(o0.x) + a1 * bflo(o1.x) + a2 * bflo(o2.x), v1 = a0 * bfhi(o0.x) + a1 * bfhi(o1.x) + a2 * bfhi(o2.x);
            const float v2 = a0 * bflo(o0.y) + a1 * bflo(o1.y) + a2 * bflo(o2.y), v3 = a0 * bfhi(o0.y) + a1 * bfhi(o1.y) + a2 * bfhi(o2.y);
            o = (unsigned long long)pk2(v0, v1) | ((unsigned long long)pk2(v2, v3) << 32);
        }
        *(GAS unsigned long long*)(AT + (size_t)m * 256 + c) = o;
    }
}

__device__ __forceinline__ void p8_final(Frame& F, const In& I, unsigned char* ws, float* out) {
    const int gw = F.vcu * NWAVES + F.wave, NGW = F.G * NWAVES, lane = F.lane;
    const float* X1 = (const float*)(ws + WS_X1); const float* ss3 = (const float*)(ws + WS_STAT) + 3 * (size_t)MPAD;
    f32x4 nf[4];
#pragma unroll
    for (int j = 0; j < 4; ++j) nf[j] = ((const f32x4*)I.norm_final)[lane + 64 * j];
    for (int m = gw; m < NTOK; m += NGW) {
        const float rs = 1.0f / sqrtf(ss3[m] * (1.0f / DM) + 1e-6f);
        const f32x4* xr = (const f32x4*)(X1 + (size_t)m * DM) + lane;
        f32x4* orow = (f32x4*)(out + (m < NTOK_P ? OFF_Y_P + (size_t)m * DM : OFF_Y_S + (size_t)(m - NTOK_P) * DM)) + lane;
#pragma unroll
        for (int j = 0; j < 4; ++j) orow[64 * j] = xr[64 * j] * rs * nf[j];
    }
}

__global__ void __launch_bounds__(NWAVES * 64, 2) mk_fwd(Args args) {
    extern __shared__ __attribute__((aligned(16))) unsigned char lds[];
    Frame F;
    F.lds = (LAS unsigned char*)lds;
    F.MISC = (volatile LAS unsigned*)(F.lds + MISC_OFF);
    F.tid = threadIdx.x; F.lane = F.tid & 63; F.wave = __builtin_amdgcn_readfirstlane(F.tid >> 6);
    F.G = gridDim.x; { const int bx = blockIdx.x; F.vcu = (F.G % 8 == 0) ? (bx % 8) * (F.G / 8) + bx / 8 : bx; }
    unsigned char* ws = args.ws; float* out = args.out; const In& I = args.in;
    F.ctl = (gu32*)(ws + WS_CTL);
    for (int u = F.tid; u < (LDS_BYTES - LDSCTL_OFF) / 4; u += NWAVES * 64) ((LAS unsigned*)(F.lds + LDSCTL_OFF))[u] = 0u;
    __syncthreads();
    XcdBarrier bar = xcd_barrier_post((unsigned*)(F.ctl + CW_BAR), F.MISC + 8);
#define GRID_BAR() do { xcd_barrier(bar); int t_ = threadIdx.x; asm volatile("" : "+v"(t_)); F.tid = t_; F.lane = t_ & 63; F.wave = __builtin_amdgcn_readfirstlane(t_ >> 6); } while (0)
    const int bx = (int)blockIdx.x;
    bf16* XB = (bf16*)(ws + WS_XB); bf16* Zb = (bf16*)(ws + WS_Z); float* stat = (float*)(ws + WS_STAT);
    float* ss1 = stat + MPAD; float* ss2 = stat + 2 * (size_t)MPAD; float* ss3 = stat + 3 * (size_t)MPAD;

    p0_prologue(F, I, ws);
    GRID_BAR();
    {
        pg8::Gemm g{XB, (const bf16*)(ws + WS_WIN), MPAD, ZC, DM}; pg8::StaticOrder S; S.init(MPAD, ZC, F.G, bx);
        pg8::EpiZ E{Zb, stat, out};
        pg8::gemm_phase<pg8::EpiZ, pg8::StaticOrder, true, true>(F.lds + RING_OFF, g, S, E);
    }
    GRID_BAR();
    p2a_lora_prep(F, I, ws);
    GRID_BAR();
    {
        pg8::Gemm g{(const bf16*)(ws + WS_ALORA), (const bf16*)(ws + WS_WLORA), MPAD, 3072, 256}; pg8::StaticOrder S; S.init(MPAD, 3072, F.G, bx);
        pg8::EpiLora E{(float*)(ws + WS_LW), (bf16*)(ws + WS_AA), (bf16*)(ws + WS_GG), I.decay_w0, I.aaa_a0};
        pg8::gemm_phase<pg8::EpiLora, pg8::StaticOrder, true, true>(F.lds + RING_OFF, g, S, E);
    }
    GRID_BAR();
    {
        LAS float* wl = (LAS float*)(F.lds + RING_OFF + F.wave * 16384);
        const int gwp = bx * NWAVES + F.wave, ngw = F.G * NWAVES;
        for (int item = gwp; item < 1536; item += ngw) attn_sample_item(F, I, ws, item, wl);
        if (bx < 32) { if (F.wave == 0) scan_wave(F, I, ws, out, bx, wl); }
        else { for (int sidx = (bx - 32) * NWAVES + F.wave; sidx < 512; sidx += (F.G - 32) * NWAVES) scan_wave(F, I, ws, out, 32 + sidx, wl); }
        __syncthreads();
        gu32* queue = F.ctl + CW_QUEUE;
        for (;;) {
            if (F.tid == 0) F.MISC[16] = __hip_atomic_fetch_add(queue, 1u, RLX_AGENT);
            __syncthreads();
            const int unit = (int)F.MISC[16];
            __syncthreads();
            if (unit >= 1536) break;
            attn_prompt_unit(F, ws, unit);
        }
    }
    GRID_BAR();
    p2d_attn_merge(F, ws);
    GRID_BAR();
    {
        pg8::Gemm g{(const bf16*)(ws + WS_RO), (const bf16*)(ws + WS_WBR), MPAD, DM, DM}; pg8::StaticOrder S; S.init(MPAD, DM, F.G, bx);
        pg8::EpiGate<false> E{(bf16*)(ws + WS_MIX), Zb, ZGA};
        pg8::gemm_phase<pg8::EpiGate<false>, pg8::StaticOrder, true, true>(F.lds + RING_OFF, g, S, E);
    }
    VM_WAIT(); __syncthreads();
    {
        pg8::Gemm g{(const bf16*)(ws + WS_ATTN), (const bf16*)(ws + WS_WBA), MPAD, DM, 256}; pg8::StaticOrder S; S.init(MPAD, DM, F.G, bx);
        pg8::EpiGate<true> E{(bf16*)(ws + WS_MIX), Zb, ZGB};
        pg8::gemm_phase<pg8::EpiGate<true>, pg8::StaticOrder, true, true>(F.lds + RING_OFF, g, S, E);
    }
    GRID_BAR();
    {
        pg8::Gemm g{(const bf16*)(ws + WS_MIX), (const bf16*)(ws + WS_WOUT), MPAD, DM, DM}; pg8::StaticOrder S; S.init(MPAD, DM, F.G, bx);
        pg8::EpiRes<0> E{(float*)(ws + WS_X1), (bf16*)(ws + WS_X1B), ss1, I.x_prompt, I.x_sample};
        pg8::gemm_phase<pg8::EpiRes<0>, pg8::StaticOrder, true, true>(F.lds + RING_OFF, g, S, E);
    }
    GRID_BAR();
    {
        pg8::Gemm g{(const bf16*)(ws + WS_X1B), (const bf16*)(ws + WS_WFF1), MPAD, DFF, DM}; pg8::StaticOrder S; S.init(MPAD, DFF, F.G, bx);
        pg8::EpiFF1 E{(bf16*)(ws + WS_HDN), ss1};
        pg8::gemm_phase<pg8::EpiFF1, pg8::StaticOrder, true, true>(F.lds + RING_OFF, g, S, E);
    }
    GRID_BAR();
    {
        pg8::Gemm g{(const bf16*)(ws + WS_HDN), (const bf16*)(ws + WS_WFF2), MPAD, DM, DFF}; pg8::StaticOrder S; S.init(MPAD, DM, F.G, bx);
        pg8::EpiRes<1> E{(float*)(ws + WS_X1), (bf16*)(ws + WS_X1B), ss2, nullptr, nullptr};
        pg8::gemm_phase<pg8::EpiRes<1>, pg8::StaticOrder, true, true>(F.lds + RING_OFF, g, S, E);
    }
    GRID_BAR();
    {
        pg8::Gemm g{(const bf16*)(ws + WS_PB), (const bf16*)(ws + WS_WPLE), MPAD, DM, 256}; pg8::StaticOrder S; S.init(MPAD, DM, F.G, bx);
        pg8::EpiT2 E{(bf16*)(ws + WS_T2)};
        pg8::gemm_phase<pg8::EpiT2, pg8::StaticOrder, true, true>(F.lds + RING_OFF, g, S, E);
    }
    VM_WAIT(); __syncthreads();
    {
        pg8::Gemm g{(const bf16*)(ws + WS_X1B), (const bf16*)(ws + WS_WPG), MPAD, DM, DM}; pg8::StaticOrder S; S.init(MPAD, DM, F.G, bx);
        pg8::EpiPle E{(float*)(ws + WS_X1), (const bf16*)(ws + WS_T2), ss2, ss3};
        pg8::gemm_phase<pg8::EpiPle, pg8::StaticOrder, true, true>(F.lds + RING_OFF, g, S, E);
    }
    GRID_BAR();
    p8_final(F, I, ws, out);
#undef GRID_BAR
}

extern "C" void kernel_launch(void* const* d_in, const int* in_sizes, int n_in, void* d_out, int out_size, void* d_ws, size_t ws_size, hipStream_t stream) {
    static int grid = 0;
    if (grid == 0) {
        if (n_in != 32 || (size_t)out_size != OUT_TOTAL || ws_size < WS_END) { fprintf(stderr, "kernel_launch: unexpected shapes: n_in %d out %d ws %zu\n", n_in, out_size, ws_size); grid = -1; return; }
        int dev = 0, cus = 0, per_cu = 0;
        if (hipGetDevice(&dev) != hipSuccess || hipDeviceGetAttribute(&cus, hipDeviceAttributeMultiprocessorCount, dev) != hipSuccess) { fprintf(stderr, "kernel_launch: device query failed\n"); grid = -1; return; }
        if (hipFuncSetAttribute((const void*)mk_fwd, hipFuncAttributeMaxDynamicSharedMemorySize, LDS_BYTES) != hipSuccess) { fprintf(stderr, "kernel_launch: hipFuncSetAttribute failed\n"); grid = -1; return; }
        if (hipOccupancyMaxActiveBlocksPerMultiprocessor(&per_cu, (const void*)mk_fwd, NWAVES * 64, LDS_BYTES) != hipSuccess || per_cu < 1) { fprintf(stderr, "kernel_launch: occupancy query says %d blocks per CU\n", per_cu); per_cu = 1; }
        (void)hipGetLastError();
        grid = cus;
    }
    if (grid < 0) return;
    if (hipMemsetAsync((char*)d_ws + WS_CTL, 0, CTL_ZERO_BYTES, stream) != hipSuccess) { fprintf(stderr, "kernel_launch: memset failed\n"); return; }
    Args a{};
    const float** ip = (const float**)&a.in;
    for (int i = 0; i < 32; ++i) ip[i] = (const float*)d_in[i];
    a.out = (float*)d_out; a.ws = (unsigned char*)d_ws;
    void* kargs[] = {&a};
    hipError_t e = hipLaunchCooperativeKernel((const void*)mk_fwd, dim3(grid), dim3(NWAVES * 64), kargs, LDS_BYTES, stream);
    if (e != hipSuccess) fprintf(stderr, "kernel_launch: cooperative launch failed: %s (grid %d)\n", hipGetErrorString(e), grid);
}
```

```cpp
#include <hip/hip_runtime.h>
#include <cstdio>
#include <cstdint>
__device__ __forceinline__ int mk_lane_id() { unsigned z = 0u; asm volatile("" : "+v"(z)); return (int)__builtin_amdgcn_mbcnt_hi(0xffffffffu, __builtin_amdgcn_mbcnt_lo(0xffffffffu, z)); }
__device__ __forceinline__ int mk_tid(int wave) { return wave * 64 + mk_lane_id(); }
namespace pg8 {
#define PG8_LAS __attribute__((address_space(3)))
typedef unsigned short bf16_t;
typedef short bf16x8 __attribute__((ext_vector_type(8)));
typedef float f32x4 __attribute__((ext_vector_type(4)));
typedef unsigned u32x4 __attribute__((ext_vector_type(4)));
constexpr int BM = 256, BK = 64, HALF = 128, HTB = HALF * BK * 2  , STAGE_BYTES = 8 * HTB, NXCD = 8, WGM = 4, PRE_OFF = STAGE_BYTES + 4096  ;

__host__ __device__ __forceinline__ int lds_byte(int r, int c) { const int st = (r >> 4) * 2 + (c >> 5), rr = r & 15, cc = c & 31, ob = rr * 64 + cc * 2; return st * 1024 + (ob ^ (((ob >> 9) & 1) << 5)); }
__host__ __device__ __forceinline__ void stage_rc(int b, int& R, int& C) { const int st = b / 1024, sb = b % 1024, swz = sb ^ (((sb >> 9) & 1) << 5); R = (st >> 1) * 16 + swz / 64; C = (st & 1) * 32 + (swz % 64) / 2; }
__host__ __device__ __forceinline__ int perm32(int rho) { const int n = rho >> 4, i = rho & 15; return 8 * (i >> 2) + 4 * n + (i & 3); }

struct Unit { int pm, pn; };
struct Gemm { const bf16_t* A; const bf16_t* Bt; int M, N, K; };

struct StaticOrder {
    int nM, nN, nwg, G, c;
    __host__ __device__ void init(int M, int N, int G_, int c_) { nM = M / BM; nN = N / BM; nwg = nM * nN; G = G_; c = c_; }
    __host__ __device__ bool next(int i, Unit& u) const {
        const long L = (long)i * G + c; if (L >= nwg) return false;
        int wgid = (int)L; { const int q = nwg / NXCD, r = nwg % NXCD, xcd = wgid % NXCD, off = wgid / NXCD; wgid = (xcd < r ? xcd * (q + 1) : r * (q + 1) + (xcd - r) * q) + off; }
        const int nig = WGM * nN, gid = wgid / nig, fm = gid * WGM, gsz = (nM - fm) < WGM ? (nM - fm) : WGM;
        u.pm = fm + ((wgid % nig) % gsz); u.pn = (wgid % nig) / gsz; return true;
    }
    __device__ __forceinline__ void a_ready(const Unit&) const {}
    __device__ __forceinline__ void done(const Unit&) const {}
};
struct StaticOrderX {
    StaticOrder base; int nN, nbase, nextra, G, c;
    __host__ __device__ void init(int Mmain, int N, int G_, int c_) { base.init(Mmain, N, G_, c_); nN = N / BM; nbase = base.nwg; nextra = nN; G = G_; c = c_; }
    __host__ __device__ bool next(int i, Unit& u) const {
        const long L = (long)i * G + c;
        if (L < nbase) return base.next(i, u);
        if (L < nbase + nextra) { u.pm = base.nM; u.pn = (int)(L - nbase); return true; }
        return false;
    }
    __device__ __forceinline__ void a_ready(const Unit&) const {}
    __device__ __forceinline__ void done(const Unit&) const {}
};

__device__ __forceinline__ unsigned cvt_pk_bf16(float lo, float hi) { unsigned r; asm volatile("v_cvt_pk_bf16_f32 %0, %1, %2" : "=v"(r) : "v"(lo), "v"(hi)); return r; }
typedef float f32x2 __attribute__((ext_vector_type(2)));
typedef unsigned u32x2 __attribute__((ext_vector_type(2)));
__device__ __forceinline__ float bf_lo(unsigned w) { return __uint_as_float(w << 16); }
__device__ __forceinline__ float bf_hi(unsigned w) { return __uint_as_float(w & 0xffff0000u); }
__device__ __forceinline__ float sigmoidf_(float x) { return __builtin_amdgcn_rcpf(1.0f + __expf(-x)); }

constexpr int NTOK_P = 16384, NTOK = 16512, MPAD = 16640, ZC = 7680;
constexpr size_t OFF_Y_P = 0, OFF_Y_S = 16777216, OFF_KVP0 = 16908288, OFF_KVP1 = 17039360, OFF_KVP2 = 17563648, OFF_WKV_P = 19660800, OFF_SHIFT_P = 19791872,
                 OFF_KVS0 = 19798528, OFF_KVS1 = 19864064, OFF_KVS2 = 19929600, OFF_WKV_S = 19995136, OFF_SHIFT_S = 22092288, OUT_TOTAL = 22198784;

struct EpiZ {
    static constexpr bool PERM = true, AFTER_DRAIN = false; static constexpr int NPRE = 8;
    bf16_t* Z; const float* rstd0; float* out;
    __device__ __forceinline__ const float* pre_base(const Unit& u, int wr) const { return rstd0 + u.pm * BM + wr * 64; }
    __device__ __forceinline__ void operator()(const f32x4 (&acc)[2][2][4][2], const Unit& u, int wr, int wc, int fr, int fq, const PG8_LAS float* pre) const {
        const int pn = u.pn, pm = u.pm;
#pragma unroll
        for (int ai = 0; ai < 2; ++ai)
#pragma unroll
            for (int m = 0; m < 4; ++m) {
                const int row = pm * BM + ai * HALF + wr * 64 + m * 16 + fr;
                const float rs = pre[ai * 64 + m * 16 + fr];
                bf16_t* zrow = Z + (size_t)row * ZC;
#pragma unroll
                for (int bj = 0; bj < 2; ++bj) {
                    const int col = pn * BM + bj * HALF + wc * 32 + 8 * fq;
                    const f32x4 v0 = acc[ai][bj][m][0] * rs, v1 = acc[ai][bj][m][1] * rs;
                    u32x4 w; w.x = cvt_pk_bf16(v0[0], v0[1]); w.y = cvt_pk_bf16(v0[2], v0[3]); w.z = cvt_pk_bf16(v1[0], v1[1]); w.w = cvt_pk_bf16(v1[2], v1[3]);
                    *(u32x4*)(zrow + col) = w;
                }
            }
    }
};

struct EpiLora {
    static constexpr bool PERM = true, AFTER_DRAIN = false; static constexpr int NPRE = 0;
    bf16_t* LW; bf16_t* AA; bf16_t* GG; const float* w0; const float* a0;
    __device__ __forceinline__ void operator()(const f32x4 (&acc)[2][2][4][2], const Unit& u, int wr, int wc, int fr, int fq) const {
        const int pn = u.pn;
        if (pn < 4) {
#pragma unroll
            for (int ai = 0; ai < 2; ++ai)
#pragma unroll
                for (int m = 0; m < 4; ++m) {
                    const int row = u.pm * BM + ai * HALF + wr * 64 + m * 16 + fr;
#pragma unroll
                    for (int bj = 0; bj < 2; ++bj) {
                        const int col = pn * BM + bj * HALF + wc * 32 + 8 * fq;
                        f32x4 v0 = acc[ai][bj][m][0], v1 = acc[ai][bj][m][1];
                        const f32x4 b0 = *(const f32x4*)(w0 + col), b1 = *(const f32x4*)(w0 + col + 4);
#pragma unroll
                        for (int i = 0; i < 4; ++i) { v0[i] = -0.60653065971f * sigmoidf_(v0[i] + b0[i]); v1[i] = -0.60653065971f * sigmoidf_(v1[i] + b1[i]); }
                        u32x4 w; w.x = cvt_pk_bf16(v0[0], v0[1]); w.y = cvt_pk_bf16(v0[2], v0[3]); w.z = cvt_pk_bf16(v1[0], v1[1]); w.w = cvt_pk_bf16(v1[2], v1[3]);
                        *(u32x4*)(LW + (size_t)row * 1024 + col) = w;
                    }
                }
        } else if (pn < 8) {
#pragma unroll
            for (int ai = 0; ai < 2; ++ai)
#pragma unroll
                for (int m = 0; m < 4; ++m) {
                    const int row = u.pm * BM + ai * HALF + wr * 64 + m * 16 + fr;
#pragma unroll
                    for (int bj = 0; bj < 2; ++bj) {
                        const int col = (pn - 4) * BM + bj * HALF + wc * 32 + 8 * fq;
                        f32x4 v0 = acc[ai][bj][m][0], v1 = acc[ai][bj][m][1];
                        const f32x4 b0 = *(const f32x4*)(a0 + col), b1 = *(const f32x4*)(a0 + col + 4);
#pragma unroll
                        for (int i = 0; i < 4; ++i) { v0[i] = sigmoidf_(v0[i] + b0[i]); v1[i] = sigmoidf_(v1[i] + b1[i]); }
                        u32x4 w; w.x = cvt_pk_bf16(v0[0], v0[1]); w.y = cvt_pk_bf16(v0[2], v0[3]); w.z = cvt_pk_bf16(v1[0], v1[1]); w.w = cvt_pk_bf16(v1[2], v1[3]);
                        *(u32x4*)(AA + (size_t)row * 1024 + col) = w;
                    }
                }
        } else {
#pragma unroll
            for (int ai = 0; ai < 2; ++ai)
#pragma unroll
                for (int m = 0; m < 4; ++m) {
                    const int row = u.pm * BM + ai * HALF + wr * 64 + m * 16 + fr;
#pragma unroll
                    for (int bj = 0; bj < 2; ++bj) {
                        const int col = (pn - 8) * BM + bj * HALF + wc * 32 + 8 * fq;
                        const f32x4 v0 = acc[ai][bj][m][0], v1 = acc[ai][bj][m][1];
                        u32x4 w; w.x = cvt_pk_bf16(v0[0], v0[1]); w.y = cvt_pk_bf16(v0[2], v0[3]); w.z = cvt_pk_bf16(v1[0], v1[1]); w.w = cvt_pk_bf16(v1[2], v1[3]);
                        *(u32x4*)(GG + (size_t)row * 1024 + col) = w;
                    }
                }
        }
    }
    __device__ __forceinline__ void mini(int row, int col, f32x4 v0, f32x4 v1, int lane) const {
        const int blk = col >> 10, c = col & 1023;
        if (blk < 2) {
            const long long boff = blk == 0 ? 0ll : (long long)((const char*)a0 - (const char*)w0);
            const float* bp = (const float*)((const char*)w0 + boff) + c;
            const f32x4 b0 = *(const f32x4*)bp, b1 = *(const f32x4*)(bp + 4);
            const float sc = blk == 0 ? -0.60653065971f : 1.0f;
#pragma unroll
            for (int i = 0; i < 4; ++i) { v0[i] = sc * sigmoidf_(v0[i] + b0[i]); v1[i] = sc * sigmoidf_(v1[i] + b1[i]); }
        }
        u32x4 w; w.x = cvt_pk_bf16(v0[0], v0[1]); w.y = cvt_pk_bf16(v0[2], v0[3]); w.z = cvt_pk_bf16(v1[0], v1[1]); w.w = cvt_pk_bf16(v1[2], v1[3]);
        const long long ooff = blk == 0 ? 0ll : (blk == 1 ? (long long)((const char*)AA - (const char*)LW) : (long long)((const char*)GG - (const char*)LW));
        *(u32x4*)((char*)LW + ooff + ((size_t)row * 1024 + c) * 2) = w;
    }
};

template <bool ADD> struct EpiGate {
    static constexpr bool PERM = true, AFTER_DRAIN = false; static constexpr int NPRE = 0;
    bf16_t* MIX; const bf16_t* Z; int gate_off;
    __device__ __forceinline__ void operator()(const f32x4 (&acc)[2][2][4][2], const Unit& u, int wr, int wc, int fr, int fq) const {
#pragma unroll
        for (int ai = 0; ai < 2; ++ai)
#pragma unroll
            for (int m = 0; m < 4; ++m) {
                const int row = u.pm * BM + ai * HALF + wr * 64 + m * 16 + fr;
#pragma unroll
                for (int bj = 0; bj < 2; ++bj) {
                    const int col = u.pn * BM + bj * HALF + wc * 32 + 8 * fq;
                    const u32x4 gz = *(const u32x4*)(Z + (size_t)row * ZC + gate_off + col);
                    f32x4 v0 = acc[ai][bj][m][0], v1 = acc[ai][bj][m][1];
                    v0[0] *= sigmoidf_(bf_lo(gz.x)); v0[1] *= sigmoidf_(bf_hi(gz.x)); v0[2] *= sigmoidf_(bf_lo(gz.y)); v0[3] *= sigmoidf_(bf_hi(gz.y));
                    v1[0] *= sigmoidf_(bf_lo(gz.z)); v1[1] *= sigmoidf_(bf_hi(gz.z)); v1[2] *= sigmoidf_(bf_lo(gz.w)); v1[3] *= sigmoidf_(bf_hi(gz.w));
                    bf16_t* d = MIX + (size_t)row * 1024 + col;
                    if (ADD) { const u32x4 o = *(const u32x4*)d;
                        v0[0] += bf_lo(o.x); v0[1] += bf_hi(o.x); v0[2] += bf_lo(o.y); v0[3] += bf_hi(o.y);
                        v1[0] += bf_lo(o.z); v1[1] += bf_hi(o.z); v1[2] += bf_lo(o.w); v1[3] += bf_hi(o.w); }
                    u32x4 w; w.x = cvt_pk_bf16(v0[0], v0[1]); w.y = cvt_pk_bf16(v0[2], v0[3]); w.z = cvt_pk_bf16(v1[0], v1[1]); w.w = cvt_pk_bf16(v1[2], v1[3]);
                    *(u32x4*)d = w;
                }
            }
    }
    __device__ __forceinline__ void mini(int row, int col, f32x4 v0, f32x4 v1, int lane) const {
        const u32x4 gz = *(const u32x4*)(Z + (size_t)row * ZC + gate_off + col);
        v0[0] *= sigmoidf_(bf_lo(gz.x)); v0[1] *= sigmoidf_(bf_hi(gz.x)); v0[2] *= sigmoidf_(bf_lo(gz.y)); v0[3] *= sigmoidf_(bf_hi(gz.y));
        v1[0] *= sigmoidf_(bf_lo(gz.z)); v1[1] *= sigmoidf_(bf_hi(gz.z)); v1[2] *= sigmoidf_(bf_lo(gz.w)); v1[3] *= sigmoidf_(bf_hi(gz.w));
        bf16_t* d = MIX + (size_t)row * 1024 + col;
        if (ADD) { const u32x4 o = *(const u32x4*)d;
            v0[0] += bf_lo(o.x); v0[1] += bf_hi(o.x); v0[2] += bf_lo(o.y); v0[3] += bf_hi(o.y);
            v1[0] += bf_lo(o.z); v1[1] += bf_hi(o.z); v1[2] += bf_lo(o.w); v1[3] += bf_hi(o.w); }
        u32x4 w; w.x = cvt_pk_bf16(v0[0], v0[1]); w.y = cvt_pk_bf16(v0[2], v0[3]); w.z = cvt_pk_bf16(v1[0], v1[1]); w.w = cvt_pk_bf16(v1[2], v1[3]);
        *(u32x4*)d = w;
    }
};

template <int SRC> struct EpiRes {
    static constexpr bool PERM = true, AFTER_DRAIN = false; static constexpr int NPRE = 0;
    bf16_t* XB; float* ss; const float* xp; const float* xs;
    __device__ __forceinline__ float core(int row, int col, f32x4 v0, f32x4 v1) const {
        bf16_t* d = XB + (size_t)row * 1024 + col;
        if (SRC == 0) { const float* brow = (row < NTOK_P ? xp + (size_t)row * 1024 : xs + (size_t)(row - NTOK_P) * 1024) + col; v0 += *(const f32x4*)brow; v1 += *(const f32x4*)(brow + 4); }
        else { const u32x4 o = *(const u32x4*)d; v0[0] += bf_lo(o.x); v0[1] += bf_hi(o.x); v0[2] += bf_lo(o.y); v0[3] += bf_hi(o.y); v1[0] += bf_lo(o.z); v1[1] += bf_hi(o.z); v1[2] += bf_lo(o.w); v1[3] += bf_hi(o.w); }
        u32x4 w; w.x = cvt_pk_bf16(v0[0], v0[1]); w.y = cvt_pk_bf16(v0[2], v0[3]); w.z = cvt_pk_bf16(v1[0], v1[1]); w.w = cvt_pk_bf16(v1[2], v1[3]);
        *(u32x4*)d = w;
        return ((v0[0] * v0[0] + v0[1] * v0[1]) + (v0[2] * v0[2] + v0[3] * v0[3])) + ((v1[0] * v1[0] + v1[1] * v1[1]) + (v1[2] * v1[2] + v1[3] * v1[3]));
    }
    __device__ __forceinline__ void operator()(const f32x4 (&acc)[2][2][4][2], const Unit& u, int wr, int wc, int fr, int fq) const {
#pragma unroll
        for (int ai = 0; ai < 2; ++ai)
#pragma unroll
            for (int m = 0; m < 4; ++m) {
                const int row = u.pm * BM + ai * HALF + wr * 64 + m * 16 + fr;
                float q = 0.f;
#pragma unroll
                for (int bj = 0; bj < 2; ++bj) q += core(row, u.pn * BM + bj * HALF + wc * 32 + 8 * fq, acc[ai][bj][m][0], acc[ai][bj][m][1]);
                q += __shfl_xor(q, 16); q += __shfl_xor(q, 32);
                if (fq == 0) atomicAdd(ss + row, q);
            }
    }
    __device__ __forceinline__ void mini(int row, int col, f32x4 v0, f32x4 v1, int lane) const {
        float q = core(row, col, v0, v1);
        q += __shfl_xor(q, 1); q += __shfl_xor(q, 2);
        if ((lane & 3) == 0) atomicAdd(ss + row, q);
    }
};

struct EpiFF1 {
    static constexpr bool PERM = true, AFTER_DRAIN = false; static constexpr int NPRE = 8;
    bf16_t* H; const float* ss;
    __device__ __forceinline__ const float* pre_base(const Unit& u, int wr) const { return ss + u.pm * BM + wr * 64; }
    __device__ __forceinline__ void operator()(const f32x4 (&acc)[2][2][4][2], const Unit& u, int wr, int wc, int fr, int fq, const PG8_LAS float* pre) const {
#pragma unroll
        for (int ai = 0; ai < 2; ++ai)
#pragma unroll
            for (int m = 0; m < 4; ++m) {
                const int row = u.pm * BM + ai * HALF + wr * 64 + m * 16 + fr;
                const float rs = __builtin_amdgcn_rsqf(pre[ai * 64 + m * 16 + fr] * (1.0f / 1024.0f) + 1e-6f);
#pragma unroll
                for (int bj = 0; bj < 2; ++bj) {
                    const int col = u.pn * BM + bj * HALF + wc * 32 + 8 * fq;
                    f32x4 v0 = acc[ai][bj][m][0] * rs, v1 = acc[ai][bj][m][1] * rs;
#pragma unroll
                    for (int i = 0; i < 4; ++i) { const float a = fmaxf(v0[i], 0.f), b = fmaxf(v1[i], 0.f); v0[i] = a * a; v1[i] = b * b; }
                    u32x4 w; w.x = cvt_pk_bf16(v0[0], v0[1]); w.y = cvt_pk_bf16(v0[2], v0[3]); w.z = cvt_pk_bf16(v1[0], v1[1]); w.w = cvt_pk_bf16(v1[2], v1[3]);
                    *(u32x4*)(H + (size_t)row * 4096 + col) = w;
                }
            }
    }
    __device__ __forceinline__ void mini(int row, int col, f32x4 v0, f32x4 v1, int lane) const {
        const float rs = __builtin_amdgcn_rsqf(ss[row] * (1.0f / 1024.0f) + 1e-6f);
        v0 = v0 * rs; v1 = v1 * rs;
#pragma unroll
        for (int i = 0; i < 4; ++i) { const float a = fmaxf(v0[i], 0.f), b = fmaxf(v1[i], 0.f); v0[i] = a * a; v1[i] = b * b; }
        u32x4 w; w.x = cvt_pk_bf16(v0[0], v0[1]); w.y = cvt_pk_bf16(v0[2], v0[3]); w.z = cvt_pk_bf16(v1[0], v1[1]); w.w = cvt_pk_bf16(v1[2], v1[3]);
        *(u32x4*)(H + (size_t)row * 4096 + col) = w;
    }
};

struct EpiT2 {
    static constexpr bool PERM = true, AFTER_DRAIN = false; static constexpr int NPRE = 0;
    bf16_t* T2;
    __device__ __forceinline__ void core(int row, int col, f32x4 v0, f32x4 v1) const {
        u32x4 w; w.x = cvt_pk_bf16(v0[0], v0[1]); w.y = cvt_pk_bf16(v0[2], v0[3]); w.z = cvt_pk_bf16(v1[0], v1[1]); w.w = cvt_pk_bf16(v1[2], v1[3]);
        *(u32x4*)(T2 + (size_t)row * 1024 + col) = w;
    }
    __device__ __forceinline__ void operator()(const f32x4 (&acc)[2][2][4][2], const Unit& u, int wr, int wc, int fr, int fq) const {
#pragma unroll
        for (int ai = 0; ai < 2; ++ai)
#pragma unroll
            for (int m = 0; m < 4; ++m) {
                const int row = u.pm * BM + ai * HALF + wr * 64 + m * 16 + fr;
#pragma unroll
                for (int bj = 0; bj < 2; ++bj) core(row, u.pn * BM + bj * HALF + wc * 32 + 8 * fq, acc[ai][bj][m][0], acc[ai][bj][m][1]);
            }
    }
    __device__ __forceinline__ void mini(int row, int col, f32x4 v0, f32x4 v1, int lane) const { core(row, col, v0, v1); }
};

struct EpiPle {
    static constexpr bool PERM = true, AFTER_DRAIN = false; static constexpr int NPRE = 0;
    const bf16_t* XB; bf16_t* X3; const bf16_t* T2; const float* ss2; float* ss3;
    __device__ __forceinline__ float core(int row, int col, f32x4 v0, f32x4 v1, float rs) const {
        const u32x4 t = *(const u32x4*)(T2 + (size_t)row * 1024 + col), b = *(const u32x4*)(XB + (size_t)row * 1024 + col);
        v0 = v0 * rs; v1 = v1 * rs;
        f32x4 a0, a1;
        a0[0] = bf_lo(b.x) + sigmoidf_(v0[0]) * bf_lo(t.x); a0[1] = bf_hi(b.x) + sigmoidf_(v0[1]) * bf_hi(t.x); a0[2] = bf_lo(b.y) + sigmoidf_(v0[2]) * bf_lo(t.y); a0[3] = bf_hi(b.y) + sigmoidf_(v0[3]) * bf_hi(t.y);
        a1[0] = bf_lo(b.z) + sigmoidf_(v1[0]) * bf_lo(t.z); a1[1] = bf_hi(b.z) + sigmoidf_(v1[1]) * bf_hi(t.z); a1[2] = bf_lo(b.w) + sigmoidf_(v1[2]) * bf_lo(t.w); a1[3] = bf_hi(b.w) + sigmoidf_(v1[3]) * bf_hi(t.w);
        u32x4 w; w.x = cvt_pk_bf16(a0[0], a0[1]); w.y = cvt_pk_bf16(a0[2], a0[3]); w.z = cvt_pk_bf16(a1[0], a1[1]); w.w = cvt_pk_bf16(a1[2], a1[3]);
        *(u32x4*)(X3 + (size_t)row * 1024 + col) = w;
        return ((a0[0] * a0[0] + a0[1] * a0[1]) + (a0[2] * a0[2] + a0[3] * a0[3])) + ((a1[0] * a1[0] + a1[1] * a1[1]) + (a1[2] * a1[2] + a1[3] * a1[3]));
    }
    __device__ __forceinline__ void operator()(const f32x4 (&acc)[2][2][4][2], const Unit& u, int wr, int wc, int fr, int fq) const {
#pragma unroll
        for (int ai = 0; ai < 2; ++ai)
#pragma unroll
            for (int m = 0; m < 4; ++m) {
                const int row = u.pm * BM + ai * HALF + wr * 64 + m * 16 + fr;
                const float rs = __builtin_amdgcn_rsqf(ss2[row] * (1.0f / 1024.0f) + 1e-6f);
                float q = 0.f;
#pragma unroll
                for (int bj = 0; bj < 2; ++bj) q += core(row, u.pn * BM + bj * HALF + wc * 32 + 8 * fq, acc[ai][bj][m][0], acc[ai][bj][m][1], rs);
                q += __shfl_xor(q, 16); q += __shfl_xor(q, 32);
                if (fq == 0) atomicAdd(ss3 + row, q);
            }
    }
    __device__ __forceinline__ void mini(int row, int col, f32x4 v0, f32x4 v1, int lane) const {
        const float rs = __builtin_amdgcn_rsqf(ss2[row] * (1.0f / 1024.0f) + 1e-6f);
        float q = core(row, col, v0, v1, rs);
        q += __shfl_xor(q, 1); q += __shfl_xor(q, 2);
        if ((lane & 3) == 0) atomicAdd(ss3 + row, q);
    }
};

template <class Epi, int KT, int NU>
__device__ __forceinline__ void mini_gemm_nu(int wave_idx, PG8_LAS unsigned char* lds, const bf16_t* A, const bf16_t* Bt, int N, int row_base, int first, int stride, const Epi& E) {
    int tid_ = mk_tid(wave_idx); asm volatile("" : "+v"(tid_));
    const int tid = tid_, w = __builtin_amdgcn_readfirstlane(tid >> 6), lane = tid & 63, r = lane & 15, q = lane >> 4;
    constexpr int KW = KT / 8, NKS = KW / 32, NBK = (NU * NKS <= 8) ? NKS : (8 / NU >= 1 ? 8 / NU : 1);
    static_assert(NKS % NBK == 0, "mini_gemm_nu: batch must divide the k-steps");
    PG8_LAS float* red = (PG8_LAS float*)lds;
    const int nunits = (N / 32) * 8;
    for (int u0 = first; u0 < nunits; u0 += NU * stride) {
        f32x4 acc0[NU], acc1[NU];
#pragma unroll
        for (int j = 0; j < NU; ++j) { acc0[j] = (f32x4){0.f, 0.f, 0.f, 0.f}; acc1[j] = (f32x4){0.f, 0.f, 0.f, 0.f}; }
#pragma unroll
        for (int k0 = 0; k0 < NKS; k0 += NBK) {
            bf16x8 af[NU][NBK], b0[NU][NBK], b1[NU][NBK];
#pragma unroll
            for (int j = 0; j < NU; ++j) { const int u = u0 + j * stride;
                if (u < nunits) { const int n0 = (u >> 3) * 32, r0 = row_base + 16 * (u & 7);
                    const bf16_t* ap = A + (size_t)(r0 + r) * KT + w * KW + 8 * q; const bf16_t* bp = Bt + (size_t)(n0 + r) * KT + w * KW + 8 * q;
#pragma unroll
                    for (int i = 0; i < NBK; ++i) { af[j][i] = *(const bf16x8*)(ap + 32 * (k0 + i)); b0[j][i] = *(const bf16x8*)(bp + 32 * (k0 + i)); b1[j][i] = *(const bf16x8*)(bp + (size_t)16 * KT + 32 * (k0 + i)); } } }
#pragma unroll
            for (int j = 0; j < NU; ++j) { if (u0 + j * stride < nunits) {
#pragma unroll
                for (int i = 0; i < NBK; ++i) { acc0[j] = __builtin_amdgcn_mfma_f32_16x16x32_bf16(af[j][i], b0[j][i], acc0[j], 0, 0, 0); acc1[j] = __builtin_amdgcn_mfma_f32_16x16x32_bf16(af[j][i], b1[j][i], acc1[j], 0, 0, 0); } } }
        }
#pragma unroll
        for (int j = 0; j < NU; ++j) { if (u0 + j * stride < nunits) {
#pragma unroll
            for (int rg = 0; rg < 4; ++rg) { red[((j * 8 + w) * 16 + 4 * q + rg) * 32 + r] = acc0[j][rg]; red[((j * 8 + w) * 16 + 4 * q + rg) * 32 + 16 + r] = acc1[j][rg]; } } }
        __syncthreads();
        if (w < NU && u0 + w * stride < nunits) {
            const int u = u0 + w * stride, n0 = (u >> 3) * 32, r0 = row_base + 16 * (u & 7);
            const int row = lane >> 2, c8 = (lane & 3) * 8;
            f32x4 v0 = (f32x4){0.f, 0.f, 0.f, 0.f}, v1 = (f32x4){0.f, 0.f, 0.f, 0.f};
#pragma unroll
            for (int ww = 0; ww < 8; ++ww) { const PG8_LAS f32x4* p = (const PG8_LAS f32x4*)(red + ((w * 8 + ww) * 16 + row) * 32 + c8); v0 += p[0]; v1 += p[1]; }
            E.mini(r0 + row, n0 + c8, v0, v1, lane);
        }
        __syncthreads();
    }
}
template <class Epi, int KT>
__device__ __forceinline__ void mini_gemm(int wave_idx, PG8_LAS unsigned char* lds, const bf16_t* A, const bf16_t* Bt, int N, int row_base, int first, int stride, const Epi& E) {
    int tid_ = mk_tid(wave_idx); asm volatile("" : "+v"(tid_));
    const int tid = tid_, w = __builtin_amdgcn_readfirstlane(tid >> 6), lane = tid & 63, r = lane & 15, q = lane >> 4;
    constexpr int KW = KT / 8, NKS = KW / 32, NB = NKS < 8 ? NKS : 8;
    PG8_LAS float* red = (PG8_LAS float*)lds;
    const int nunits = (N / 32) * 8;
    for (int u = first; u < nunits; u += stride) {
        const int n0 = (u >> 3) * 32, r0 = row_base + 16 * (u & 7);
        f32x4 acc0 = (f32x4){0.f, 0.f, 0.f, 0.f}, acc1 = (f32x4){0.f, 0.f, 0.f, 0.f};
        const bf16_t* ap = A + (size_t)(r0 + r) * KT + w * KW + 8 * q;
        const bf16_t* bp = Bt + (size_t)(n0 + r) * KT + w * KW + 8 * q;
#pragma unroll
        for (int k0 = 0; k0 < NKS; k0 += NB) {
            bf16x8 af[NB], b0[NB], b1[NB];
#pragma unroll
            for (int i = 0; i < NB; ++i) { af[i] = *(const bf16x8*)(ap + 32 * (k0 + i)); b0[i] = *(const bf16x8*)(bp + 32 * (k0 + i)); b1[i] = *(const bf16x8*)(bp + (size_t)16 * KT + 32 * (k0 + i)); }
#pragma unroll
            for (int i = 0; i < NB; ++i) { acc0 = __builtin_amdgcn_mfma_f32_16x16x32_bf16(af[i], b0[i], acc0, 0, 0, 0); acc1 = __builtin_amdgcn_mfma_f32_16x16x32_bf16(af[i], b1[i], acc1, 0, 0, 0); }
        }
#pragma unroll
        for (int rg = 0; rg < 4; ++rg) { red[(w * 16 + 4 * q + rg) * 32 + r] = acc0[rg]; red[(w * 16 + 4 * q + rg) * 32 + 16 + r] = acc1[rg]; }
        __syncthreads();
        if (tid < 64) {
            const int row = tid >> 2, c8 = (tid & 3) * 8;
            f32x4 v0 = (f32x4){0.f, 0.f, 0.f, 0.f}, v1 = (f32x4){0.f, 0.f, 0.f, 0.f};
#pragma unroll
            for (int ww = 0; ww < 8; ++ww) { const PG8_LAS f32x4* p = (const PG8_LAS f32x4*)(red + (ww * 16 + row) * 32 + c8); v0 += p[0]; v1 += p[1]; }
            E.mini(r0 + row, n0 + c8, v0, v1, lane);
        }
        __syncthreads();
    }
}
template <class Epi, class Sched, bool ALIGN_EPI = false, bool SP2 = false>
__device__ __forceinline__ void gemm_phase(int wave_idx, PG8_LAS unsigned char* lds, const Gemm g, const Sched& S, const Epi& E) {
    int tid_ = mk_tid(wave_idx); asm volatile("" : "+v"(tid_));
    const int tid = tid_, wid = __builtin_amdgcn_readfirstlane(tid >> 6), lane = tid & 63, wr = wid >> 2, wc = wid & 3, fr = lane & 15, fq = lane >> 4;
    int K_ = g.K; asm volatile("" : "+s"(K_));
    const int K = K_, nt = K / BK;
    unsigned voffA[2], voffB[2];
#pragma unroll
    for (int i = 0; i < 2; ++i) { int R, C; stage_rc(tid * 16 + i * 8192, R, C); const int Rb = Epi::PERM ? ((R & ~31) + perm32(R & 31)) : R;
        voffA[i] = (unsigned)(R * K + C) * 2u; voffB[i] = (unsigned)(Rb * K + C) * 2u; }
    const size_t kstep = (size_t)(BK * 2);
    const size_t hstep = (size_t)HALF * K * 2;
    const size_t tstep = 2 * hstep;
    const unsigned ldsw = (unsigned)wid * 1024u;
    const int aoff = lds_byte(wr * 64 + fr, fq * 8), boff = lds_byte(wc * 32 + fr, fq * 8);
#define PG8_SA(b, h) (((b) * 2 + (h)) * HTB)
#define PG8_SB(b, h) ((4 + (b) * 2 + (h)) * HTB)
#define PG8_STAGE(bufoff, gbase, voff) do { _Pragma("unroll") for (int _i = 0; _i < 2; ++_i) \
        __builtin_amdgcn_global_load_lds((const unsigned*)((const char*)(gbase) + (voff)[_i]), (PG8_LAS unsigned*)(lds + (bufoff) + ldsw + _i * 8192), 16, 0, 0); } while (0)
#define PG8_LDA(dst, b, h) do { _Pragma("unroll") for (int m = 0; m < 4; ++m) _Pragma("unroll") for (int k = 0; k < 2; ++k) dst[m][k] = *(const PG8_LAS bf16x8*)(lds + PG8_SA(b, h) + aoff + m * 2048 + k * 1024); } while (0)
#define PG8_LDB(dst, b, h) do { _Pragma("unroll") for (int n = 0; n < 2; ++n) _Pragma("unroll") for (int k = 0; k < 2; ++k) dst[n][k] = *(const PG8_LAS bf16x8*)(lds + PG8_SB(b, h) + boff + n * 2048 + k * 1024); } while (0)
#define PG8_MMA(ai, bj, At, Bt) do { __builtin_amdgcn_s_setprio(1); _Pragma("unroll") for (int m = 0; m < 4; ++m) _Pragma("unroll") for (int n = 0; n < 2; ++n) _Pragma("unroll") for (int k = 0; k < 2; ++k) \
        acc[ai][bj][m][n] = __builtin_amdgcn_mfma_f32_16x16x32_bf16(Bt[n][k], At[m][k], acc[ai][bj][m][n], 0, 0, 0); __builtin_amdgcn_s_setprio(0); } while (0)
#define PG8_WAIT_V(n) asm volatile("s_waitcnt vmcnt(" #n ")" ::: "memory")
#define PG8_WAIT_L(n) asm volatile("s_waitcnt lgkmcnt(" #n ")" ::: "memory")
#define PG8_BAR __builtin_amdgcn_s_barrier()
#define PG8_SCHED __builtin_amdgcn_sched_barrier(0)
    Unit cur, nxt; int ui = 0;
    if (!S.next(0, cur)) return;
    f32x4 acc[2][2][4][2];
#pragma unroll
    for (int a = 0; a < 2; ++a)
#pragma unroll
        for (int b = 0; b < 2; ++b)
#pragma unroll
            for (int m = 0; m < 4; ++m)
#pragma unroll
                for (int n = 0; n < 2; ++n) acc[a][b][m][n] = (f32x4){0.f, 0.f, 0.f, 0.f};
    bf16x8 At[4][2], B0[2][2], B1[2][2];
    const char* cA = (const char*)g.A + (size_t)cur.pm * tstep; const char* cB = (const char*)g.Bt + (size_t)cur.pn * tstep;
    S.a_ready(cur);
    if constexpr (SP2) {
        PG8_STAGE(PG8_SB(0, 0), cB, voffB); PG8_STAGE(PG8_SB(0, 1), cB + hstep, voffB); PG8_STAGE(PG8_SA(0, 0), cA, voffA); PG8_STAGE(PG8_SA(0, 1), cA + hstep, voffA);
        if (wr == 1) PG8_BAR;
        PG8_WAIT_V(2); PG8_BAR;
        PG8_STAGE(PG8_SB(1, 0), cB + kstep, voffB); PG8_STAGE(PG8_SA(1, 0), cA + kstep, voffA); PG8_STAGE(PG8_SB(1, 1), cB + hstep + kstep, voffB);
        PG8_WAIT_V(6); PG8_BAR;
    } else {
        PG8_STAGE(PG8_SB(0, 0), cB, voffB); PG8_STAGE(PG8_SA(0, 0), cA, voffA); PG8_STAGE(PG8_SB(0, 1), cB + hstep, voffB); PG8_STAGE(PG8_SA(0, 1), cA + hstep, voffA);
        if (wr == 1) PG8_BAR;
        PG8_WAIT_V(4); PG8_BAR;
        PG8_STAGE(PG8_SB(1, 0), cB + kstep, voffB); PG8_STAGE(PG8_SA(1, 0), cA + kstep, voffA); PG8_STAGE(PG8_SB(1, 1), cB + hstep + kstep, voffB);
        PG8_WAIT_V(6); PG8_BAR;
    }
    for (;;) {
        const bool has_next = S.next(ui + 1, nxt);
        if constexpr (Epi::NPRE > 0) {
            const float* pp = E.pre_base(cur, wr) + lane;
            __builtin_amdgcn_global_load_lds((const unsigned*)pp, (PG8_LAS unsigned*)(lds + PRE_OFF + wid * 512), 4, 0, 0);
            __builtin_amdgcn_global_load_lds((const unsigned*)(pp + 128), (PG8_LAS unsigned*)(lds + PRE_OFF + wid * 512 + 256), 4, 0, 0);
        }
        const char* nA = has_next ? (const char*)g.A + (size_t)nxt.pm * tstep : cA; const char* nB = has_next ? (const char*)g.Bt + (size_t)nxt.pn * tstep : cB;
        for (int t = 0; t < nt; t += 2) {
            const bool last = (t == nt - 2);
            const char* a1 = cA + (size_t)(t + 1) * kstep;
            const char* a2 = last ? nA : cA + (size_t)(t + 2) * kstep; const char* b2 = last ? nB : cB + (size_t)(t + 2) * kstep;
            const char* a3 = a2 + kstep; const char* b3 = b2 + kstep;
            if (last && has_next) S.a_ready(nxt);
            if constexpr (SP2) {
            PG8_LDB(B0, 0, 0); PG8_LDB(B1, 0, 1); PG8_SCHED; PG8_LDA(At, 0, 0); PG8_STAGE(PG8_SA(1, 1), a1 + hstep, voffA);
            PG8_WAIT_V(8); PG8_WAIT_L(0); PG8_BAR; PG8_MMA(0, 0, At, B0); PG8_MMA(0, 1, At, B1); PG8_BAR; PG8_SCHED;
            PG8_LDA(At, 0, 1); PG8_STAGE(PG8_SB(0, 0), b2, voffB); PG8_STAGE(PG8_SB(0, 1), b2 + hstep, voffB); PG8_STAGE(PG8_SA(0, 0), a2, voffA);
            PG8_WAIT_V(8); PG8_WAIT_L(0); PG8_BAR; PG8_MMA(1, 0, At, B0); PG8_MMA(1, 1, At, B1); PG8_BAR; PG8_SCHED;
            PG8_LDB(B0, 1, 0); PG8_LDB(B1, 1, 1); PG8_SCHED; PG8_LDA(At, 1, 0); PG8_STAGE(PG8_SA(0, 1), a2 + hstep, voffA);
            PG8_WAIT_V(8); PG8_WAIT_L(0); PG8_BAR; PG8_MMA(0, 0, At, B0); PG8_MMA(0, 1, At, B1); PG8_BAR; PG8_SCHED;
            PG8_LDA(At, 1, 1); PG8_STAGE(PG8_SB(1, 0), b3, voffB); PG8_STAGE(PG8_SB(1, 1), b3 + hstep, voffB); PG8_STAGE(PG8_SA(1, 0), a3, voffA);
            PG8_WAIT_V(8); PG8_WAIT_L(0); PG8_BAR; PG8_MMA(1, 0, At, B0); PG8_MMA(1, 1, At, B1); PG8_BAR; PG8_SCHED;
            } else {
            PG8_LDB(B0, 0, 0); PG8_SCHED; PG8_LDA(At, 0, 0); PG8_STAGE(PG8_SA(1, 1), a1 + hstep, voffA);
            PG8_WAIT_L(8); PG8_BAR; PG8_WAIT_L(0); PG8_MMA(0, 0, At, B0); PG8_BAR; PG8_SCHED;
            PG8_LDB(B1, 0, 1); PG8_STAGE(PG8_SB(0, 0), b2, voffB);
            PG8_BAR; PG8_WAIT_L(0); PG8_MMA(0, 1, At, B1); PG8_BAR;
            PG8_LDA(At, 0, 1); PG8_STAGE(PG8_SA(0, 0), a2, voffA);
            PG8_BAR; PG8_WAIT_L(0); PG8_MMA(1, 0, At, B0); PG8_BAR; PG8_SCHED;
            PG8_STAGE(PG8_SB(0, 1), b2 + hstep, voffB);
            PG8_WAIT_V(6); PG8_BAR; PG8_MMA(1, 1, At, B1); PG8_BAR;
            PG8_LDB(B0, 1, 0); PG8_SCHED; PG8_LDA(At, 1, 0); PG8_STAGE(PG8_SA(0, 1), a2 + hstep, voffA);
            PG8_WAIT_L(8); PG8_BAR; PG8_WAIT_L(0); PG8_MMA(0, 0, At, B0); PG8_BAR; PG8_SCHED;
            PG8_LDB(B1, 1, 1); PG8_STAGE(PG8_SB(1, 0), b3, voffB);
            PG8_BAR; PG8_WAIT_L(0); PG8_MMA(0, 1, At, B1); PG8_BAR;
            PG8_LDA(At, 1, 1); PG8_STAGE(PG8_SA(1, 0), a3, voffA);
            PG8_BAR; PG8_WAIT_L(0); PG8_MMA(1, 0, At, B0); PG8_BAR; PG8_SCHED;
            PG8_STAGE(PG8_SB(1, 1), b3 + hstep, voffB);
            PG8_WAIT_V(6); PG8_BAR; PG8_MMA(1, 1, At, B1); PG8_BAR;
            }
        }
        if constexpr (ALIGN_EPI) { if (wr == 0) PG8_BAR; }
        if constexpr (Epi::NPRE > 0) { E(acc, cur, wr, wc, fr, fq, (const PG8_LAS float*)(lds + PRE_OFF + wid * 512)); S.done(cur); } else
        if constexpr (!Epi::AFTER_DRAIN) { E(acc, cur, wr, wc, fr, fq); S.done(cur); }
        if (!has_next) break;
#pragma unroll
        for (int a = 0; a < 2; ++a)
#pragma unroll
            for (int b = 0; b < 2; ++b)
#pragma unroll
                for (int m = 0; m < 4; ++m)
#pragma unroll
                    for (int n = 0; n < 2; ++n) acc[a][b][m][n] = (f32x4){0.f, 0.f, 0.f, 0.f};
        cur = nxt; cA = nA; cB = nB; ++ui;
        if constexpr (ALIGN_EPI) { if (wr == 1) PG8_BAR; }
    }
    PG8_WAIT_V(0);
    if constexpr (!ALIGN_EPI) { if (wr == 0) PG8_BAR; }
    PG8_BAR;
    if constexpr (Epi::AFTER_DRAIN) { E.fused(acc, cur, wr, wc, fr, fq, lds, wid, lane); S.done(cur); }
#undef PG8_SA
#undef PG8_SB
#undef PG8_STAGE
#undef PG8_LDA
#undef PG8_LDB
#undef PG8_MMA
#undef PG8_WAIT_V
#undef PG8_WAIT_L
#undef PG8_BAR
#undef PG8_SCHED
}
}
#define GAS __attribute__((address_space(1)))
#define LAS __attribute__((address_space(3)))
typedef unsigned short bf16;
typedef unsigned v4u __attribute__((ext_vector_type(4)));
typedef float f32x4 __attribute__((ext_vector_type(4)));
typedef short bf16x8 __attribute__((ext_vector_type(8)));
typedef GAS unsigned gu32;
typedef GAS unsigned long long gu64;
#define RLX_AGENT __ATOMIC_RELAXED, __HIP_MEMORY_SCOPE_AGENT
#define LDS_WAIT() asm volatile("s_waitcnt lgkmcnt(0)" ::: "memory")
#define VM_WAIT() asm volatile("s_waitcnt vmcnt(0)" ::: "memory")
__device__ __forceinline__ unsigned long long rt() { return __builtin_amdgcn_s_memrealtime(); }
__device__ __forceinline__ unsigned f2bf(float f) { unsigned u = __builtin_bit_cast(unsigned, f); return (u + 0x7fffu + ((u >> 16) & 1u)) >> 16; }
typedef float f32x2_cv __attribute__((ext_vector_type(2))); typedef __bf16 bf16x2_cv __attribute__((ext_vector_type(2)));
__device__ __forceinline__ unsigned pk2(float lo, float hi) { const f32x2_cv v = {lo, hi}; return __builtin_bit_cast(unsigned, __builtin_convertvector(v, bf16x2_cv)); }
__device__ __forceinline__ unsigned f2bf_hw(float f) { return pk2(f, f) & 0xffffu; }

#define XB_TMO      128
#define XB_XCNT(j)  (256  + 64 * (j))
#define XB_XSUB(j)  (1280 + 64 * (j))
#define XB_XGEN(j)  (2304 + 64 * (j))
#define XB_TOP      3328
#define XB_TOPGEN   3392
#define XCD_BAR_WORDS 3456
#define XB_SPIN_CAP (1u << 18)

__device__ __forceinline__ unsigned xb_ld(unsigned* p)              { return __hip_atomic_load(p, __ATOMIC_RELAXED, __HIP_MEMORY_SCOPE_AGENT); }
__device__ __forceinline__ unsigned xb_add(unsigned* p, unsigned v) { return __hip_atomic_fetch_add(p, v, __ATOMIC_RELAXED, __HIP_MEMORY_SCOPE_AGENT); }
__device__ __forceinline__ unsigned xb_xcc_id() { return (unsigned)__builtin_amdgcn_s_getreg((3 << 11) | 20) & 0xFu; }
#define XB_SPIN(cond, bar) do { unsigned _sp = 0; while (cond) { __builtin_amdgcn_s_sleep(1); \
    if ((++_sp & 255u) == 0u) { if (xb_ld(&(bar)[XB_TMO])) break; if (_sp > XB_SPIN_CAP) { atomicAdd(&(bar)[XB_TMO], 1u); break; } } } } while (0)

struct XcdBarrier {
    unsigned* bar; unsigned x;
    volatile LAS unsigned* st;
};

__device__ __forceinline__ XcdBarrier xcd_barrier_post(unsigned* bar, volatile LAS unsigned* st) {
    XcdBarrier b; b.bar = bar; b.x = xb_xcc_id(); b.st = st;
    if (threadIdx.x == 0) (void)xb_add(&bar[XB_XCNT(b.x)], 1u);
    return b;
}
__device__ __forceinline__ void xcd_barrier_complete(unsigned* bar, unsigned x, unsigned& nloc, unsigned& nx) {
    const unsigned G = gridDim.x * gridDim.y * gridDim.z;
    unsigned sum, cnt, mine, sp = 0u;
    for (;;) {
        sum = 0u; cnt = 0u; mine = 0u;
#pragma unroll
        for (unsigned j = 0; j < 16; ++j) { const unsigned c = xb_ld(&bar[XB_XCNT(j)]); sum += c; cnt += (c > 0u) ? 1u : 0u; mine = (j == x) ? c : mine; }
        if (sum == G) break;
        __builtin_amdgcn_s_sleep(1);
        if ((++sp & 255u) == 0u) { if (xb_ld(&bar[XB_TMO])) break; if (sp > XB_SPIN_CAP) { atomicAdd(&bar[XB_TMO], 1u); break; } }
    }
    nloc = mine > 0u ? mine : 1u; nx = cnt > 0u ? cnt : 1u;
}

__device__ __forceinline__ void xcd_barrier(const XcdBarrier& b, int tid) {
    asm volatile("s_waitcnt vmcnt(0)" ::: "memory");
    __syncthreads();
    if (tid == 0) {
        unsigned* bar = b.bar;
        __builtin_amdgcn_s_waitcnt(0);
        unsigned nloc = b.st[0], nx = b.st[1];
        if (nloc == 0u) { xcd_barrier_complete(bar, b.x, nloc, nx); b.st[0] = nloc; b.st[1] = nx; }
        const unsigned old = xb_add(&bar[XB_XSUB(b.x)], 1u);
        const unsigned gen = old / nloc;
        if (old + 1u == (gen + 1u) * nloc) {
            __builtin_amdgcn_fence(__ATOMIC_RELEASE, "agent");
            asm volatile("s_waitcnt vmcnt(0)" ::: "memory");
            const unsigned og = xb_add(&bar[XB_TOP], 1u);
            const unsigned tg = og / nx;
            if (og + 1u == (tg + 1u) * nx) xb_add(&bar[XB_TOPGEN], 1u);
            else XB_SPIN(xb_ld(&bar[XB_TOPGEN]) == tg, bar);
            __builtin_amdgcn_fence(__ATOMIC_ACQUIRE, "agent");
            xb_add(&bar[XB_XGEN(b.x)], 1u);
            asm volatile("s_waitcnt vmcnt(0)" ::: "memory");
        } else {
            XB_SPIN(xb_ld(&bar[XB_XGEN(b.x)]) == gen, bar);
            __builtin_amdgcn_fence(__ATOMIC_ACQUIRE, "agent");
            asm volatile("s_waitcnt vmcnt(0)" ::: "memory");
        }
    }
    __syncthreads();
}

#define LB_SUB(j)  (64 * (j))
#define LB_GEN(j)  (1024 + 64 * (j))
#define LB_MISM    2048
__device__ __forceinline__ void xcd_local_barrier(const XcdBarrier& b, unsigned* lbar, int tid) {
    asm volatile("s_waitcnt vmcnt(0)" ::: "memory");
    __syncthreads();
    if (tid == 0) {
        __builtin_amdgcn_s_waitcnt(0);
        const unsigned nloc = b.st[0];
        const unsigned old = xb_add(&lbar[LB_SUB(b.x)], 1u);
        const unsigned gen = old / nloc;
        if (old + 1u == (gen + 1u) * nloc) xb_add(&lbar[LB_GEN(b.x)], 1u);
        else XB_SPIN(xb_ld(&lbar[LB_GEN(b.x)]) == gen, b.bar);
        __builtin_amdgcn_fence(__ATOMIC_ACQUIRE, "agent");
        asm volatile("s_waitcnt vmcnt(0)" ::: "memory");
    }
    __syncthreads();
}
typedef unsigned u32x2_t __attribute__((ext_vector_type(2)));
typedef unsigned u32x4_t __attribute__((ext_vector_type(4)));
typedef float f32x2_t __attribute__((ext_vector_type(2)));

constexpr int NWAVES = 8;
constexpr int NTOK_P = pg8::NTOK_P, NTOK = pg8::NTOK, MPAD = pg8::MPAD, ZC = pg8::ZC;
constexpr int DM = 1024, DFF = 4096, SEQ = 8192;
constexpr int ZQ = 3328, ZK = 4096, ZV = 4864, ZGA = 5632, ZGB = 6656;
using pg8::OFF_Y_P; using pg8::OFF_Y_S; using pg8::OFF_WKV_P; using pg8::OFF_WKV_S; using pg8::OUT_TOTAL;

constexpr size_t MiB = 1u << 20;
constexpr size_t WS_CTL = 0, CTL_ZERO_BYTES = 1 * MiB;
constexpr size_t WS_WIN = 1 * MiB, WS_WLORA = 16 * MiB, WS_WBR = 18 * MiB, WS_WBA = 20 * MiB, WS_WOUT = 21 * MiB, WS_WFF1 = 23 * MiB, WS_WFF2 = 31 * MiB, WS_WPG = 39 * MiB, WS_WPLE = 41 * MiB;
constexpr size_t WS_STAT = 42 * MiB;
constexpr size_t WS_LSE = 43 * MiB;
constexpr size_t WS_XB = 44 * MiB;
constexpr size_t WS_OBUF = 44 * MiB;
constexpr size_t WS_Z = 77 * MiB;
constexpr size_t WS_X1 = 77 * MiB, WS_X1B = 142 * MiB, WS_HDN = 175 * MiB, WS_T2 = 175 * MiB;
constexpr size_t WS_ALORA = 321 * MiB;
constexpr size_t WS_ATTN = 321 * MiB;
constexpr size_t WS_LW = 330 * MiB;
constexpr size_t WS_MIX = 330 * MiB;
constexpr size_t WS_PG = 363 * MiB;
constexpr size_t WS_AA = 395 * MiB;
constexpr size_t WS_RO = 395 * MiB;
constexpr size_t WS_GG = 428 * MiB;
constexpr size_t WS_GT = 461 * MiB;
constexpr size_t WS_PB = 494 * MiB, WS_GAM = 503 * MiB, WS_RK = 504 * MiB, WS_END = 505 * MiB;
static_assert(WS_Z + (size_t)MPAD * ZC * 2 <= WS_ALORA && WS_HDN + (size_t)MPAD * DFF * 2 <= WS_ALORA && WS_X1 + (size_t)MPAD * DM * 4 <= WS_X1B && WS_X1B + (size_t)MPAD * DM * 2 <= WS_HDN, "ws map");
static_assert(WS_LW + (size_t)MPAD * DM * 2 <= WS_PG && WS_PG + (size_t)4096 * 8192 <= WS_AA && WS_AA + (size_t)MPAD * DM * 2 <= WS_GG && WS_GG + (size_t)MPAD * DM * 2 <= WS_GT && WS_GT + (size_t)4096 * 8192 <= WS_PB && WS_PB + (size_t)MPAD * 256 * 2 <= WS_GAM, "ws map 2");
static_assert(WS_XB + (size_t)MPAD * DM * 2 <= WS_Z && WS_ALORA + (size_t)MPAD * 256 * 2 <= WS_LW && WS_LSE + (size_t)MPAD * 12 * 4 <= WS_XB && WS_STAT + (size_t)MPAD * 16 <= WS_LSE, "ws map 3");
constexpr int CW_TMO = 0, CW_CODE = 1, CW_BAR = 4096, CW_QUEUE = 8192, CW_QUEUE2 = 8192 + 64, CW_PROG = 12288, CW_XS = 16384, CW_LBAR = 20480;

constexpr int RING_OFF = 0, RING_BYTES = 131072;
constexpr int LDSCTL_OFF = RING_BYTES, MISC_OFF = LDSCTL_OFF + 320;
constexpr int LDS_BYTES = 147456;

struct Frame {
    LAS unsigned char* lds;
    volatile LAS unsigned* MISC;
    gu32* ctl;
    int tid, lane, wave;
    int vcu, G;
};

__device__ __forceinline__ float wave_sum(float v) {
#pragma unroll
    for (int o = 1; o < 64; o <<= 1) v += __shfl_xor(v, o);
    return v;
}
__device__ __forceinline__ float wave_max(float v) {
#pragma unroll
    for (int o = 1; o < 64; o <<= 1) v = fmaxf(v, __shfl_xor(v, o));
    return v;
}
__device__ __forceinline__ float bf2f(bf16 h) { return __uint_as_float((unsigned)h << 16); }
__device__ __forceinline__ float bflo(unsigned w) { return __uint_as_float(w << 16); }
__device__ __forceinline__ float bfhi(unsigned w) { return __uint_as_float(w & 0xffff0000u); }
__device__ __forceinline__ float sigm(float x) { return 1.0f / (1.0f + __expf(-x)); }

__device__ __forceinline__ void p0_transpose_item(const float* W, int K, int N, bf16* WT, const float* gain, LAS float* scr, int item, int lane) {
    const int nblk = N / 32, kb = item / nblk, nb = item % nblk, k0 = 64 * kb, n0 = 32 * nb;
    const int c = lane & 7;
    float v[32];
    const float* wp = W + (size_t)(k0 + (lane >> 5)) * N + n0 + (lane & 31);
#pragma unroll
    for (int i = 0; i < 32; ++i) v[i] = wp[(size_t)(2 * i) * N];
    f32x4 ga = (f32x4){1.f, 1.f, 1.f, 1.f}, gb = ga;
    if (gain) { ga = *(const f32x4*)(gain + k0 + 8 * c); gb = *(const f32x4*)(gain + k0 + 8 * c + 4); }
#pragma unroll
    for (int i = 0; i < 32; ++i) scr[(2 * i + (lane >> 5)) * 33 + (lane & 31)] = v[i];
    LDS_WAIT(); asm volatile("" ::: "memory");
#pragma unroll
    for (int j = 0; j < 4; ++j) { const int n = (lane >> 3) + 8 * j; const LAS float* s = scr + (8 * c) * 33 + n;
        v4u o; o.x = pk2(s[0 * 33] * ga.x, s[1 * 33] * ga.y); o.y = pk2(s[2 * 33] * ga.z, s[3 * 33] * ga.w); o.z = pk2(s[4 * 33] * gb.x, s[5 * 33] * gb.y); o.w = pk2(s[6 * 33] * gb.z, s[7 * 33] * gb.w);
        *(GAS v4u*)(WT + (size_t)(n0 + n) * K + k0 + 8 * c) = o; }
    LDS_WAIT(); asm volatile("" ::: "memory");
}

struct In {
    const float *x_prompt, *x_sample, *cache0, *cache1, *cache2, *state_wkv, *state_shift, *p_prompt, *p_sample, *norm_mix, *w_in, *shift_mu, *decay_w0, *decay_w2, *aaa_a0, *aaa_a2,
                *gate_g2, *k_k, *k_a, *r_k, *lnx_w, *lnx_b, *w_br, *w_ba, *w_out, *norm_mlp, *w_ff1, *w_ff2, *norm_ple, *w_ple, *w_pg, *norm_final;
};
struct Args { In in; float* out; unsigned char* ws; };

__device__ __forceinline__ void p0_prologue(Frame& F, const In& I, unsigned char* ws) {
    LAS float* scr = (LAS float*)(F.lds + RING_OFF + F.wave * 16384);
    const int gw = F.vcu * NWAVES + F.wave, NGW = F.G * NWAVES, lane = F.lane;
    constexpr int I_IN = (1024 / 64) * (7680 / 32);
    for (int it = gw; it < I_IN; it += NGW) p0_transpose_item(I.w_in, 1024, 7680, (bf16*)(ws + WS_WIN), I.norm_mix, scr, it, lane);
    {
        bf16* WL = (bf16*)(ws + WS_WLORA);
        const int gt = gw * 64 + lane, NGT = NGW * 64;
        for (int idx = gt; idx < 3072 * 32; idx += NGT) {
            const int n = idx >> 5, kc = (idx & 31) * 8, blk = n >> 10, nn = n & 1023;
            float v[8];
#pragma unroll
            for (int j = 0; j < 8; ++j) { const int k = kc + j; float x = 0.f;
                if (blk == 0) { if (k < 64) x = I.decay_w2[(size_t)k * 1024 + nn]; }
                else if (blk == 1) { if (k >= 64 && k < 128) x = I.aaa_a2[(size_t)(k - 64) * 1024 + nn]; }
                else { if (k >= 128) x = I.gate_g2[(size_t)(k - 128) * 1024 + nn]; }
                v[j] = x; }
            v4u o; o.x = pk2(v[0], v[1]); o.y = pk2(v[2], v[3]); o.z = pk2(v[4], v[5]); o.w = pk2(v[6], v[7]);
            *(GAS v4u*)(WL + (size_t)n * 256 + kc) = o;
        }
    }
    bf16* XB = (bf16*)(ws + WS_XB); float* stat = (float*)(ws + WS_STAT);
    for (int mb = gw; mb < MPAD; mb += 4 * NGW) {
        f32x4 v[4][4];
#pragma unroll
        for (int u = 0; u < 4; ++u) { const int m = mb + u * NGW;
#pragma unroll
            for (int j = 0; j < 4; ++j) v[u][j] = (f32x4){0.f, 0.f, 0.f, 0.f};
            if (m < NTOK) { const float* xrow = m < NTOK_P ? I.x_prompt + (size_t)m * DM : I.x_sample + (size_t)(m - NTOK_P) * DM; const GAS f32x4* xr = (const GAS f32x4*)xrow + lane;
#pragma unroll
                for (int j = 0; j < 4; ++j) v[u][j] = xr[64 * j]; } }
#pragma unroll
        for (int u = 0; u < 4; ++u) { const int m = mb + u * NGW;
            if (m < MPAD) {
                GAS unsigned long long* o8 = (GAS unsigned long long*)(XB + (size_t)m * DM) + lane;
                float s = 0.f;
#pragma unroll
                for (int j = 0; j < 4; ++j) s += (v[u][j].x * v[u][j].x + v[u][j].y * v[u][j].y) + (v[u][j].z * v[u][j].z + v[u][j].w * v[u][j].w);
                s = wave_sum(s);
                if (lane == 0) stat[m] = m < NTOK ? 1.0f / sqrtf(s * (1.0f / DM) + 1e-6f) : 0.f;
#pragma unroll
                for (int j = 0; j < 4; ++j) o8[64 * j] = (unsigned long long)pk2(v[u][j].x, v[u][j].y) | ((unsigned long long)pk2(v[u][j].z, v[u][j].w) << 32);
                if (lane < 3) stat[(size_t)(1 + lane) * MPAD + m] = 0.f;
            } }
    }
}
__device__ __forceinline__ void p0_late(Frame& F, const In& I, unsigned char* ws, int hw, int nhw, int it_lo, int it_hi, int m_lo, int m_hi) {
    LAS float* scr = (LAS float*)(F.lds + RING_OFF + F.wave * 16384);
    const int lane = F.lane;
    constexpr int I_SQ = (1024 / 64) * (1024 / 32), I_BA = (256 / 64) * (1024 / 32), I_F1 = (1024 / 64) * (4096 / 32), I_F2 = (4096 / 64) * (1024 / 32);
    constexpr int NITEMS = 3 * I_SQ + 2 * I_BA + I_F1 + I_F2;
    for (int it = it_lo + hw; it < (it_hi < NITEMS ? it_hi : NITEMS); it += nhw) {
        int r = it;
        if (r < I_SQ) { p0_transpose_item(I.w_br, 1024, 1024, (bf16*)(ws + WS_WBR), nullptr, scr, r, lane); continue; } r -= I_SQ;
        if (r < I_SQ) { p0_transpose_item(I.w_out, 1024, 1024, (bf16*)(ws + WS_WOUT), nullptr, scr, r, lane); continue; } r -= I_SQ;
        if (r < I_SQ) { p0_transpose_item(I.w_pg, 1024, 1024, (bf16*)(ws + WS_WPG), I.norm_ple, scr, r, lane); continue; } r -= I_SQ;
        if (r < I_BA) { p0_transpose_item(I.w_ba, 256, 1024, (bf16*)(ws + WS_WBA), nullptr, scr, r, lane); continue; } r -= I_BA;
        if (r < I_BA) { p0_transpose_item(I.w_ple, 256, 1024, (bf16*)(ws + WS_WPLE), nullptr, scr, r, lane); continue; } r -= I_BA;
        if (r < I_F1) { p0_transpose_item(I.w_ff1, 1024, 4096, (bf16*)(ws + WS_WFF1), I.norm_mlp, scr, r, lane); continue; } r -= I_F1;
        p0_transpose_item(I.w_ff2, 4096, 1024, (bf16*)(ws + WS_WFF2), nullptr, scr, r, lane);
    }
    bf16* PB = (bf16*)(ws + WS_PB);
    const int m_end = m_hi < MPAD ? m_hi : MPAD;
    for (int mb = m_lo + hw; mb < m_end; mb += 4 * nhw) {
        f32x4 pv[4];
#pragma unroll
        for (int u = 0; u < 4; ++u) { const int m = mb + u * nhw; pv[u] = (f32x4){0.f, 0.f, 0.f, 0.f};
            if (m < NTOK) { const float* prow = m < NTOK_P ? I.p_prompt + (size_t)m * 256 : I.p_sample + (size_t)(m - NTOK_P) * 256; pv[u] = ((const GAS f32x4*)prow)[lane]; } }
#pragma unroll
        for (int u = 0; u < 4; ++u) { const int m = mb + u * nhw;
            if (m < m_end) ((GAS unsigned long long*)(PB + (size_t)m * 256))[lane] = (unsigned long long)pk2(pv[u].x, pv[u].y) | ((unsigned long long)pk2(pv[u].z, pv[u].w) << 32); }
    }
}

struct LoraGroup {
    u32x2_t zr[8], zp; f32x4 pv0, pv4; int kind;
    __device__ __forceinline__ void load(const In& I, const bf16* Z, int grp, int c) {
        kind = 0; pv0 = (f32x4){0.f, 0.f, 0.f, 0.f}; pv4 = pv0; zp = (u32x2_t){0u, 0u};
#pragma unroll
        for (int i = 0; i < 8; ++i) zr[i] = (u32x2_t){0u, 0u};
        if (grp >= MPAD / 8) return;
        const int m0 = grp * 8;
        if (m0 >= NTOK) { kind = 3; return; }
        const bf16* zb = Z + (size_t)m0 * ZC + 3072 + c;
#pragma unroll
        for (int i = 0; i < 8; ++i) zr[i] = *(const u32x2_t*)(zb + (size_t)i * ZC);
        if (m0 >= NTOK_P) { kind = 2; const float* sp = I.state_shift + (size_t)((m0 - NTOK_P) >> 2) * 3328 + 3072 + c; pv0 = *(const f32x4*)sp; pv4 = *(const f32x4*)(sp + 3328); }
        else { kind = 1; if ((m0 & (SEQ - 1)) != 0) zp = *(const u32x2_t*)(zb - ZC); }
    }
    __device__ __forceinline__ void finish(bf16* AL, int grp, int c, const f32x4 mu) const {
        if (kind == 0) return;
        GAS unsigned long long* ao = (GAS unsigned long long*)(AL + (size_t)grp * 8 * 256 + c);
        if (kind == 3) {
#pragma unroll
            for (int i = 0; i < 8; ++i) ao[(size_t)i * 64] = 0ull;
            return;
        }
        const bool ident = c >= 64 && c < 128; const float ka = c < 64 ? 2.0f : 1.0f, kb = c < 64 ? -1.0f : 0.0f;
#pragma unroll
        for (int i = 0; i < 8; ++i) {
            const f32x4 z = (f32x4){bflo(zr[i].x), bfhi(zr[i].x), bflo(zr[i].y), bfhi(zr[i].y)};
            const u32x2_t q = i > 0 ? zr[i > 0 ? i - 1 : 0] : zp;
            f32x4 pr = (f32x4){bflo(q.x), bfhi(q.x), bflo(q.y), bfhi(q.y)};
            if (kind == 2) { if (i == 0) pr = pv0; if (i == 4) pr = pv4; }
            f32x4 zs; zs.x = z.x + (pr.x - z.x) * mu.x; zs.y = z.y + (pr.y - z.y) * mu.y; zs.z = z.z + (pr.z - z.z) * mu.z; zs.w = z.w + (pr.w - z.w) * mu.w;
            float r[4];
#pragma unroll
            for (int e = 0; e < 4; ++e) { const float sg = __builtin_amdgcn_rcpf(1.0f + __expf(-ka * zs[e])); const float t = ka * sg + kb; r[e] = ident ? zs[e] : t; }
            ao[(size_t)i * 64] = (unsigned long long)pk2(r[0], r[1]) | ((unsigned long long)pk2(r[2], r[3]) << 32);
        }
    }
};
__device__ __forceinline__ void p2a_all(Frame& F, const In& I, unsigned char* ws, float* out) {
    const int gw = F.vcu * NWAVES + F.wave, NGW = F.G * NWAVES, lane = F.lane;
    const bf16* Z = (const bf16*)(ws + WS_Z); bf16* AL = (bf16*)(ws + WS_ALORA);
    const int c = 4 * lane;
    const f32x4 mu = *(const f32x4*)(I.shift_mu + 3072 + c);
    constexpr int NKVP = 10752, NKV = NKVP + 768, NIT = NKV + 34 * 13, UN = 6, NGRP = MPAD / 8;
    for (int p = 0; gw + p * UN * NGW < NIT || gw + 2 * p * NGW < NGRP; ++p) {
        const int j0 = gw + p * UN * NGW, g0 = gw + 2 * p * NGW;
        int g1 = g0 + NGW;
        if (NGW * 8 == NTOK_P) { const int cls = gw >> 8, wl_ = gw & 255;
            g1 = wl_ < 2 ? NTOK_P / 8 + 2 * cls + wl_ : (wl_ < 4 ? NTOK / 8 + 2 * cls + wl_ - 2 : NGRP); }
        u32x2_t zv[UN]; size_t doff[UN];
#pragma unroll
        for (int u = 0; u < UN; ++u) {
            const int j = j0 + u * NGW; zv[u] = (u32x2_t){0u, 0u}; doff[u] = 0;
            if (j < NIT) {
                size_t srow; int col;
                if (j < NKVP) { const int b = j / 5376, q = j % 5376, g = q < 256 ? 0 : (q < 1280 ? 1 : 2), q0 = q - (g == 0 ? 0 : (g == 1 ? 256 : 1280)), rr = q0 >> 1, kvsel = q0 & 1, keep = 128 << (2 * g);
                    srow = (size_t)b * SEQ + (SEQ - keep + rr); col = (kvsel ? ZV : ZK) + g * 256;
                    doff[u] = (g == 0 ? pg8::OFF_KVP0 : (g == 1 ? pg8::OFF_KVP1 : pg8::OFF_KVP2)) + ((size_t)(b * keep + rr) * 2 + kvsel) * 256; }
                else if (j < NKV) { const int jj = j - NKVP, sr = jj / 6, kg = jj % 6, kvsel = kg / 3, g = kg % 3;
                    srow = (size_t)NTOK_P + sr; col = (kvsel ? ZV : ZK) + g * 256;
                    doff[u] = (g == 0 ? pg8::OFF_KVS0 : (g == 1 ? pg8::OFF_KVS1 : pg8::OFF_KVS2)) + ((size_t)sr * 2 + kvsel) * 256; }
                else { const int jj = j - NKV, sr = jj / 13, cb = (jj % 13) * 256;
                    srow = sr < 2 ? (size_t)sr * SEQ + SEQ - 1 : (size_t)NTOK_P + (sr - 2) * 4 + 3; col = cb;
                    doff[u] = (sr < 2 ? pg8::OFF_SHIFT_P + (size_t)sr * 3328 : pg8::OFF_SHIFT_S + (size_t)(sr - 2) * 3328) + cb; }
                zv[u] = *(const u32x2_t*)(Z + srow * ZC + col + c);
            }
        }
        LoraGroup A, B; A.load(I, Z, g0, c); B.load(I, Z, g1, c);
        A.finish(AL, g0, c, mu); B.finish(AL, g1, c, mu);
#pragma unroll
        for (int u = 0; u < UN; ++u) if (j0 + u * NGW < NIT) *(f32x4*)(out + doff[u] + c) = (f32x4){bflo(zv[u].x), bfhi(zv[u].x), bflo(zv[u].y), bfhi(zv[u].y)};
    }
}

__device__ __forceinline__ float dpp_f(float v, const int ctrl, const int rmask) { (void)ctrl; (void)rmask; return v; }
#define DPP_ADD(v, ctrl, rmask) v += __builtin_bit_cast(float, __builtin_amdgcn_update_dpp(0, __builtin_bit_cast(int, v), ctrl, rmask, 0xf, false))
__device__ __forceinline__ float wave_sum_dpp(float v) {
    DPP_ADD(v, 0xb1, 0xf);
    DPP_ADD(v, 0x4e, 0xf);
    DPP_ADD(v, 0x114, 0xf);
    DPP_ADD(v, 0x118, 0xf);
    DPP_ADD(v, 0x142, 0xa);
    DPP_ADD(v, 0x143, 0xc);
    return __builtin_bit_cast(float, __builtin_amdgcn_readlane(__builtin_bit_cast(int, v), 63));
}

constexpr int SCAN_TB = 8;
constexpr int SC_NC = 64, SC_L = 128;
struct ScanC { float mu_r, mu_k, mu_v, kk_c, ka_c, rk_c; };

template <int NB, bool NEED_R>
__device__ __forceinline__ void scan_prep(const bf16* Z, const bf16* LW, const bf16* AA, size_t m0, int col, int lane, const ScanC& c, float& pr, float& pk, float& pv, LAS float* wl) {
    LAS float* LA = wl; LAS float* LWv = wl + SCAN_TB * 64; LAS float* LB = wl + 2 * SCAN_TB * 64; LAS float* LK = wl + 3 * SCAN_TB * 64; LAS float* LR = wl + 4 * SCAN_TB * 64; LAS float* LV = wl + 5 * SCAN_TB * 64;
    LAS float* LS = wl + 6 * SCAN_TB * 64;
    float zr_[NB], zk_[NB], zv_[NB], lw_[NB], aa_[NB];
#pragma unroll
    for (int tt = 0; tt < NB; ++tt) { const size_t m = m0 + tt;
        const bf16* zrow = Z + m * ZC; const bf16* lrow = LW + m * 1024; const bf16* arow = AA + m * 1024; const unsigned uc = (unsigned)col;
        zr_[tt] = NEED_R ? bf2f(zrow[uc]) : 0.f; zk_[tt] = bf2f(zrow[uc + 1024u]); zv_[tt] = bf2f(zrow[uc + 2048u]);
        lw_[tt] = bf2f(lrow[uc]); aa_[tt] = bf2f(arow[uc]); }
#pragma unroll
    for (int tt = 0; tt < NB; ++tt) {
        const float zr = zr_[tt], zk = zk_[tt], zv = zv_[tt], aa = aa_[tt];
        const float k = zk + (pk - zk) * c.mu_k, v = zv + (pv - zv) * c.mu_v;
        pk = zk; pv = zv;
        const float w = __expf(lw_[tt]);
        const float kkv = k * c.kk_c;
        const float nrm = sqrtf(wave_sum_dpp(kkv * kkv));
        const float kk = kkv / fmaxf(nrm, 1e-12f);
        const float kp = k * (1.0f + (aa - 1.0f) * c.ka_c);
        LA[tt * 64 + lane] = -kk; LWv[tt * 64 + lane] = w; LB[tt * 64 + lane] = kk * aa; LK[tt * 64 + lane] = kp; LV[tt * 64 + lane] = v;
        if (NEED_R) { const float r = zr + (pr - zr) * c.mu_r; pr = zr; const float rk = wave_sum_dpp(r * kp * c.rk_c); LR[tt * 64 + lane] = r; if (lane == 0) LS[tt] = rk; }
    }
}

__device__ __forceinline__ void scan_pass1(Frame& F, const In& I, unsigned char* ws, float* pq, int unit, LAS float* wl) {
    const int lane = F.lane;
    const int seq = unit / SC_NC, ch = unit % SC_NC, b = seq >> 4, h = seq & 15;
    const int col = h * 64 + lane;
    const size_t row0 = (size_t)b * SEQ + (size_t)ch * SC_L;
    const bf16* Z = (const bf16*)(ws + WS_Z); const bf16* LW = (const bf16*)(ws + WS_LW); const bf16* AA = (const bf16*)(ws + WS_AA);
    ScanC c; c.mu_r = 0.f; c.mu_k = I.shift_mu[1024 + col]; c.mu_v = I.shift_mu[2048 + col]; c.kk_c = I.k_k[col]; c.ka_c = I.k_a[col]; c.rk_c = 0.f;
    float pr = 0.f, pk = 0.f, pv = 0.f;
    if (ch > 0) { pk = bf2f(Z[(row0 - 1) * ZC + 1024 + col]); pv = bf2f(Z[(row0 - 1) * ZC + 2048 + col]); }
    f32x2_t sP[32], sQ[32];
    { int ln = lane; asm volatile("" : "+v"(ln));
#pragma unroll
    for (int j = 0; j < 32; ++j) { sP[j] = (f32x2_t){(2 * j == ln) ? 1.f : 0.f, (2 * j + 1 == ln) ? 1.f : 0.f}; sQ[j] = (f32x2_t){0.f, 0.f}; } }
    LAS float* LA = wl; LAS float* LWv = wl + SCAN_TB * 64; LAS float* LB = wl + 2 * SCAN_TB * 64; LAS float* LK = wl + 3 * SCAN_TB * 64; LAS float* LV = wl + 5 * SCAN_TB * 64;
    for (int t0 = 0; t0 < SC_L; t0 += SCAN_TB) {
        scan_prep<SCAN_TB, false>(Z, LW, AA, row0 + t0, col, lane, c, pr, pk, pv, wl);
        LDS_WAIT(); asm volatile("" ::: "memory");
#pragma unroll 1
        for (int tt = 0; tt < SCAN_TB; ++tt) {
            const float vv = LV[tt * 64 + lane];
            const LAS f32x4* a4 = (const LAS f32x4*)(LA + tt * 64); const LAS f32x4* w4 = (const LAS f32x4*)(LWv + tt * 64); const LAS f32x4* b4 = (const LAS f32x4*)(LB + tt * 64);
            const LAS f32x4* k4 = (const LAS f32x4*)(LK + tt * 64);
            f32x2_t p0 = {0.f, 0.f}, p1 = {0.f, 0.f}, q0 = {0.f, 0.f}, q1 = {0.f, 0.f};
            f32x4 av[4], an[4];
#pragma unroll
            for (int i = 0; i < 4; ++i) av[i] = a4[i];
#pragma unroll
            for (int g = 0; g < 4; ++g) {
                if (g < 3) {
#pragma unroll
                    for (int i = 0; i < 4; ++i) an[i] = a4[4 * (g + 1) + i]; }
                __builtin_amdgcn_sched_barrier(0);
#pragma unroll
                for (int i = 0; i < 4; ++i) { const int j = 4 * g + i; const f32x2_t lo = __builtin_shufflevector(av[i], av[i], 0, 1), hi = __builtin_shufflevector(av[i], av[i], 2, 3);
                    p0 += sP[2 * j] * lo; p1 += sP[2 * j + 1] * hi; q0 += sQ[2 * j] * lo; q1 += sQ[2 * j + 1] * hi; }
#pragma unroll
                for (int i = 0; i < 4; ++i) av[i] = an[i];
            }
            const float saP = (p0.x + p0.y) + (p1.x + p1.y), saQ = (q0.x + q0.y) + (q1.x + q1.y);
            const f32x2_t saP2 = {saP, saP}, saQ2 = {saQ, saQ}, vv2 = {vv, vv};
            f32x4 wv[2], bv[2], kv[2], wn[2], bn[2], kn[2];
#pragma unroll
            for (int i = 0; i < 2; ++i) { wv[i] = w4[i]; bv[i] = b4[i]; kv[i] = k4[i]; }
#pragma unroll
            for (int g = 0; g < 8; ++g) {
                if (g < 7) {
#pragma unroll
                    for (int i = 0; i < 2; ++i) { wn[i] = w4[2 * (g + 1) + i]; bn[i] = b4[2 * (g + 1) + i]; kn[i] = k4[2 * (g + 1) + i]; } }
                __builtin_amdgcn_sched_barrier(0);
#pragma unroll
                for (int i = 0; i < 2; ++i) { const int j = 2 * g + i;
                    const f32x2_t wlo = __builtin_shufflevector(wv[i], wv[i], 0, 1), whi = __builtin_shufflevector(wv[i], wv[i], 2, 3);
                    const f32x2_t blo = __builtin_shufflevector(bv[i], bv[i], 0, 1), bhi = __builtin_shufflevector(bv[i], bv[i], 2, 3);
                    const f32x2_t klo = __builtin_shufflevector(kv[i], kv[i], 0, 1), khi = __builtin_shufflevector(kv[i], kv[i], 2, 3);
                    sP[2 * j] = sP[2 * j] * wlo + saP2 * blo; sP[2 * j + 1] = sP[2 * j + 1] * whi + saP2 * bhi;
                    sQ[2 * j] = sQ[2 * j] * wlo + (saQ2 * blo + vv2 * klo); sQ[2 * j + 1] = sQ[2 * j + 1] * whi + (saQ2 * bhi + vv2 * khi); }
#pragma unroll
                for (int i = 0; i < 2; ++i) { wv[i] = wn[i]; bv[i] = bn[i]; kv[i] = kn[i]; }
            }
        }
        LDS_WAIT(); asm volatile("" ::: "memory");
    }
    float* dP = pq + (size_t)unit * 8192 + (size_t)lane * 64; float* dQ = dP + 4096;
#pragma unroll
    for (int j = 0; j < 16; ++j) { *(f32x4*)(dP + 4 * j) = (f32x4){sP[2 * j].x, sP[2 * j].y, sP[2 * j + 1].x, sP[2 * j + 1].y}; *(f32x4*)(dQ + 4 * j) = (f32x4){sQ[2 * j].x, sQ[2 * j].y, sQ[2 * j + 1].x, sQ[2 * j + 1].y}; }
}

template <bool STORE> __device__ __forceinline__ void scan_chain(Frame& F, float* pq, float* out, int seq, int ct) {
    const int lane = F.lane, a = lane & 15, q = lane >> 4;
    float* base = pq + (size_t)seq * SC_NC * 8192;
    const size_t qoff = (size_t)(16 * ct + a) * 64 + 4 * q, poff = (size_t)(4 * q) * 64 + a;
    f32x4 st[4], qn[4]; float pn[64];
#pragma unroll
    for (int rt2 = 0; rt2 < 4; ++rt2) st[rt2] = *(const f32x4*)(base + 4096 + qoff + 16 * rt2);
#pragma unroll
    for (int rt2 = 0; rt2 < 4; ++rt2) qn[rt2] = *(const f32x4*)(base + 8192 + 4096 + qoff + 16 * rt2);
#pragma unroll
    for (int rt = 0; rt < 4; ++rt)
#pragma unroll
        for (int rg = 0; rg < 4; ++rg)
#pragma unroll
            for (int rt2 = 0; rt2 < 4; ++rt2) pn[(rt * 4 + rg) * 4 + rt2] = base[8192 + poff + (size_t)(16 * rt + rg) * 64 + 16 * rt2];
    for (int c = 1; c < SC_NC; ++c) {
        float* P = base + (size_t)c * 8192; float* Q = P + 4096;
        f32x4 acc[4]; float pc[64];
#pragma unroll
        for (int rt2 = 0; rt2 < 4; ++rt2) acc[rt2] = qn[rt2];
#pragma unroll
        for (int i = 0; i < 64; ++i) pc[i] = pn[i];
        if (c + 1 < SC_NC) {
#pragma unroll
            for (int rt2 = 0; rt2 < 4; ++rt2) qn[rt2] = *(const f32x4*)(Q + 8192 + qoff + 16 * rt2);
#pragma unroll
            for (int rt = 0; rt < 4; ++rt)
#pragma unroll
                for (int rg = 0; rg < 4; ++rg)
#pragma unroll
                    for (int rt2 = 0; rt2 < 4; ++rt2) pn[(rt * 4 + rg) * 4 + rt2] = P[8192 + poff + (size_t)(16 * rt + rg) * 64 + 16 * rt2];
        }
#pragma unroll
        for (int rt2 = 0; rt2 < 4; ++rt2) if (STORE) *(f32x4*)(Q - 8192 + qoff + 16 * rt2) = st[rt2];
#pragma unroll
        for (int rt = 0; rt < 4; ++rt)
#pragma unroll
            for (int rg = 0; rg < 4; ++rg)
#pragma unroll
                for (int rt2 = 0; rt2 < 4; ++rt2) acc[rt2] = __builtin_amdgcn_mfma_f32_16x16x4f32(pc[(rt * 4 + rg) * 4 + rt2], st[rt][rg], acc[rt2], 0, 0, 0);
#pragma unroll
        for (int rt2 = 0; rt2 < 4; ++rt2) st[rt2] = acc[rt2];
    }
    float* dst = out + OFF_WKV_P + (size_t)seq * 4096;
#pragma unroll
    for (int rt2 = 0; rt2 < 4; ++rt2) { if (STORE) *(f32x4*)(dst + qoff + 16 * rt2) = st[rt2]; else asm volatile("" :: "v"(st[rt2])); }
}

template <int NB>
__device__ __forceinline__ void scan_out(Frame& F, const In& I, unsigned char* ws, size_t row0, int T, int h, const float* init, float* fin, float pr, float pk, float pv, LAS float* wl) {
    const int lane = F.lane;
    const int col = h * 64 + lane;
    const bf16* Z = (const bf16*)(ws + WS_Z); const bf16* LW = (const bf16*)(ws + WS_LW); const bf16* AA = (const bf16*)(ws + WS_AA); const bf16* GG = (const bf16*)(ws + WS_GG);
    bf16* RO = (bf16*)(ws + WS_RO);
    ScanC c; c.mu_r = I.shift_mu[col]; c.mu_k = I.shift_mu[1024 + col]; c.mu_v = I.shift_mu[2048 + col]; c.kk_c = I.k_k[col]; c.ka_c = I.k_a[col]; c.rk_c = I.r_k[col];
    const float lnw_c = I.lnx_w[col], lnb_c = I.lnx_b[col];
    f32x2_t s[32];
    if (init) { const f32x4* sp = (const f32x4*)(init + (size_t)lane * 64);
#pragma unroll
        for (int j = 0; j < 16; ++j) { const f32x4 v = sp[j]; s[2 * j] = (f32x2_t){v.x, v.y}; s[2 * j + 1] = (f32x2_t){v.z, v.w}; } }
    else {
#pragma unroll
        for (int j = 0; j < 32; ++j) s[j] = (f32x2_t){0.f, 0.f}; }
    LAS float* LA = wl; LAS float* LWv = wl + SCAN_TB * 64; LAS float* LB = wl + 2 * SCAN_TB * 64; LAS float* LK = wl + 3 * SCAN_TB * 64; LAS float* LR = wl + 4 * SCAN_TB * 64; LAS float* LV = wl + 5 * SCAN_TB * 64;
    LAS float* LS = wl + 6 * SCAN_TB * 64;
    for (int t0 = 0; t0 < T; t0 += NB) {
        scan_prep<NB, true>(Z, LW, AA, row0 + t0, col, lane, c, pr, pk, pv, wl);
        LDS_WAIT(); asm volatile("" ::: "memory");
#pragma unroll 1
        for (int tt = 0; tt < NB; ++tt) {
            const size_t m = row0 + t0 + tt;
            const float vv = LV[tt * 64 + lane];
            const float gg = bf2f(GG[m * 1024 + col]);
            const LAS f32x4* a4 = (const LAS f32x4*)(LA + tt * 64); const LAS f32x4* w4 = (const LAS f32x4*)(LWv + tt * 64); const LAS f32x4* b4 = (const LAS f32x4*)(LB + tt * 64);
            const LAS f32x4* k4 = (const LAS f32x4*)(LK + tt * 64); const LAS f32x4* r4 = (const LAS f32x4*)(LR + tt * 64);
            f32x2_t p0 = {0.f, 0.f}, p1 = {0.f, 0.f};
            f32x4 av[4], an[4];
#pragma unroll
            for (int i = 0; i < 4; ++i) av[i] = a4[i];
#pragma unroll
            for (int g = 0; g < 4; ++g) {
                if (g < 3) {
#pragma unroll
                    for (int i = 0; i < 4; ++i) an[i] = a4[4 * (g + 1) + i]; }
                __builtin_amdgcn_sched_barrier(0);
#pragma unroll
                for (int i = 0; i < 4; ++i) { const int j = 4 * g + i; const f32x2_t lo = __builtin_shufflevector(av[i], av[i], 0, 1), hi = __builtin_shufflevector(av[i], av[i], 2, 3);
                    p0 += s[2 * j] * lo; p1 += s[2 * j + 1] * hi; }
#pragma unroll
                for (int i = 0; i < 4; ++i) av[i] = an[i];
            }
            const float sa = (p0.x + p0.y) + (p1.x + p1.y);
            const f32x2_t sa2 = {sa, sa}, vv2 = {vv, vv};
            f32x2_t y0 = {0.f, 0.f}, y1 = {0.f, 0.f};
            f32x4 wv[2], bv[2], kv[2], rv[2], wn[2], bn[2], kn[2], rn[2];
#pragma unroll
            for (int i = 0; i < 2; ++i) { wv[i] = w4[i]; bv[i] = b4[i]; kv[i] = k4[i]; rv[i] = r4[i]; }
#pragma unroll
            for (int g = 0; g < 8; ++g) {
                if (g < 7) {
#pragma unroll
                    for (int i = 0; i < 2; ++i) { wn[i] = w4[2 * (g + 1) + i]; bn[i] = b4[2 * (g + 1) + i]; kn[i] = k4[2 * (g + 1) + i]; rn[i] = r4[2 * (g + 1) + i]; } }
                __builtin_amdgcn_sched_barrier(0);
#pragma unroll
                for (int i = 0; i < 2; ++i) { const int j = 2 * g + i;
                    const f32x2_t wlo = __builtin_shufflevector(wv[i], wv[i], 0, 1), whi = __builtin_shufflevector(wv[i], wv[i], 2, 3);
                    const f32x2_t blo = __builtin_shufflevector(bv[i], bv[i], 0, 1), bhi = __builtin_shufflevector(bv[i], bv[i], 2, 3);
                    const f32x2_t klo = __builtin_shufflevector(kv[i], kv[i], 0, 1), khi = __builtin_shufflevector(kv[i], kv[i], 2, 3);
                    const f32x2_t rlo = __builtin_shufflevector(rv[i], rv[i], 0, 1), rhi = __builtin_shufflevector(rv[i], rv[i], 2, 3);
                    s[2 * j] = s[2 * j] * wlo + (sa2 * blo + vv2 * klo); s[2 * j + 1] = s[2 * j + 1] * whi + (sa2 * bhi + vv2 * khi);
                    y0 += s[2 * j] * rlo; y1 += s[2 * j + 1] * rhi; }
#pragma unroll
                for (int i = 0; i < 2; ++i) { wv[i] = wn[i]; bv[i] = bn[i]; kv[i] = kn[i]; rv[i] = rn[i]; }
            }
            const float y = (y0.x + y0.y) + (y1.x + y1.y);
            const float mean = wave_sum_dpp(y) * (1.0f / 64.0f), d = y - mean;
            const float var = wave_sum_dpp(d * d) * (1.0f / 64.0f);
            const float yn = d * (1.0f / sqrtf(var + 64e-5f)) * lnw_c + lnb_c;
            const float o = (yn + LS[tt] * vv) * gg;
            RO[m * 1024 + col] = (bf16)pk2(o, o);
        }
        LDS_WAIT(); asm volatile("" ::: "memory");
    }
    if (fin) { float* dst = fin + (size_t)lane * 64;
#pragma unroll
        for (int j = 0; j < 16; ++j) *(f32x4*)(dst + 4 * j) = (f32x4){s[2 * j].x, s[2 * j].y, s[2 * j + 1].x, s[2 * j + 1].y}; }
}

__device__ __forceinline__ void attn_sample_item(Frame& F, const In& I, unsigned char* ws, int item, LAS float* wl) {
    const int lane = F.lane;
    const int h = item & 3, g = (item >> 2) % 3, nt = item / 12, n = nt >> 2, t = nt & 3;
    const int d = g == 0 ? 1 : (g == 1 ? 4 : 16), L = g == 0 ? 128 : (g == 1 ? 512 : 2048);
    const float* cache = g == 0 ? I.cache0 : (g == 1 ? I.cache1 : I.cache2);
    const bf16* Z = (const bf16*)(ws + WS_Z);
    const size_t mq = (size_t)(NTOK_P + nt);
    const int hc = g * 256 + h * 64;
    wl[lane] = bf2f(Z[mq * ZC + ZQ + hc + lane]) * 0.125f;
    LDS_WAIT(); asm volatile("" ::: "memory");
    float sc[3];
#pragma unroll
    for (int jj = 0; jj < 3; ++jj) {
        const int j = lane + 64 * jj;
        float s = -1e30f;
        if (j <= 128) {
            const int idx = L + t - d * j;
            float acc = 0.f;
            if (idx >= L) { const bf16* kr = Z + (size_t)(NTOK_P + n * 4 + idx - L) * ZC + ZK + hc;
#pragma unroll
                for (int e8 = 0; e8 < 8; ++e8) { const v4u kv = *(const v4u*)(kr + 8 * e8); const LAS f32x4* qq = (const LAS f32x4*)(wl + 8 * e8); const f32x4 q0 = qq[0], q1 = qq[1];
                    acc += bflo(kv.x) * q0.x + bfhi(kv.x) * q0.y + bflo(kv.y) * q0.z + bfhi(kv.y) * q0.w + bflo(kv.z) * q1.x + bfhi(kv.z) * q1.y + bflo(kv.w) * q1.z + bfhi(kv.w) * q1.w; } }
            else { const float* kr = cache + (((size_t)n * L + idx) * 2 + 0) * 256 + h * 64;
#pragma unroll
                for (int e4 = 0; e4 < 16; ++e4) { const f32x4 kv = *(const f32x4*)(kr + 4 * e4); const f32x4 q0 = ((const LAS f32x4*)wl)[e4];
                    acc += kv.x * q0.x + kv.y * q0.y + kv.z * q0.z + kv.w * q0.w; } }
            s = acc;
        }
        sc[jj] = s;
    }
    const float mx = wave_max(fmaxf(fmaxf(sc[0], sc[1]), sc[2]));
    float den = 0.f;
#pragma unroll
    for (int jj = 0; jj < 3; ++jj) { const int j = lane + 64 * jj; const float p = (j <= 128) ? __expf(sc[jj] - mx) : 0.f; den += p; if (j <= 128) wl[64 + j] = p; }
    den = wave_sum(den);
    LDS_WAIT(); asm volatile("" ::: "memory");
    float o = 0.f;
    {
#pragma unroll
        for (int j = 0; j < 4; ++j) { const int idx = L + t - d * j; float v;
            if (idx >= L) v = bf2f(Z[(size_t)(NTOK_P + n * 4 + idx - L) * ZC + ZV + hc + lane]); else v = cache[(((size_t)n * L + idx) * 2 + 1) * 256 + h * 64 + lane];
            o += wl[64 + j] * v; }
        const float* cv = cache + ((size_t)n * L * 2 + 1) * 256 + h * 64 + lane;
        for (int j0 = 4; j0 < 124; j0 += 8) {
            float v[8];
#pragma unroll
            for (int u = 0; u < 8; ++u) v[u] = cv[(size_t)(L + t - d * (j0 + u)) * 512];
#pragma unroll
            for (int u = 0; u < 8; ++u) o += wl[64 + j0 + u] * v[u];
        }
#pragma unroll
        for (int j = 124; j <= 128; ++j) o += wl[64 + j] * cv[(size_t)(L + t - d * j) * 512];
    }
    bf16* OB = (bf16*)(ws + WS_OBUF); float* LSE = (float*)(ws + WS_LSE);
    OB[mq * 768 + hc + lane] = (bf16)pk2(o / den, o / den);
    if (lane == 0) LSE[mq * 12 + g * 4 + h] = mx + __logf(den);
    LDS_WAIT(); asm volatile("" ::: "memory");
}

constexpr int AQ_PITCH = 144, AK_PITCH = 144, AV_PITCH = 528;
constexpr int A_QS = 0, A_KS = 128 * AQ_PITCH, A_VT = A_KS + 256 * AK_PITCH, A_END = A_VT + 64 * AV_PITCH;
static_assert(A_END <= RING_BYTES, "attention LDS");
typedef short s16x4 __attribute__((ext_vector_type(4)));
__device__ __forceinline__ void attn_prompt_unit(Frame& F, unsigned char* ws, int unit) {
    const int tid = F.tid, lane = F.lane, w = F.wave;
    const int sub = unit & 63, bgh = unit >> 6, h = bgh & 3, g = (bgh >> 2) % 3, b = bgh / 12;
    const int dsh = 2 * g, d = 1 << dsh, nblk = 64 >> dsh;
    const int r = sub / nblk, blk = sub % nblk;
    const bf16* Z = (const bf16*)(ws + WS_Z);
    const int hc = g * 256 + h * 64;
    LAS unsigned char* lds = F.lds + RING_OFF;
    const size_t rowb = (size_t)b * SEQ;
    for (int ch = tid; ch < 128 * 8; ch += 512) { const int i = ch >> 3, c8 = ch & 7; const int pos = r + d * (128 * blk + i);
        const v4u v = *(const v4u*)(Z + (rowb + pos) * ZC + ZQ + hc + 8 * c8); *(LAS v4u*)(lds + A_QS + i * AQ_PITCH + 16 * c8) = v; }
    for (int ch = tid; ch < 256 * 8; ch += 512) { const int j = ch >> 3, c8 = ch & 7; const int pos = r + d * (128 * (blk - 1) + j);
        v4u kv = (v4u){0u, 0u, 0u, 0u}, vv = (v4u){0u, 0u, 0u, 0u};
        if (pos >= 0) { kv = *(const v4u*)(Z + (rowb + pos) * ZC + ZK + hc + 8 * c8); vv = *(const v4u*)(Z + (rowb + pos) * ZC + ZV + hc + 8 * c8); }
        *(LAS v4u*)(lds + A_KS + j * AK_PITCH + 16 * c8) = kv;
        LAS unsigned short* vt = (LAS unsigned short*)(lds + A_VT) + j;
        const int e0 = 8 * c8;
        vt[(e0 + 0) * (AV_PITCH / 2)] = (unsigned short)(vv.x & 0xffffu); vt[(e0 + 1) * (AV_PITCH / 2)] = (unsigned short)(vv.x >> 16);
        vt[(e0 + 2) * (AV_PITCH / 2)] = (unsigned short)(vv.y & 0xffffu); vt[(e0 + 3) * (AV_PITCH / 2)] = (unsigned short)(vv.y >> 16);
        vt[(e0 + 4) * (AV_PITCH / 2)] = (unsigned short)(vv.z & 0xffffu); vt[(e0 + 5) * (AV_PITCH / 2)] = (unsigned short)(vv.z >> 16);
        vt[(e0 + 6) * (AV_PITCH / 2)] = (unsigned short)(vv.w & 0xffffu); vt[(e0 + 7) * (AV_PITCH / 2)] = (unsigned short)(vv.w >> 16); }
    __syncthreads();
    const int l15 = lane & 15, lq = lane >> 4;
    bf16x8 qf[2];
#pragma unroll
    for (int es = 0; es < 2; ++es) qf[es] = *(const LAS bf16x8*)(lds + A_QS + (16 * w + l15) * AQ_PITCH + es * 64 + 16 * lq);
    f32x4 sacc[9];
#pragma unroll
    for (int kt = 0; kt < 9; ++kt) {
        f32x4 a = (f32x4){0.f, 0.f, 0.f, 0.f};
#pragma unroll
        for (int es = 0; es < 2; ++es) { const bf16x8 kf = *(const LAS bf16x8*)(lds + A_KS + (16 * (w + kt) + l15) * AK_PITCH + es * 64 + 16 * lq);
            a = __builtin_amdgcn_mfma_f32_16x16x32_bf16(kf, qf[es], a, 0, 0, 0); }
        sacc[kt] = a;
    }
    const int qi = 16 * w + l15;
    float mx = -1e30f;
#pragma unroll
    for (int kt = 0; kt < 9; ++kt)
#pragma unroll
        for (int rg = 0; rg < 4; ++rg) { const int kj = 16 * (w + kt) + 4 * lq + rg; const int dist = qi + 128 - kj;
            const bool ok = (dist >= 0) && (dist <= 128) && (blk > 0 || kj >= 128);
            const float sv = ok ? sacc[kt][rg] * 0.125f : -1e30f; sacc[kt][rg] = sv; mx = fmaxf(mx, sv); }
    mx = fmaxf(mx, __shfl_xor(mx, 16)); mx = fmaxf(mx, __shfl_xor(mx, 32));
    float den = 0.f;
#pragma unroll
    for (int kt = 0; kt < 9; ++kt)
#pragma unroll
        for (int rg = 0; rg < 4; ++rg) { const float p = __expf(sacc[kt][rg] - mx); sacc[kt][rg] = p; den += p; }
    den += __shfl_xor(den, 16); den += __shfl_xor(den, 32);
    f32x4 oacc[4];
#pragma unroll
    for (int et = 0; et < 4; ++et) oacc[et] = (f32x4){0.f, 0.f, 0.f, 0.f};
#pragma unroll
    for (int ks = 0; ks < 5; ++ks) {
        const int k0 = 2 * ks, k1 = 2 * ks + 1;
        u32x4_t pw;
        pw.x = pk2(sacc[k0][0], sacc[k0][1]); pw.y = pk2(sacc[k0][2], sacc[k0][3]);
        if (k1 < 9) { pw.z = pk2(sacc[k1 < 9 ? k1 : 8][0], sacc[k1 < 9 ? k1 : 8][1]); pw.w = pk2(sacc[k1 < 9 ? k1 : 8][2], sacc[k1 < 9 ? k1 : 8][3]); } else { pw.z = 0u; pw.w = 0u; }
        const bf16x8 pf = __builtin_bit_cast(bf16x8, pw);
#pragma unroll
        for (int et = 0; et < 4; ++et) {
            const LAS unsigned char* vrow = lds + A_VT + (16 * et + l15) * AV_PITCH;
            const s16x4 lo = *(const LAS s16x4*)(vrow + (16 * (w + k0) + 4 * lq) * 2);
            s16x4 hi = (s16x4){0, 0, 0, 0};
            if (k1 < 9) hi = *(const LAS s16x4*)(vrow + (16 * (w + (k1 < 9 ? k1 : 8)) + 4 * lq) * 2);
            const bf16x8 vf = (bf16x8){lo[0], lo[1], lo[2], lo[3], hi[0], hi[1], hi[2], hi[3]};
            oacc[et] = __builtin_amdgcn_mfma_f32_16x16x32_bf16(vf, pf, oacc[et], 0, 0, 0);
        }
    }
    const float rden = 1.0f / den;
    const size_t mq = rowb + (size_t)(r + d * (128 * blk + qi));
    bf16* OB = (bf16*)(ws + WS_OBUF); float* LSE = (float*)(ws + WS_LSE);
#pragma unroll
    for (int et = 0; et < 4; ++et) { const f32x4 o = oacc[et] * rden;
        *(GAS unsigned long long*)(OB + mq * 768 + hc + 16 * et + 4 * lq) = (unsigned long long)pk2(o[0], o[1]) | ((unsigned long long)pk2(o[2], o[3]) << 32); }
    if (lq == 0) LSE[mq * 12 + g * 4 + h] = mx + __logf(den);
    __syncthreads();
}

__device__ __forceinline__ void p2d_attn_merge(Frame& F, unsigned char* ws) {
    const int gw = F.vcu * NWAVES + F.wave, NGW = F.G * NWAVES, lane = F.lane;
    const bf16* OB = (const bf16*)(ws + WS_OBUF); const float* LSE = (const float*)(ws + WS_LSE); bf16* AT = (bf16*)(ws + WS_ATTN);
    const int c = 4 * lane, h = lane >> 4;
    const bool cls_map = NGW * 8 == NTOK_P; const int cls_w = NGW / 8 > 0 ? NGW / 8 : 1, cls = gw / cls_w, wl_ = gw - cls * cls_w;
    const int npass = cls_map ? 3 : (MPAD + 4 * NGW - 1) / (4 * NGW);
    for (int pass = 0; pass < npass; ++pass) {
        int mrow[4];
#pragma unroll
        for (int u = 0; u < 4; ++u) { mrow[u] = MPAD;
            if (!cls_map) mrow[u] = gw + (4 * pass + u) * NGW;
            else if (pass < 2) mrow[u] = gw * 8 + 4 * pass + u;
            else if (u == 0 && wl_ < 16) mrow[u] = NTOK_P + 16 * cls + wl_;
            else if (u == 0 && wl_ < 32) mrow[u] = NTOK + 16 * cls + wl_ - 16; }
        float l[4][3]; u32x2_t ob[4][3];
#pragma unroll
        for (int u = 0; u < 4; ++u) { const int m = mrow[u];
#pragma unroll
            for (int g = 0; g < 3; ++g) { l[u][g] = 0.f; ob[u][g] = (u32x2_t){0u, 0u}; }
            if (m < NTOK) {
#pragma unroll
                for (int g = 0; g < 3; ++g) { l[u][g] = LSE[(size_t)m * 12 + 4 * g + h]; ob[u][g] = *(const u32x2_t*)(OB + (size_t)m * 768 + 256 * g + c); } } }
#pragma unroll
        for (int u = 0; u < 4; ++u) { const int m = mrow[u];
            if (m < MPAD) {
                unsigned long long o = 0ull;
                if (m < NTOK) {
                    const float l0 = l[u][0], l1 = l[u][1], l2 = l[u][2];
                    const u32x2_t o0 = ob[u][0], o1 = ob[u][1], o2 = ob[u][2];
                    const float mx = fmaxf(fmaxf(l0, l1), l2);
                    float a0 = __expf(l0 - mx), a1 = __expf(l1 - mx), a2 = __expf(l2 - mx);
                    const float rs = 1.0f / (a0 + a1 + a2); a0 *= rs; a1 *= rs; a2 *= rs;
                    const float v0 = a0 * bflo(o0.x) + a1 * bflo(o1.x) + a2 * bflo(o2.x), v1 = a0 * bfhi(o0.x) + a1 * bfhi(o1.x) + a2 * bfhi(o2.x);
                    const float v2 = a0 * bflo(o0.y) + a1 * bflo(o1.y) + a2 * bflo(o2.y), v3 = a0 * bfhi(o0.y) + a1 * bfhi(o1.y) + a2 * bfhi(o2.y);
                    o = (unsigned long long)pk2(v0, v1) | ((unsigned long long)pk2(v2, v3) << 32);
                }
                *(GAS unsigned long long*)(AT + (size_t)m * 256 + c) = o;
            } }
    }
}

__device__ __forceinline__ void p8_final(Frame& F, const In& I, unsigned char* ws, float* out) {
    const int gw = F.vcu * NWAVES + F.wave, NGW = F.G * NWAVES, lane = F.lane;
    const bf16* X3 = (const bf16*)(ws + WS_X1); const float* ss3 = (const float*)(ws + WS_STAT) + 3 * (size_t)MPAD;
    f32x4 nf[4];
#pragma unroll
    for (int j = 0; j < 4; ++j) nf[j] = ((const f32x4*)I.norm_final)[lane + 64 * j];
    const bool cls_map = NGW * 8 == NTOK_P;
    const int cls_w = NGW / 8 > 0 ? NGW / 8 : 1, cls = gw / cls_w, wl_ = gw - cls * cls_w;
    const int npass = cls_map ? 3 : (NTOK + 4 * NGW - 1) / (4 * NGW);
    for (int pass = 0; pass < npass; ++pass) {
        int mrow[4];
#pragma unroll
        for (int u = 0; u < 4; ++u) { mrow[u] = -1;
            if (!cls_map) { const int m = gw + (4 * pass + u) * NGW; mrow[u] = m < NTOK ? m : -1; }
            else if (pass < 2) mrow[u] = gw * 8 + 4 * pass + u;
            else if (u == 0 && wl_ < 16) mrow[u] = NTOK_P + 16 * cls + wl_; }
        u32x2_t v[4][4]; float q[4];
#pragma unroll
        for (int u = 0; u < 4; ++u) { const int m = mrow[u]; q[u] = 1.f;
#pragma unroll
            for (int j = 0; j < 4; ++j) v[u][j] = (u32x2_t){0u, 0u};
            if (m >= 0) { q[u] = ss3[m]; const u32x2_t* xr = (const u32x2_t*)(X3 + (size_t)m * DM) + lane;
#pragma unroll
                for (int j = 0; j < 4; ++j) v[u][j] = xr[64 * j]; } }
#pragma unroll
        for (int u = 0; u < 4; ++u) { const int m = mrow[u];
            if (m >= 0) {
                const float rs = 1.0f / sqrtf(q[u] * (1.0f / DM) + 1e-6f);
                f32x4* orow = (f32x4*)(out + (m < NTOK_P ? OFF_Y_P + (size_t)m * DM : OFF_Y_S + (size_t)(m - NTOK_P) * DM)) + lane;
#pragma unroll
                for (int j = 0; j < 4; ++j) orow[64 * j] = (f32x4){bflo(v[u][j].x), bfhi(v[u][j].x), bflo(v[u][j].y), bfhi(v[u][j].y)} * rs * nf[j];
            } }
    }
}
constexpr int PA_P = 144;
constexpr int PA_AT = 0, PA_RT = 9216, PA_BT = 18432, PA_KT = 27648;
constexpr int PA_AC = 36864, PA_BGC = 46080, PA_KGC = 55296, PA_VC = 64512;
constexpr int PA_NT = 73728;
constexpr int PA_N01 = 82944;
constexpr int PA_MKA = 85504, PA_NR = 94720, PA_MKR = 103936;
constexpr int PA_TR = 113152;
constexpr int PA_XU = 118272;
constexpr int PA_ND2 = 127488;
constexpr int PA_TT = PA_AT, PA_W1 = PA_BT, PA_U0 = PA_KT;
static_assert(PA_ND2 + 2560 <= RING_BYTES && PA_XU + 9216 <= PA_ND2, "pass A LDS");
constexpr int CH = 64;
constexpr int NUNIT = 32 * (SEQ / CH);
typedef __attribute__((address_space(3))) unsigned char* ldsp_t;
__device__ __forceinline__ bf16x8 lfrag(ldsp_t base, int row, int kbyte) { return *(const LAS bf16x8*)(base + row * PA_P + kbyte); }
typedef short s16x4_t __attribute__((ext_vector_type(4)));
__device__ __forceinline__ bf16x8 cat4(s16x4_t lo, s16x4_t hi) { return (bf16x8){lo[0], lo[1], lo[2], lo[3], hi[0], hi[1], hi[2], hi[3]}; }
__device__ __forceinline__ unsigned short f2bf16(float f) { return (unsigned short)pk2(f, f); }
__device__ __forceinline__ float dppsum16(float v) {
    DPP_ADD(v, 0xb1, 0xf); DPP_ADD(v, 0x4e, 0xf); DPP_ADD(v, 0x141, 0xf); DPP_ADD(v, 0x140, 0xf); return v; }

struct PaBufs { bf16* Pg; bf16* Qg; bf16* Gg; bf16* Yb; float* gam; float* rk; };

struct PaRaw { unsigned short zr[8], zk[8], zv[8], lw[8], aa[8]; unsigned short pr, pk, pv; float mu_r, mu_k, mu_v, kk_c, ka_c, rk_c; };
__device__ __forceinline__ void pa_load(PaRaw& R, const In& I, const bf16* Z, const bf16* LW, const bf16* AA, int unit, int w, int c) {
    const int seq = unit >> 7, ch = unit & 127, b = seq >> 4, h = seq & 15;
    const size_t m0 = (size_t)b * SEQ + (size_t)ch * CH + 8 * w; const unsigned uc = (unsigned)(h * 64 + c);
#pragma unroll
    for (int tt = 0; tt < 8; ++tt) { const bf16* zrow = Z + (m0 + tt) * ZC;
        R.zr[tt] = zrow[uc]; R.zk[tt] = zrow[uc + 1024u]; R.zv[tt] = zrow[uc + 2048u]; R.lw[tt] = LW[(m0 + tt) * 1024 + uc]; R.aa[tt] = AA[(m0 + tt) * 1024 + uc]; }
    if (ch == 0 && w == 0) { R.pr = 0; R.pk = 0; R.pv = 0; }
    else { const bf16* zrow = Z + (m0 - 1) * ZC; R.pr = zrow[uc]; R.pk = zrow[uc + 1024u]; R.pv = zrow[uc + 2048u]; }
    R.mu_r = I.shift_mu[uc]; R.mu_k = I.shift_mu[1024u + uc]; R.mu_v = I.shift_mu[2048u + uc]; R.kk_c = I.k_k[uc]; R.ka_c = I.k_a[uc]; R.rk_c = I.r_k[uc];
}

__device__ __forceinline__ void passA_unit(Frame& F, const In& I, const PaBufs& B, int unit, PaRaw& R, int next_unit, const bf16* Zc, const bf16* LWc, const bf16* AAc) {
    int lane = F.lane; asm volatile("" : "+v"(lane));
    const int w = F.wave; int r = lane & 15, q = lane >> 4;
    const int seq = unit >> 7, ch = unit & 127, bb_ = seq >> 4, h = seq & 15;
    const size_t row0 = (size_t)bb_ * SEQ + (size_t)ch * CH;
    ldsp_t L = F.lds + RING_OFF;
#ifdef PROBE_PA_REP
#define REP_BEGIN(n) _Pragma("unroll 1") for (int rep_ = 0; rep_ < ((n) == PROBE_PA_REP ? 2 : 1); ++rep_) {
#define REP_END() }
#else
#define REP_BEGIN(n) {
#define REP_END() }
#endif
#define PA_RELAUNDER() do { asm volatile("" : "+v"(lane)); r = lane & 15; q = lane >> 4; } while (0)
    REP_BEGIN(1)
    {
        const int c = lane, col = h * 64 + c;
        const float mu_r = R.mu_r, mu_k = R.mu_k, mu_v = R.mu_v, kk_c = R.kk_c, ka_c = R.ka_c, rk_c = R.rk_c;
        float rr[8], kkn[8], kp[8], bb[8], vv[8], lw[8], ll[8], s1[8], s2[8], kkv[8];
        float pr = bf2f(R.pr), pk = bf2f(R.pk), pv = bf2f(R.pv), run = 0.f;
#pragma unroll
        for (int tt = 0; tt < 8; ++tt) {
            const float zr = bf2f(R.zr[tt]), zk = bf2f(R.zk[tt]), zv = bf2f(R.zv[tt]), aa = bf2f(R.aa[tt]);
            const float rv = zr + (pr - zr) * mu_r, kv = zk + (pk - zk) * mu_k; vv[tt] = zv + (pv - zv) * mu_v; pr = zr; pk = zk; pv = zv;
            kkv[tt] = kv * kk_c; kp[tt] = kv * (1.0f + (aa - 1.0f) * ka_c); rr[tt] = rv; bb[tt] = aa;
            s1[tt] = kkv[tt] * kkv[tt]; s2[tt] = rv * kp[tt] * rk_c;
            lw[tt] = bf2f(R.lw[tt]); run += lw[tt]; ll[tt] = run;
        }
#define PA_DPP8(x, ctrl, rmask) _Pragma("unroll") for (int tt = 0; tt < 8; ++tt) DPP_ADD(x[tt], ctrl, rmask)
        PA_DPP8(s1, 0xb1, 0xf); PA_DPP8(s2, 0xb1, 0xf); PA_DPP8(s1, 0x4e, 0xf); PA_DPP8(s2, 0x4e, 0xf); PA_DPP8(s1, 0x114, 0xf); PA_DPP8(s2, 0x114, 0xf);
        PA_DPP8(s1, 0x118, 0xf); PA_DPP8(s2, 0x118, 0xf); PA_DPP8(s1, 0x142, 0xa); PA_DPP8(s2, 0x142, 0xa); PA_DPP8(s1, 0x143, 0xc); PA_DPP8(s2, 0x143, 0xc);
#undef PA_DPP8
#pragma unroll
        for (int tt = 0; tt < 8; ++tt) {
            const float n2 = __builtin_bit_cast(float, __builtin_amdgcn_readlane(__builtin_bit_cast(int, s1[tt]), 63)), rk = __builtin_bit_cast(float, __builtin_amdgcn_readlane(__builtin_bit_cast(int, s2[tt]), 63));
            kkn[tt] = kkv[tt] / fmaxf(sqrtf(n2), 1e-12f); bb[tt] = kkn[tt] * bb[tt];
            if (lane == 0) B.rk[(row0 + 8 * w + tt) * 16 + h] = rk;
        }
        LAS float* pre = (LAS float*)(L + PA_NT);
        pre[w * 64 + c] = run;
        __syncthreads();
        float off = 0.f, tot = 0.f;
#pragma unroll
        for (int ww = 0; ww < 8; ++ww) { const float p = pre[ww * 64 + c]; tot += p; if (ww < w) off += p; }
        const float etot = __expf(tot);
        if (w == 0) B.gam[(size_t)unit * 64 + c] = etot;
        unsigned short a_[8], r_[8], b_[8], k_[8], bg_[8], kg_[8], v_[8];
        float e1 = __expf(off);
#pragma unroll
        for (int tt = 0; tt < 8; ++tt) {
            const float Lc = off + ll[tt], e3 = __expf(Lc), e2 = __expf(-Lc), eg = etot * e2;
            a_[tt] = f2bf16(-kkn[tt] * e1); r_[tt] = f2bf16(rr[tt] * e3); b_[tt] = f2bf16(bb[tt] * e2); k_[tt] = f2bf16(kp[tt] * e2);
            bg_[tt] = f2bf16(bb[tt] * eg); kg_[tt] = f2bf16(kp[tt] * eg); v_[tt] = f2bf16(vv[tt]);
            e1 = e3;
            const int t = 8 * w + tt;
            *(LAS unsigned short*)(L + PA_AT + t * PA_P + 2 * c) = a_[tt]; *(LAS unsigned short*)(L + PA_RT + t * PA_P + 2 * c) = r_[tt];
            *(LAS unsigned short*)(L + PA_BT + t * PA_P + 2 * c) = b_[tt]; *(LAS unsigned short*)(L + PA_KT + t * PA_P + 2 * c) = k_[tt];
        }
#define PK8(x) (v4u){(unsigned)x[0] | ((unsigned)x[1] << 16), (unsigned)x[2] | ((unsigned)x[3] << 16), (unsigned)x[4] | ((unsigned)x[5] << 16), (unsigned)x[6] | ((unsigned)x[7] << 16)}
        *(LAS v4u*)(L + PA_AC + c * PA_P + 16 * w) = PK8(a_); *(LAS v4u*)(L + PA_BGC + c * PA_P + 16 * w) = PK8(bg_);
        *(LAS v4u*)(L + PA_KGC + c * PA_P + 16 * w) = PK8(kg_); *(LAS v4u*)(L + PA_VC + c * PA_P + 16 * w) = PK8(v_);
#undef PK8
    }
    __syncthreads(); PA_RELAUNDER();
    REP_END()
    REP_BEGIN(2)
    {
        const int job = w >> 1, half = w & 1;
        ldsp_t Am = L + (job < 2 ? PA_AT : PA_RT), Bm = L + ((job & 1) ? PA_KT : PA_BT);
#pragma unroll
        for (int t2 = 0; t2 < 2; ++t2) {
            const int tt = 2 * half + t2;
            const bf16x8 a0 = lfrag(Am, 16 * tt + r, 16 * q), a1 = lfrag(Am, 16 * tt + r, 64 + 16 * q);
#pragma unroll
            for (int it = 0; it < 4; ++it) {
                f32x4 acc = (f32x4){0.f, 0.f, 0.f, 0.f};
                if (job == 0) {
                    if (it <= tt) { const bf16x8 b0 = lfrag(Bm, 16 * it + r, 16 * q), b1 = lfrag(Bm, 16 * it + r, 64 + 16 * q);
                        acc = __builtin_amdgcn_mfma_f32_16x16x32_bf16(a0, b0, acc, 0, 0, 0); acc = __builtin_amdgcn_mfma_f32_16x16x32_bf16(a1, b1, acc, 0, 0, 0); }
                    const int i = 16 * it + r;
#pragma unroll
                    for (int rg = 0; rg < 4; ++rg) { const int t = 16 * tt + 4 * q + rg; if (!(i < t)) acc[rg] = 0.f; }
                    *(LAS u32x2_t*)(L + PA_NT + i * PA_P + (16 * tt + 4 * q) * 2) = (u32x2_t){pk2(acc[0], acc[1]), pk2(acc[2], acc[3])};
                    if (it == tt) *(LAS f32x4*)(L + (tt < 2 ? PA_N01 + tt * 1280 : PA_ND2 + (tt - 2) * 1280) + r * 80 + 16 * q) = acc;
                } else {
                    if (it <= tt) { const bf16x8 b0 = lfrag(Bm, 16 * it + r, 16 * q), b1 = lfrag(Bm, 16 * it + r, 64 + 16 * q);
                        acc = __builtin_amdgcn_mfma_f32_16x16x32_bf16(b0, a0, acc, 0, 0, 0); acc = __builtin_amdgcn_mfma_f32_16x16x32_bf16(b1, a1, acc, 0, 0, 0); }
                    const int t = 16 * tt + r;
#pragma unroll
                    for (int rg = 0; rg < 4; ++rg) { const int i = 16 * it + 4 * q + rg; const bool keep = (job == 1) ? (i < t) : (i <= t); if (!keep) acc[rg] = 0.f; }
                    ldsp_t Om = L + (job == 1 ? PA_MKA : (job == 2 ? PA_NR : PA_MKR));
                    *(LAS u32x2_t*)(Om + t * PA_P + (16 * it + 4 * q) * 2) = (u32x2_t){pk2(acc[0], acc[1]), pk2(acc[2], acc[3])};
                }
            }
        }
    }
    __syncthreads(); PA_RELAUNDER();
    REP_END()
    REP_BEGIN(3)
    if (w == 0) {
        const int blk = lane >> 4, i = lane & 15;
        f32x2_t tr[8];
#pragma unroll
        for (int p2 = 0; p2 < 8; ++p2) tr[p2] = (f32x2_t){(2 * p2 == i) ? 1.f : 0.f, (2 * p2 + 1 == i) ? 1.f : 0.f};
        const LAS float* nb = (const LAS float*)(L + (blk < 2 ? PA_N01 + blk * 1280 : PA_ND2 + (blk - 2) * 1280));
#pragma unroll
        for (int j = 0; j < 15; ++j) {
            const LAS float* nbj = nb;
            if (j > 2) { const float dep = ((j - 3) & 1) ? tr[(j - 3) >> 1].y : tr[(j - 3) >> 1].x; asm volatile("" : "+v"(nbj) : "v"(dep)); } else asm volatile("" : "+v"(nbj));
            f32x4 cur[4];
#pragma unroll
            for (int q4 = (j + 1) / 4; q4 < 4; ++q4) cur[q4] = *(const LAS f32x4*)(nbj + j * 20 + 4 * q4);
            const float sc = (j & 1) ? tr[j >> 1].y : tr[j >> 1].x;
            const f32x2_t sc2 = {sc, sc};
#pragma unroll
            for (int p2 = (j + 1) >> 1; p2 < 8; ++p2) tr[p2] += sc2 * ((p2 & 1) ? __builtin_shufflevector(cur[p2 >> 1], cur[p2 >> 1], 2, 3) : __builtin_shufflevector(cur[p2 >> 1], cur[p2 >> 1], 0, 1));
        }
        unsigned tp[8];
#pragma unroll
        for (int p2 = 0; p2 < 8; ++p2) { tp[p2] = pk2(tr[p2].x, tr[p2].y);
            *(LAS unsigned short*)(L + PA_TT + (16 * blk + 2 * p2) * PA_P + (16 * blk + i) * 2) = (unsigned short)(tp[p2] & 0xffffu);
            *(LAS unsigned short*)(L + PA_TT + (16 * blk + 2 * p2 + 1) * PA_P + (16 * blk + i) * 2) = (unsigned short)(tp[p2] >> 16); }
        *(LAS v4u*)(L + PA_TR + blk * 768 + i * 48) = (v4u){tp[0], tp[1], tp[2], tp[3]}; *(LAS v4u*)(L + PA_TR + blk * 768 + i * 48 + 16) = (v4u){tp[4], tp[5], tp[6], tp[7]};
    } else if (w == 1) {
        const int t = lane;
#pragma unroll
        for (int bb2 = 0; bb2 < 4; ++bb2) if (bb2 != (t >> 4)) { *(LAS v4u*)(L + PA_TT + t * PA_P + 32 * bb2) = (v4u){0u, 0u, 0u, 0u}; *(LAS v4u*)(L + PA_TT + t * PA_P + 32 * bb2 + 16) = (v4u){0u, 0u, 0u, 0u}; }
    } else if (w >= 4) {
        const int vt = w - 4;
        const bf16x8 a0 = lfrag(L + PA_VC, 16 * vt + r, 16 * q), a1 = lfrag(L + PA_VC, 16 * vt + r, 64 + 16 * q);
#pragma unroll
        for (int tt = 0; tt < 4; ++tt) {
            const bf16x8 b0 = lfrag(L + PA_MKA, 16 * tt + r, 16 * q), b1 = lfrag(L + PA_MKA, 16 * tt + r, 64 + 16 * q);
            f32x4 acc = (f32x4){0.f, 0.f, 0.f, 0.f};
            acc = __builtin_amdgcn_mfma_f32_16x16x32_bf16(b0, a0, acc, 0, 0, 0); acc = __builtin_amdgcn_mfma_f32_16x16x32_bf16(b1, a1, acc, 0, 0, 0);
            *(LAS u32x2_t*)(L + PA_XU + (16 * vt + r) * PA_P + (16 * tt + 4 * q) * 2) = (u32x2_t){pk2(acc[0], acc[1]), pk2(acc[2], acc[3])};
        }
    }
    __syncthreads(); PA_RELAUNDER();
    REP_END()
    REP_BEGIN(4)
#pragma unroll
    for (int lev = 1; lev <= 3; ++lev) {
        if (w + lev <= 3) {
            const int a = w, b = w + lev;
            f32x4 m = (f32x4){0.f, 0.f, 0.f, 0.f};
            if (a == 0) m = __builtin_amdgcn_mfma_f32_16x16x32_bf16(lfrag(L + PA_NT, 16 * a + r, 16 * q), lfrag(L + PA_TT, 16 * b + r, 16 * q), m, 0, 0, 0);
            if (a >= 1 || b >= 2) m = __builtin_amdgcn_mfma_f32_16x16x32_bf16(lfrag(L + PA_NT, 16 * a + r, 64 + 16 * q), lfrag(L + PA_TT, 16 * b + r, 64 + 16 * q), m, 0, 0, 0);
            const u32x4_t mp = (u32x4_t){pk2(m[0], m[1]), pk2(m[2], m[3]), 0u, 0u};
            const s16x4_t alo = *(const LAS s16x4_t*)(L + PA_TR + a * 768 + r * 48 + (4 * q) * 2);
            f32x4 acc = (f32x4){0.f, 0.f, 0.f, 0.f};
            acc = __builtin_amdgcn_mfma_f32_16x16x32_bf16(cat4(alo, (s16x4_t){0, 0, 0, 0}), __builtin_bit_cast(bf16x8, mp), acc, 0, 0, 0);
            *(LAS u32x2_t*)(L + PA_TT + (16 * b + r) * PA_P + (16 * a + 4 * q) * 2) = (u32x2_t){pk2(acc[0], acc[1]), pk2(acc[2], acc[3])};
        }
        __syncthreads(); PA_RELAUNDER();
    }
    REP_END()
    if (next_unit < NUNIT) pa_load(R, I, Zc, LWc, AAc, next_unit, w, lane);
    REP_BEGIN(5)
    {
        const int rt = w & 3;
        ldsp_t Am = L + (w < 4 ? PA_AC : PA_XU), Om = L + (w < 4 ? PA_W1 : PA_U0);
        const bf16x8 a0 = lfrag(Am, 16 * rt + r, 16 * q), a1 = lfrag(Am, 16 * rt + r, 64 + 16 * q);
#pragma unroll
        for (int tt = 0; tt < 4; ++tt) {
            const bf16x8 b0 = lfrag(L + PA_TT, 16 * tt + r, 16 * q), b1 = lfrag(L + PA_TT, 16 * tt + r, 64 + 16 * q);
            f32x4 acc = (f32x4){0.f, 0.f, 0.f, 0.f};
            acc = __builtin_amdgcn_mfma_f32_16x16x32_bf16(b0, a0, acc, 0, 0, 0); acc = __builtin_amdgcn_mfma_f32_16x16x32_bf16(b1, a1, acc, 0, 0, 0);
            *(LAS u32x2_t*)(Om + (16 * rt + r) * PA_P + (16 * tt + 4 * q) * 2) = (u32x2_t){pk2(acc[0], acc[1]), pk2(acc[2], acc[3])};
        }
    }
    __syncthreads(); PA_RELAUNDER();
    REP_END()
    REP_BEGIN(6)
    if (w < 4) {
        const int kt = w;
        {
            const bf16x8 a0 = lfrag(L + PA_W1, 16 * kt + r, 16 * q), a1 = lfrag(L + PA_W1, 16 * kt + r, 64 + 16 * q);
#pragma unroll
            for (int k2 = 0; k2 < 4; ++k2) {
                const bf16x8 b0 = lfrag(L + PA_BGC, 16 * k2 + r, 16 * q), b1 = lfrag(L + PA_BGC, 16 * k2 + r, 64 + 16 * q);
                f32x4 acc = (f32x4){0.f, 0.f, 0.f, 0.f};
                acc = __builtin_amdgcn_mfma_f32_16x16x32_bf16(a0, b0, acc, 0, 0, 0); acc = __builtin_amdgcn_mfma_f32_16x16x32_bf16(a1, b1, acc, 0, 0, 0);
                *(LAS u32x2_t*)(L + PA_AC + (16 * k2 + r) * PA_P + (32 * (kt >> 1) + 8 * q + 4 * (kt & 1)) * 2) = (u32x2_t){pk2(acc[0], acc[1]), pk2(acc[2], acc[3])};
            }
        }
        {
            const bf16x8 a0 = lfrag(L + PA_BGC, 16 * kt + r, 16 * q), a1 = lfrag(L + PA_BGC, 16 * kt + r, 64 + 16 * q), a2 = lfrag(L + PA_KGC, 16 * kt + r, 16 * q), a3 = lfrag(L + PA_KGC, 16 * kt + r, 64 + 16 * q);
#pragma unroll
            for (int vt = 0; vt < 4; ++vt) {
                const bf16x8 b0 = lfrag(L + PA_U0, 16 * vt + r, 16 * q), b1 = lfrag(L + PA_U0, 16 * vt + r, 64 + 16 * q), b2 = lfrag(L + PA_VC, 16 * vt + r, 16 * q), b3 = lfrag(L + PA_VC, 16 * vt + r, 64 + 16 * q);
                f32x4 acc = (f32x4){0.f, 0.f, 0.f, 0.f};
                acc = __builtin_amdgcn_mfma_f32_16x16x32_bf16(a0, b0, acc, 0, 0, 0); acc = __builtin_amdgcn_mfma_f32_16x16x32_bf16(a1, b1, acc, 0, 0, 0);
                acc = __builtin_amdgcn_mfma_f32_16x16x32_bf16(a2, b2, acc, 0, 0, 0); acc = __builtin_amdgcn_mfma_f32_16x16x32_bf16(a3, b3, acc, 0, 0, 0);
                *(LAS u32x2_t*)(L + PA_NT + (16 * vt + r) * PA_P + (16 * kt + 4 * q) * 2) = (u32x2_t){pk2(acc[0], acc[1]), pk2(acc[2], acc[3])};
            }
        }
    } else {
        const int xt = w - 4;
        {
            const bf16x8 a0 = lfrag(L + PA_W1, 16 * xt + r, 16 * q), a1 = lfrag(L + PA_W1, 16 * xt + r, 64 + 16 * q);
#pragma unroll
            for (int tt = 0; tt < 4; ++tt) {
                const bf16x8 b0 = lfrag(L + PA_NR, 16 * tt + r, 16 * q), b1 = lfrag(L + PA_NR, 16 * tt + r, 64 + 16 * q);
                const u32x2_t rv = *(const LAS u32x2_t*)(L + PA_RT + (16 * tt + r) * PA_P + (16 * xt + 4 * q) * 2);
                f32x4 acc = (f32x4){bflo(rv.x), bfhi(rv.x), bflo(rv.y), bfhi(rv.y)};
                acc = __builtin_amdgcn_mfma_f32_16x16x32_bf16(a0, b0, acc, 0, 0, 0); acc = __builtin_amdgcn_mfma_f32_16x16x32_bf16(a1, b1, acc, 0, 0, 0);
                *(LAS u32x2_t*)(L + PA_MKA + (16 * tt + r) * PA_P + (16 * xt + 4 * q) * 2) = (u32x2_t){pk2(acc[0], acc[1]), pk2(acc[2], acc[3])};
            }
        }
        {
            const bf16x8 a0 = lfrag(L + PA_U0, 16 * xt + r, 16 * q), a1 = lfrag(L + PA_U0, 16 * xt + r, 64 + 16 * q), a2 = lfrag(L + PA_VC, 16 * xt + r, 16 * q), a3 = lfrag(L + PA_VC, 16 * xt + r, 64 + 16 * q);
#pragma unroll
            for (int tt = 0; tt < 4; ++tt) {
                const bf16x8 b0 = lfrag(L + PA_NR, 16 * tt + r, 16 * q), b1 = lfrag(L + PA_NR, 16 * tt + r, 64 + 16 * q), b2 = lfrag(L + PA_MKR, 16 * tt + r, 16 * q), b3 = lfrag(L + PA_MKR, 16 * tt + r, 64 + 16 * q);
                f32x4 acc = (f32x4){0.f, 0.f, 0.f, 0.f};
                acc = __builtin_amdgcn_mfma_f32_16x16x32_bf16(a0, b0, acc, 0, 0, 0); acc = __builtin_amdgcn_mfma_f32_16x16x32_bf16(a1, b1, acc, 0, 0, 0);
                acc = __builtin_amdgcn_mfma_f32_16x16x32_bf16(a2, b2, acc, 0, 0, 0); acc = __builtin_amdgcn_mfma_f32_16x16x32_bf16(a3, b3, acc, 0, 0, 0);
                *(LAS u32x2_t*)(L + PA_XU + (16 * tt + r) * PA_P + (16 * xt + 4 * q) * 2) = (u32x2_t){pk2(acc[0], acc[1]), pk2(acc[2], acc[3])};
            }
        }
    }
    __syncthreads(); PA_RELAUNDER();
    {
        const int row = 8 * w + (lane >> 3), cb = (lane & 7) * 16;
        *(v4u*)((char*)(B.Pg + (size_t)unit * 4096) + ((((row >> 4) * 2 + ((lane & 7) >> 2)) * 64 + (lane & 3) * 16 + (row & 15)) * 16)) = *(const LAS v4u*)(L + PA_AC + row * PA_P + cb);
        *(v4u*)((char*)(B.Qg + (size_t)unit * 4096) + row * 128 + cb) = *(const LAS v4u*)(L + PA_NT + row * PA_P + cb);
        *(v4u*)((char*)(B.Gg + (size_t)unit * 4096) + row * 128 + cb) = *(const LAS v4u*)(L + PA_MKA + row * PA_P + cb);
        *(v4u*)((char*)(B.Yb + (size_t)unit * 4096) + row * 128 + cb) = *(const LAS v4u*)(L + PA_XU + row * PA_P + cb);
    }
    __syncthreads();
    REP_END()
#undef PA_RELAUNDER
#undef REP_BEGIN
#undef REP_END
}

struct ChOp { bf16x8 pf[4][2]; u32x2_t qv[4]; f32x4 g4[4]; };
__device__ __forceinline__ void ch_load(ChOp& o, const PaBufs& B, size_t unit, int ct, int a, int q) {
    const bf16* Pg = B.Pg + unit * 4096; const bf16* Qg = B.Qg + unit * 4096; const float* gm = B.gam + unit * 64;
#pragma unroll
    for (int rt = 0; rt < 4; ++rt) {
        o.qv[rt] = *(const u32x2_t*)(Qg + (16 * ct + a) * 64 + 16 * rt + 4 * q); o.g4[rt] = *(const f32x4*)(gm + 16 * rt + 4 * q);
#pragma unroll
        for (int ks = 0; ks < 2; ++ks) o.pf[rt][ks] = *(const bf16x8*)(Pg + (16 * rt + a) * 64 + 32 * ks + 8 * q);
    }
}
template <bool STORE> __device__ __forceinline__ void ch_step(f32x4 (&st)[4], const ChOp& o, const PaBufs& B, size_t unit, int ct, int a, int q) {
    bf16x8 sf[2]; u32x2_t sb[4];
#pragma unroll
    for (int rt = 0; rt < 4; ++rt) sb[rt] = (u32x2_t){pk2(st[rt][0], st[rt][1]), pk2(st[rt][2], st[rt][3])};
#pragma unroll
    for (int ks = 0; ks < 2; ++ks) sf[ks] = __builtin_bit_cast(bf16x8, (u32x4_t){sb[2 * ks].x, sb[2 * ks].y, sb[2 * ks + 1].x, sb[2 * ks + 1].y});
    bf16* Qg = B.Qg + unit * 4096;
#pragma unroll
    for (int rt = 0; rt < 4; ++rt) if (STORE) *(u32x2_t*)(Qg + (16 * ct + a) * 64 + 16 * rt + 4 * q) = sb[rt];
    f32x4 nw[4];
#pragma unroll
    for (int rt = 0; rt < 4; ++rt) {
        f32x4 acc = (f32x4){bflo(o.qv[rt].x), bfhi(o.qv[rt].x), bflo(o.qv[rt].y), bfhi(o.qv[rt].y)} + st[rt] * o.g4[rt];
#pragma unroll
        for (int ks = 0; ks < 2; ++ks) acc = __builtin_amdgcn_mfma_f32_16x16x32_bf16(o.pf[rt][ks], sf[ks], acc, 0, 0, 0);
        nw[rt] = acc;
    }
#pragma unroll
    for (int rt = 0; rt < 4; ++rt) st[rt] = nw[rt];
}
template <bool STORE> __device__ __forceinline__ void chain2(Frame& F, const PaBufs& B, float* out, int seq, int ct, unsigned* prog) {
    const int lane = F.lane, a = lane & 15, q = lane >> 4;
    f32x4 st[4];
#pragma unroll
    for (int rt = 0; rt < 4; ++rt) st[rt] = (f32x4){0.f, 0.f, 0.f, 0.f};
    const size_t u0 = (size_t)seq * (SEQ / CH);
    ChOp oa, ob, oc;
    ch_load(oa, B, u0, ct, a, q); ch_load(ob, B, u0 + 1, ct, a, q);
    int c = 0;
    for (; c + 3 <= SEQ / CH - 2; c += 3) {
        ch_load(oc, B, u0 + c + 2, ct, a, q); ch_step<STORE>(st, oa, B, u0 + c, ct, a, q);
        ch_load(oa, B, u0 + c + 3, ct, a, q); ch_step<STORE>(st, ob, B, u0 + c + 1, ct, a, q);
        ch_load(ob, B, u0 + c + 4, ct, a, q); ch_step<STORE>(st, oc, B, u0 + c + 2, ct, a, q);
    }
    ch_step<STORE>(st, oa, B, u0 + c, ct, a, q); ch_step<STORE>(st, ob, B, u0 + c + 1, ct, a, q);
    float* dst = out + OFF_WKV_P + (size_t)seq * 4096 + (size_t)(16 * ct + a) * 64 + 4 * q;
#pragma unroll
    for (int rt = 0; rt < 4; ++rt) { if (STORE) *(f32x4*)(dst + 16 * rt) = st[rt]; else asm volatile("" :: "v"(st[rt])); }
}

struct ChOp3 { bf16x8 pf[4][2]; u32x2_t qv[4]; };
__device__ __forceinline__ void ch_load3(ChOp3& o, const PaBufs& B, size_t unit, int ct, int a, int q) {
    const bf16* Pg = B.Pg + unit * 4096; const bf16* Qg = B.Qg + unit * 4096;
#pragma unroll
    for (int rt = 0; rt < 4; ++rt) {
        o.qv[rt] = *(const u32x2_t*)(Qg + (16 * ct + a) * 64 + 16 * rt + 4 * q);
#pragma unroll
        for (int ks = 0; ks < 2; ++ks) o.pf[rt][ks] = *(const bf16x8*)(Pg + ((rt * 2 + ks) * 64 + q * 16 + a) * 8);
    }
}
__device__ __forceinline__ void ch_gam_stage(LAS float* tbl, const float* gm, int lane) {
    f32x4 v[16];
#pragma unroll
    for (int i = 0; i < 16; ++i) v[i] = *(const f32x4*)(gm + (size_t)(i * 64 + lane) * 4);
#pragma unroll
    for (int i = 0; i < 16; ++i) *(LAS f32x4*)(tbl + (i * 64 + lane) * 4) = v[i];
}
__device__ __forceinline__ void ch_gam_read(f32x4 (&g)[4], const LAS float* tbl, int c, int q) {
#pragma unroll
    for (int rt = 0; rt < 4; ++rt) g[rt] = *(const LAS f32x4*)(tbl + (c & 63) * 64 + 16 * rt + 4 * q);
}
__device__ __forceinline__ void ch_step3(f32x4 (&st)[4], const ChOp3& o, const f32x4 (&g4)[4], const PaBufs& B, size_t unit, int ct, int a, int q) {
    bf16x8 sf[2]; u32x2_t sb[4];
#pragma unroll
    for (int rt = 0; rt < 4; ++rt) sb[rt] = (u32x2_t){pk2(st[rt][0], st[rt][1]), pk2(st[rt][2], st[rt][3])};
#pragma unroll
    for (int ks = 0; ks < 2; ++ks) sf[ks] = __builtin_bit_cast(bf16x8, (u32x4_t){sb[2 * ks].x, sb[2 * ks].y, sb[2 * ks + 1].x, sb[2 * ks + 1].y});
    bf16* Qg = B.Qg + unit * 4096;
#pragma unroll
    for (int rt = 0; rt < 4; ++rt) *(u32x2_t*)(Qg + (16 * ct + a) * 64 + 16 * rt + 4 * q) = sb[rt];
    f32x4 nw[4];
#pragma unroll
    for (int rt = 0; rt < 4; ++rt) nw[rt] = (f32x4){bflo(o.qv[rt].x), bfhi(o.qv[rt].x), bflo(o.qv[rt].y), bfhi(o.qv[rt].y)} + st[rt] * g4[rt];
#pragma unroll
    for (int rt = 0; rt < 4; ++rt) nw[rt] = __builtin_amdgcn_mfma_f32_16x16x32_bf16(o.pf[rt][0], sf[0], nw[rt], 0, 0, 0);
#pragma unroll
    for (int rt = 0; rt < 4; ++rt) nw[rt] = __builtin_amdgcn_mfma_f32_16x16x32_bf16(o.pf[rt][1], sf[1], nw[rt], 0, 0, 0);
#pragma unroll
    for (int rt = 0; rt < 4; ++rt) st[rt] = nw[rt];
}
__device__ __forceinline__ void chain3(Frame& F, const PaBufs& B, float* out, int seq, int ct, LAS float* tbl) {
    const int lane = F.lane, a = lane & 15, q = lane >> 4;
    constexpr int NS = SEQ / CH;
    f32x4 st[4];
#pragma unroll
    for (int rt = 0; rt < 4; ++rt) st[rt] = (f32x4){0.f, 0.f, 0.f, 0.f};
    const size_t u0 = (size_t)seq * NS;
    const float* gm0 = B.gam + u0 * 64;
    ch_gam_stage(tbl, gm0, lane);
    ChOp3 o0, o1, o2, o3; f32x4 g[4];
    ch_load3(o0, B, u0, ct, a, q); ch_load3(o1, B, u0 + 1, ct, a, q); ch_load3(o2, B, u0 + 2, ct, a, q);
#define CH_CL(i) (u0 + ((i) < NS ? (i) : NS - 1))
#pragma unroll 1
    for (int c = 0; c < NS; c += 4) {
        const bool rs = c >= 16 && c < 80; const int cq = c & ~15, sub = (c & 15) >> 2;
        f32x4 gv = (f32x4){0.f, 0.f, 0.f, 0.f};
        if (rs) gv = *(const f32x4*)(gm0 + (size_t)(cq + 48) * 64 + (sub * 64 + lane) * 4);
        ch_load3(o3, B, CH_CL(c + 3), ct, a, q); ch_gam_read(g, tbl, c, q);     ch_step3(st, o0, g, B, u0 + c, ct, a, q);
        ch_load3(o0, B, CH_CL(c + 4), ct, a, q); ch_gam_read(g, tbl, c + 1, q); ch_step3(st, o1, g, B, u0 + c + 1, ct, a, q);
        ch_load3(o1, B, CH_CL(c + 5), ct, a, q); ch_gam_read(g, tbl, c + 2, q); ch_step3(st, o2, g, B, u0 + c + 2, ct, a, q);
        ch_load3(o2, B, CH_CL(c + 6), ct, a, q); ch_gam_read(g, tbl, c + 3, q); ch_step3(st, o3, g, B, u0 + c + 3, ct, a, q);
        if (rs) *(LAS f32x4*)(tbl + ((cq + 48) & 63) * 64 + (sub * 64 + lane) * 4) = gv;
    }
#undef CH_CL
    float* dst = out + OFF_WKV_P + (size_t)seq * 4096 + (size_t)(16 * ct + a) * 64 + 4 * q;
#pragma unroll
    for (int rt = 0; rt < 4; ++rt) *(f32x4*)(dst + 16 * rt) = st[rt];
}

struct FinOp { bf16x8 g0, g1; u32x2_t y0[4], zv[4], zp[4], gv[4]; float rk; };
__device__ __forceinline__ void wkv_finish_unit(Frame& F, const In& I, unsigned char* ws, const PaBufs& B, bf16* RO, int unit) {
    const int lane = F.lane, r = lane & 15, q = lane >> 4;
    const int seq = unit >> 7, ch = unit & 127, bb_ = seq >> 4, h = seq & 15;
    const size_t row0 = (size_t)bb_ * SEQ + (size_t)ch * CH;
    const bf16* Z = (const bf16*)(ws + WS_Z); const bf16* GG = (const bf16*)(ws + WS_GG);
    const bf16* Sg = B.Qg + (size_t)unit * 4096; const bf16* Gg = B.Gg + (size_t)unit * 4096;
    auto fin_load = [&](FinOp& o, int tt) {
        const size_t m = row0 + 16 * tt + r;
        o.g0 = *(const bf16x8*)(Gg + (16 * tt + r) * 64 + 8 * q); o.g1 = *(const bf16x8*)(Gg + (16 * tt + r) * 64 + 32 + 8 * q);
        const bool first = (m & (SEQ - 1)) == 0;
#pragma unroll
        for (int vt = 0; vt < 4; ++vt) { const int c = h * 64 + 16 * vt + 4 * q;
            o.y0[vt] = *(const u32x2_t*)(B.Yb + (size_t)unit * 4096 + (16 * tt + r) * 64 + 16 * vt + 4 * q);
            o.zv[vt] = *(const u32x2_t*)(Z + m * ZC + 2048 + c);
            o.zp[vt] = (u32x2_t){0u, 0u};
            if (r == 0 && !first) o.zp[vt] = *(const u32x2_t*)(Z + (m - 1) * ZC + 2048 + c);
            o.gv[vt] = *(const u32x2_t*)(GG + m * 1024 + c); }
        o.rk = B.rk[m * 16 + h];
    };
    bf16x8 sfr[4][2];
#pragma unroll
    for (int vt = 0; vt < 4; ++vt)
#pragma unroll
        for (int ks = 0; ks < 2; ++ks) sfr[vt][ks] = *(const bf16x8*)(Sg + (16 * vt + r) * 64 + 32 * ks + 8 * q);
    const f32x4 mu[4] = {*(const f32x4*)(I.shift_mu + 2048 + h * 64 + 4 * q), *(const f32x4*)(I.shift_mu + 2048 + h * 64 + 16 + 4 * q), *(const f32x4*)(I.shift_mu + 2048 + h * 64 + 32 + 4 * q), *(const f32x4*)(I.shift_mu + 2048 + h * 64 + 48 + 4 * q)};
    auto fin_compute = [&](const FinOp& o, int tt) {
        const size_t m = row0 + 16 * tt + r;
        f32x4 y[4];
#pragma unroll
        for (int vt = 0; vt < 4; ++vt) {
            f32x4 acc = (f32x4){bflo(o.y0[vt].x), bfhi(o.y0[vt].x), bflo(o.y0[vt].y), bfhi(o.y0[vt].y)};
            if (ch > 0) { acc = __builtin_amdgcn_mfma_f32_16x16x32_bf16(sfr[vt][0], o.g0, acc, 0, 0, 0); acc = __builtin_amdgcn_mfma_f32_16x16x32_bf16(sfr[vt][1], o.g1, acc, 0, 0, 0); }
            y[vt] = acc;
        }
        float sm = 0.f;
#pragma unroll
        for (int vt = 0; vt < 4; ++vt) sm += (y[vt][0] + y[vt][1]) + (y[vt][2] + y[vt][3]);
        sm += __shfl_xor(sm, 16); sm += __shfl_xor(sm, 32);
        const float mean = sm * (1.0f / 64.0f);
        float sq = 0.f;
#pragma unroll
        for (int vt = 0; vt < 4; ++vt) { y[vt] = y[vt] - mean; sq += (y[vt][0] * y[vt][0] + y[vt][1] * y[vt][1]) + (y[vt][2] * y[vt][2] + y[vt][3] * y[vt][3]); }
        sq += __shfl_xor(sq, 16); sq += __shfl_xor(sq, 32);
        const float rs = 1.0f / sqrtf(sq * (1.0f / 64.0f) + 64e-5f);
        const float rk = o.rk;
#pragma unroll
        for (int vt = 0; vt < 4; ++vt) {
            const int c = h * 64 + 16 * vt + 4 * q;
            const u32x2_t zv = o.zv[vt]; u32x2_t zp = o.zp[vt];
            float v0 = bflo(zv.x), v1 = bfhi(zv.x), v2 = bflo(zv.y), v3 = bfhi(zv.y);
            zp.x = (unsigned)__builtin_amdgcn_update_dpp((int)zp.x, (int)zv.x, 0x111, 0xf, 0xf, false); zp.y = (unsigned)__builtin_amdgcn_update_dpp((int)zp.y, (int)zv.y, 0x111, 0xf, 0xf, false);
            const float p0 = bflo(zp.x), p1 = bfhi(zp.x), p2 = bflo(zp.y), p3 = bfhi(zp.y);
            v0 += (p0 - v0) * mu[vt].x; v1 += (p1 - v1) * mu[vt].y; v2 += (p2 - v2) * mu[vt].z; v3 += (p3 - v3) * mu[vt].w;
            const f32x4 lw4 = *(const f32x4*)(I.lnx_w + c), lb4 = *(const f32x4*)(I.lnx_b + c);
            const u32x2_t gv = o.gv[vt];
            const float o0 = (y[vt][0] * rs * lw4.x + lb4.x + rk * v0) * bflo(gv.x), o1 = (y[vt][1] * rs * lw4.y + lb4.y + rk * v1) * bfhi(gv.x);
            const float o2 = (y[vt][2] * rs * lw4.z + lb4.z + rk * v2) * bflo(gv.y), o3 = (y[vt][3] * rs * lw4.w + lb4.w + rk * v3) * bfhi(gv.y);
            *(u32x2_t*)(RO + m * 1024 + c) = (u32x2_t){pk2(o0, o1), pk2(o2, o3)};
        }
    };
    FinOp oa, ob;
    fin_load(oa, 0); fin_load(ob, 1); fin_compute(oa, 0); fin_load(oa, 2); fin_compute(ob, 1); fin_load(ob, 3); fin_compute(oa, 2); fin_compute(ob, 3);
}
#define HELPERS_OFF_CHAIN 1
#ifndef P1_SP2
#define P1_SP2 true
#endif

__global__ void __launch_bounds__(NWAVES * 64, 2) mk_fwd(Args args) {
    extern __shared__ __attribute__((aligned(16))) unsigned char lds[];
    Frame F;
    F.lds = (LAS unsigned char*)lds;
    F.MISC = (volatile LAS unsigned*)(F.lds + MISC_OFF);
    F.tid = threadIdx.x; F.lane = F.tid & 63; F.wave = __builtin_amdgcn_readfirstlane(F.tid >> 6);
    const int wave_idx = F.wave;
    F.G = gridDim.x; { const int bx = blockIdx.x; F.vcu = (F.G % 8 == 0) ? (bx % 8) * (F.G / 8) + bx / 8 : bx; }
    unsigned char* ws = args.ws; float* out = args.out; const In& I = args.in;
    F.ctl = (gu32*)(ws + WS_CTL);
    for (int u = F.tid; u < (LDS_BYTES - LDSCTL_OFF) / 4; u += NWAVES * 64) ((LAS unsigned*)(F.lds + LDSCTL_OFF))[u] = 0u;
    __syncthreads();
    XcdBarrier bar = xcd_barrier_post((unsigned*)(F.ctl + CW_BAR), F.MISC + 8);
    unsigned* const lbar = (unsigned*)(F.ctl + CW_LBAR);
    if (threadIdx.x == 0 && (bar.x != (blockIdx.x & 7u) || (gridDim.x & 7u) != 0u || gridDim.x * NWAVES * 8u != (unsigned)NTOK_P)) (void)xb_add(&lbar[LB_MISM], 1u);
#define GRID_BAR() do { xcd_barrier(bar, mk_tid(wave_idx)); int t_ = mk_tid(wave_idx); asm volatile("" : "+v"(t_)); F.tid = t_; F.lane = t_ & 63; F.wave = wave_idx; } while (0)
#define GROUP_BAR() do { if (F.MISC[10] != 0u) xcd_local_barrier(bar, lbar, mk_tid(wave_idx)); else xcd_barrier(bar, mk_tid(wave_idx)); int t_ = mk_tid(wave_idx); asm volatile("" : "+v"(t_)); F.tid = t_; F.lane = t_ & 63; F.wave = wave_idx; } while (0)
    const int bx = (int)blockIdx.x;
#ifdef PROBE_HALF
#define GP_SEL(n) ((n) == PROBE_HALF || (PROBE_HALF == 3 && (n) == 4) || (PROBE_HALF == 8 && (n) == 9))
#define GP_G(n) (GP_SEL(n) ? F.G / 2 : F.G)
#define GP_C(n) (GP_SEL(n) ? (bx < F.G / 2 ? bx : (1 << 28)) : bx)
#else
#define GP_G(n) F.G
#define GP_C(n) bx
#endif
    bf16* XB = (bf16*)(ws + WS_XB); bf16* Zb = (bf16*)(ws + WS_Z); float* stat = (float*)(ws + WS_STAT);
    float* ss1 = stat + MPAD; float* ss2 = stat + 2 * (size_t)MPAD; float* ss3 = stat + 3 * (size_t)MPAD;

    p0_prologue(F, I, ws);
#ifdef P0LATE_IN_P0
    p0_late(F, I, ws, F.vcu * NWAVES + F.wave, F.G * NWAVES, 0, 1 << 30, 0, 1 << 30);
#endif
#ifdef PROBE_P0
    __syncthreads(); p0_prologue(F, I, ws);
#endif
    GRID_BAR();
    if (F.tid == 0) F.MISC[10] = (xb_ld(&lbar[LB_MISM]) == 0u && F.MISC[9] == 8u && F.MISC[8] * 8u == gridDim.x) ? 1u : 0u;
    __syncthreads();
    constexpr int LATE_SPLIT_IT = 2944, LATE_SPLIT_M = 8320;
    {
        pg8::Gemm g{XB, (const bf16*)(ws + WS_WIN), MPAD, ZC, DM}; pg8::StaticOrder S; S.init(MPAD, ZC, GP_G(1), GP_C(1));
        pg8::EpiZ E{Zb, stat, out};
        pg8::gemm_phase<pg8::EpiZ, pg8::StaticOrder, true, true>(wave_idx, F.lds + RING_OFF, g, S, E);
#ifdef PROBE_P1
        VM_WAIT(); __syncthreads();
        pg8::gemm_phase<pg8::EpiZ, pg8::StaticOrder, true, true>(wave_idx, F.lds + RING_OFF, g, S, E);
#endif
    }
    GRID_BAR();
    p2a_all(F, I, ws, out);
#ifdef PROBE_P2A
    for (int rep = 0; rep < 4; ++rep) { asm volatile("" ::: "memory"); p2a_all(F, I, ws, out); }
#endif
    GROUP_BAR();
    {
        pg8::Gemm g{(const bf16*)(ws + WS_ALORA), (const bf16*)(ws + WS_WLORA), NTOK_P, 3072, 256}; pg8::StaticOrder S; S.init(NTOK_P, 3072, GP_G(2), GP_C(2));
        pg8::EpiLora E{(bf16*)(ws + WS_LW), (bf16*)(ws + WS_AA), (bf16*)(ws + WS_GG), I.decay_w0, I.aaa_a0};
        pg8::mini_gemm_nu<pg8::EpiLora, 256, 3>(wave_idx, F.lds + RING_OFF, g.A, g.Bt, g.N, NTOK_P, GP_C(2), GP_G(2), E);
        pg8::gemm_phase<pg8::EpiLora, pg8::StaticOrder, true, true>(wave_idx, F.lds + RING_OFF, g, S, E);
#ifdef PROBE_P2B
        VM_WAIT(); __syncthreads();
        pg8::gemm_phase<pg8::EpiLora, pg8::StaticOrder, true, true>(wave_idx, F.lds + RING_OFF, g, S, E);
#endif
    }
    GROUP_BAR();
    PaBufs PB_; PB_.Pg = (bf16*)(ws + WS_PG); PB_.Gg = (bf16*)(ws + WS_GT); PB_.Yb = (bf16*)(out + OFF_Y_P); PB_.Qg = PB_.Yb + (size_t)NTOK_P * 1024; PB_.gam = (float*)(ws + WS_GAM); PB_.rk = (float*)(ws + WS_RK);
    {
        const bf16* Zc = (const bf16*)(ws + WS_Z); const bf16* LWc = (const bf16*)(ws + WS_LW); const bf16* AAc = (const bf16*)(ws + WS_AA);
        PaRaw raw;
#ifdef PROBE_PASSA
#pragma unroll 1
        for (int rep = 0; rep < 2; ++rep) {
#endif
        const bool pa_cls = F.G * NWAVES * 8 == NTOK_P;
        auto pa_unit = [&](int k) -> int {
            if (pa_cls) { if (k >= 16) return NUNIT; const int c = bx & 7, j = bx >> 3; return (((c >> 2) * 16 + k) * 128) + 32 * (c & 3) + j; }
            const long u = (long)bx + (long)k * F.G; return u < NUNIT ? (int)u : NUNIT; };
        if (pa_unit(0) < NUNIT) pa_load(raw, I, Zc, LWc, AAc, pa_unit(0), F.wave, F.lane);
        for (int k = 0; pa_unit(k) < NUNIT; ++k) passA_unit(F, I, PB_, pa_unit(k), raw, pa_unit(k + 1), Zc, LWc, AAc);
#ifdef PROBE_PASSA
        }
#endif
    }
    GRID_BAR();
    {
        LAS float* wl = (LAS float*)(F.lds + RING_OFF + F.wave * 16384);
        const int NCH = 128, NCW = 1;
#ifdef HELPERS_OFF_CHAIN
        const int nhw = (F.G - NCH) * NWAVES;
#else
        const int nhw = NCH * (NWAVES - NCW) + (F.G - NCH) * NWAVES;
#endif
        int hw = -1;
        if (bx < NCH) { if (F.wave < NCW) {
#ifdef PROBE_CHAIN
            chain2<false>(F, PB_, out, bx >> 2, bx & 3, (unsigned*)(F.ctl + CW_PROG));
#endif
            chain3(F, PB_, out, bx >> 2, bx & 3, wl); }
#ifdef HELPERS_OFF_CHAIN
            }
        else hw = (bx - NCH) * NWAVES + F.wave;
#else
            else hw = bx * (NWAVES - NCW) + F.wave - NCW; }
        else hw = NCH * (NWAVES - NCW) + (bx - NCH) * NWAVES + F.wave;
#endif
        if (hw >= 0) {
#ifndef P0LATE_IN_P0
            p0_late(F, I, ws, hw, nhw, 0, 1 << 30, 0, 1 << 30);
#endif
#ifdef PROBE_SAMPLE
            for (int rep = 0; rep < 2; ++rep)
#endif
            for (int item = hw; item < 1536 + 512; item += nhw) {
                if (item < 1536) attn_sample_item(F, I, ws, item, wl);
                else { const int q = item - 1536, n = q >> 4, h = q & 15; const float* sp = I.state_shift + (size_t)n * 3328 + h * 64 + F.lane;
                    scan_out<4>(F, I, ws, (size_t)(NTOK_P + n * 4), 4, h, I.state_wkv + (size_t)q * 4096, out + OFF_WKV_S + (size_t)q * 4096, sp[0], sp[1024], sp[2048], wl); }
            }

        }
        __syncthreads();
        gu32* queue = F.ctl + CW_QUEUE;
        for (;;) {
            if (F.tid == 0) F.MISC[16] = __hip_atomic_fetch_add(queue, 1u, RLX_AGENT);
            __syncthreads();
            const int unit = (int)F.MISC[16];
            __syncthreads();
            if (unit >= 1536) break;
            attn_prompt_unit(F, ws, unit);
        }
    }
    GRID_BAR();
    {
        if (F.G * NWAVES * 8 == NTOK_P) {
            const int c = bx & 7, j = bx >> 3, bb = c >> 2, ch = 32 * (c & 3) + j;
            wkv_finish_unit(F, I, ws, PB_, (bf16*)(ws + WS_RO), (bb * 16 + F.wave) * 128 + ch);
            wkv_finish_unit(F, I, ws, PB_, (bf16*)(ws + WS_RO), (bb * 16 + F.wave + 8) * 128 + ch);
        } else
        for (int i = bx * NWAVES + F.wave; i < NUNIT; i += F.G * NWAVES) {
            const int h = 8 * ((i >> 3) & 1) + (i & 7), rest = i >> 4, ch = rest & 127, bb = rest >> 7;
            wkv_finish_unit(F, I, ws, PB_, (bf16*)(ws + WS_RO), (bb * 16 + h) * 128 + ch);
        }
        p2d_attn_merge(F, ws);
    }
    GROUP_BAR();
    {
        pg8::Gemm g{(const bf16*)(ws + WS_RO), (const bf16*)(ws + WS_WBR), NTOK_P, DM, DM}; pg8::StaticOrder S; S.init(NTOK_P, DM, GP_G(3), GP_C(3));
        pg8::EpiGate<false> E{(bf16*)(ws + WS_MIX), Zb, ZGA};
        pg8::mini_gemm<pg8::EpiGate<false>, 1024>(wave_idx, F.lds + RING_OFF, g.A, g.Bt, g.N, NTOK_P, GP_C(3), GP_G(3), E);
        pg8::gemm_phase<pg8::EpiGate<false>, pg8::StaticOrder, true, true>(wave_idx, F.lds + RING_OFF, g, S, E);
    }
    VM_WAIT(); __syncthreads();
    {
        pg8::Gemm g{(const bf16*)(ws + WS_ATTN), (const bf16*)(ws + WS_WBA), NTOK_P, DM, 256}; pg8::StaticOrder S; S.init(NTOK_P, DM, GP_G(4), GP_C(4));
        pg8::EpiGate<true> E{(bf16*)(ws + WS_MIX), Zb, ZGB};
        pg8::mini_gemm<pg8::EpiGate<true>, 256>(wave_idx, F.lds + RING_OFF, g.A, g.Bt, g.N, NTOK_P, GP_C(4), GP_G(4), E);
        pg8::gemm_phase<pg8::EpiGate<true>, pg8::StaticOrder, true, true>(wave_idx, F.lds + RING_OFF, g, S, E);
    }
    GROUP_BAR();
    {
        pg8::Gemm g{(const bf16*)(ws + WS_MIX), (const bf16*)(ws + WS_WOUT), NTOK_P, DM, DM}; pg8::StaticOrder S; S.init(NTOK_P, DM, GP_G(5), GP_C(5));
        pg8::EpiRes<0> E{(bf16*)(ws + WS_X1B), ss1, I.x_prompt, I.x_sample};
        pg8::mini_gemm<pg8::EpiRes<0>, 1024>(wave_idx, F.lds + RING_OFF, g.A, g.Bt, g.N, NTOK_P, GP_C(5), GP_G(5), E);
        pg8::gemm_phase<pg8::EpiRes<0>, pg8::StaticOrder, true, true>(wave_idx, F.lds + RING_OFF, g, S, E);
    }
    GROUP_BAR();
    {
        pg8::Gemm g{(const bf16*)(ws + WS_X1B), (const bf16*)(ws + WS_WFF1), NTOK_P, DFF, DM}; pg8::StaticOrder S; S.init(NTOK_P, DFF, GP_G(6), GP_C(6));
        pg8::EpiFF1 E{(bf16*)(ws + WS_HDN), ss1};
        pg8::mini_gemm_nu<pg8::EpiFF1, 1024, 4>(wave_idx, F.lds + RING_OFF, g.A, g.Bt, g.N, NTOK_P, GP_C(6), GP_G(6), E);
        pg8::gemm_phase<pg8::EpiFF1, pg8::StaticOrder, true, true>(wave_idx, F.lds + RING_OFF, g, S, E);
#ifdef PROBE_P5
        VM_WAIT(); __syncthreads();
        pg8::gemm_phase<pg8::EpiFF1, pg8::StaticOrder, true, true>(wave_idx, F.lds + RING_OFF, g, S, E);
#endif
    }
    GROUP_BAR();
    {
        pg8::Gemm g{(const bf16*)(ws + WS_HDN), (const bf16*)(ws + WS_WFF2), NTOK_P, DM, DFF}; pg8::StaticOrder S; S.init(NTOK_P, DM, GP_G(7), GP_C(7));
        pg8::EpiRes<1> E{(bf16*)(ws + WS_X1B), ss2, nullptr, nullptr};
        pg8::mini_gemm<pg8::EpiRes<1>, 4096>(wave_idx, F.lds + RING_OFF, g.A, g.Bt, g.N, NTOK_P, GP_C(7), GP_G(7), E);
        pg8::gemm_phase<pg8::EpiRes<1>, pg8::StaticOrder, true, true>(wave_idx, F.lds + RING_OFF, g, S, E);
    }
    GROUP_BAR();
    {
        pg8::Gemm g{(const bf16*)(ws + WS_PB), (const bf16*)(ws + WS_WPLE), NTOK_P, DM, 256}; pg8::StaticOrder S; S.init(NTOK_P, DM, GP_G(8), GP_C(8));
        pg8::EpiT2 E{(bf16*)(ws + WS_T2)};
        pg8::mini_gemm<pg8::EpiT2, 256>(wave_idx, F.lds + RING_OFF, g.A, g.Bt, g.N, NTOK_P, GP_C(8), GP_G(8), E);
        pg8::gemm_phase<pg8::EpiT2, pg8::StaticOrder, true, true>(wave_idx, F.lds + RING_OFF, g, S, E);
    }
    VM_WAIT(); __syncthreads();
    {
        pg8::Gemm g{(const bf16*)(ws + WS_X1B), (const bf16*)(ws + WS_WPG), NTOK_P, DM, DM}; pg8::StaticOrder S; S.init(NTOK_P, DM, GP_G(9), GP_C(9));
        pg8::EpiPle E{(const bf16*)(ws + WS_X1B), (bf16*)(ws + WS_X1), (const bf16*)(ws + WS_T2), ss2, ss3};
        pg8::mini_gemm<pg8::EpiPle, 1024>(wave_idx, F.lds + RING_OFF, g.A, g.Bt, g.N, NTOK_P, GP_C(9), GP_G(9), E);
        pg8::gemm_phase<pg8::EpiPle, pg8::StaticOrder, true, true>(wave_idx, F.lds + RING_OFF, g, S, E);
    }
    GROUP_BAR();
#ifdef PROBE_BARS
    GRID_BAR(); GRID_BAR(); GRID_BAR(); GRID_BAR(); GRID_BAR();
#endif
    p8_final(F, I, ws, out);
#ifdef PROBE_P8
    p8_final(F, I, ws, out);
#endif
#undef GRID_BAR
}

extern "C" void kernel_launch(void* const* d_in, const int* in_sizes, int n_in, void* d_out, int out_size, void* d_ws, size_t ws_size, hipStream_t stream) {
    static int grid = 0;
    if (grid == 0) {
        if (n_in != 32 || (size_t)out_size != OUT_TOTAL || ws_size < WS_END) { fprintf(stderr, "kernel_launch: unexpected shapes: n_in %d out %d ws %zu\n", n_in, out_size, ws_size); grid = -1; return; }
        int dev = 0, cus = 0, per_cu = 0;
        if (hipGetDevice(&dev) != hipSuccess || hipDeviceGetAttribute(&cus, hipDeviceAttributeMultiprocessorCount, dev) != hipSuccess) { fprintf(stderr, "kernel_launch: device query failed\n"); grid = -1; return; }
        if (hipFuncSetAttribute((const void*)mk_fwd, hipFuncAttributeMaxDynamicSharedMemorySize, LDS_BYTES) != hipSuccess) { fprintf(stderr, "kernel_launch: hipFuncSetAttribute failed\n"); grid = -1; return; }
        if (hipOccupancyMaxActiveBlocksPerMultiprocessor(&per_cu, (const void*)mk_fwd, NWAVES * 64, LDS_BYTES) != hipSuccess || per_cu < 1) { fprintf(stderr, "kernel_launch: occupancy query says %d blocks per CU\n", per_cu); per_cu = 1; }
        (void)hipGetLastError();
        grid = cus;
    }
    if (grid < 0) return;
    if (hipMemsetAsync((char*)d_ws + WS_CTL, 0, CTL_ZERO_BYTES, stream) != hipSuccess) { fprintf(stderr, "kernel_launch: memset failed\n"); return; }
    Args a{};
    const float** ip = (const float**)&a.in;
    for (int i = 0; i < 32; ++i) ip[i] = (const float*)d_in[i];
    a.out = (float*)d_out; a.ws = (unsigned char*)d_ws;
    void* kargs[] = {&a};
    hipError_t e = hipLaunchCooperativeKernel((const void*)mk_fwd, dim3(grid), dim3(NWAVES * 64), kargs, LDS_BYTES, stream);
    if (e != hipSuccess) fprintf(stderr, "kernel_launch: cooperative launch failed: %s (grid %d)\n", hipGetErrorString(e), grid);
}
```

```cpp
#include <hip/hip_runtime.h>
#include <cstdio>
#include <cstdint>
__device__ __forceinline__ int mk_lane_id() { unsigned z = 0u; asm volatile("" : "+v"(z)); return (int)__builtin_amdgcn_mbcnt_hi(0xffffffffu, __builtin_amdgcn_mbcnt_lo(0xffffffffu, z)); }
__device__ __forceinline__ int mk_tid(int wave) { return wave * 64 + mk_lane_id(); }
namespace pg8 {
#define PG8_LAS __attribute__((address_space(3)))
typedef unsigned short bf16_t;
typedef short bf16x8 __attribute__((ext_vector_type(8)));
typedef float f32x4 __attribute__((ext_vector_type(4)));
typedef unsigned u32x4 __attribute__((ext_vector_type(4)));
constexpr int BM = 256, BK = 64, HALF = 128, HTB = HALF * BK * 2  , STAGE_BYTES = 8 * HTB, NXCD = 8, WGM = 4, PRE_OFF = STAGE_BYTES + 4096  ;

__host__ __device__ __forceinline__ int lds_byte(int r, int c) { const int st = (r >> 4) * 2 + (c >> 5), rr = r & 15, cc = c & 31, ob = rr * 64 + cc * 2; return st * 1024 + (ob ^ (((ob >> 9) & 1) << 5)); }
__host__ __device__ __forceinline__ void stage_rc(int b, int& R, int& C) { const int st = b / 1024, sb = b % 1024, swz = sb ^ (((sb >> 9) & 1) << 5); R = (st >> 1) * 16 + swz / 64; C = (st & 1) * 32 + (swz % 64) / 2; }
__host__ __device__ __forceinline__ int perm32(int rho) { const int n = rho >> 4, i = rho & 15; return 8 * (i >> 2) + 4 * n + (i & 3); }

struct Unit { int pm, pn; };
struct Gemm { const bf16_t* A; const bf16_t* Bt; int M, N, K; };

struct StaticOrder {
    int nM, nN, nwg, G, c;
    __host__ __device__ void init(int M, int N, int G_, int c_) { nM = M / BM; nN = N / BM; nwg = nM * nN; G = G_; c = c_; }
    __host__ __device__ bool next(int i, Unit& u) const {
        const long L = (long)i * G + c; if (L >= nwg) return false;
        int wgid = (int)L; { const int q = nwg / NXCD, r = nwg % NXCD, xcd = wgid % NXCD, off = wgid / NXCD; wgid = (xcd < r ? xcd * (q + 1) : r * (q + 1) + (xcd - r) * q) + off; }
        const int nig = WGM * nN, gid = wgid / nig, fm = gid * WGM, gsz = (nM - fm) < WGM ? (nM - fm) : WGM;
        u.pm = fm + ((wgid % nig) % gsz); u.pn = (wgid % nig) / gsz; return true;
    }
    __device__ __forceinline__ void a_ready(const Unit&) const {}
    __device__ __forceinline__ void done(const Unit&) const {}
};
struct StaticOrderX {
    StaticOrder base; int nN, nbase, nextra, G, c;
    __host__ __device__ void init(int Mmain, int N, int G_, int c_) { base.init(Mmain, N, G_, c_); nN = N / BM; nbase = base.nwg; nextra = nN; G = G_; c = c_; }
    __host__ __device__ bool next(int i, Unit& u) const {
        const long L = (long)i * G + c;
        if (L < nbase) return base.next(i, u);
        if (L < nbase + nextra) { u.pm = base.nM; u.pn = (int)(L - nbase); return true; }
        return false;
    }
    __device__ __forceinline__ void a_ready(const Unit&) const {}
    __device__ __forceinline__ void done(const Unit&) const {}
};

__device__ __forceinline__ unsigned cvt_pk_bf16(float lo, float hi) { unsigned r; asm volatile("v_cvt_pk_bf16_f32 %0, %1, %2" : "=v"(r) : "v"(lo), "v"(hi)); return r; }
typedef float f32x2 __attribute__((ext_vector_type(2)));
typedef unsigned u32x2 __attribute__((ext_vector_type(2)));
__device__ __forceinline__ float bf_lo(unsigned w) { return __uint_as_float(w << 16); }
__device__ __forceinline__ float bf_hi(unsigned w) { return __uint_as_float(w & 0xffff0000u); }
__device__ __forceinline__ float sigmoidf_(float x) { return __builtin_amdgcn_rcpf(1.0f + __expf(-x)); }

constexpr int NTOK_P = 16384, NTOK = 16512, MPAD = 16640, ZC = 7680;
constexpr size_t OFF_Y_P = 0, OFF_Y_S = 16777216, OFF_KVP0 = 16908288, OFF_KVP1 = 17039360, OFF_KVP2 = 17563648, OFF_WKV_P = 19660800, OFF_SHIFT_P = 19791872,
                 OFF_KVS0 = 19798528, OFF_KVS1 = 19864064, OFF_KVS2 = 19929600, OFF_WKV_S = 19995136, OFF_SHIFT_S = 22092288, OUT_TOTAL = 22198784;

struct EpiZ {
    static constexpr bool PERM = true, AFTER_DRAIN = false; static constexpr int NPRE = 8;
    bf16_t* Z; const float* rstd0; float* out;
    __device__ __forceinline__ const float* pre_base(const Unit& u, int wr) const { return rstd0 + u.pm * BM + wr * 64; }
    __device__ __forceinline__ void operator()(const f32x4 (&acc)[2][2][4][2], const Unit& u, int wr, int wc, int fr, int fq, const PG8_LAS float* pre) const {
        const int pn = u.pn, pm = u.pm;
#pragma unroll
        for (int ai = 0; ai < 2; ++ai)
#pragma unroll
            for (int m = 0; m < 4; ++m) {
                const int row = pm * BM + ai * HALF + wr * 64 + m * 16 + fr;
                const float rs = pre[ai * 64 + m * 16 + fr];
                bf16_t* zrow = Z + (size_t)row * ZC;
#pragma unroll
                for (int bj = 0; bj < 2; ++bj) {
                    const int col = pn * BM + bj * HALF + wc * 32 + 8 * fq;
                    const f32x4 v0 = acc[ai][bj][m][0] * rs, v1 = acc[ai][bj][m][1] * rs;
                    u32x4 w; w.x = cvt_pk_bf16(v0[0], v0[1]); w.y = cvt_pk_bf16(v0[2], v0[3]); w.z = cvt_pk_bf16(v1[0], v1[1]); w.w = cvt_pk_bf16(v1[2], v1[3]);
                    *(u32x4*)(zrow + col) = w;
                }
            }
    }
};

struct EpiLora {
    static constexpr bool PERM = true, AFTER_DRAIN = false; static constexpr int NPRE = 0;
    bf16_t* LW; bf16_t* AA; bf16_t* GG; const float* w0; const float* a0;
    __device__ __forceinline__ void operator()(const f32x4 (&acc)[2][2][4][2], const Unit& u, int wr, int wc, int fr, int fq) const {
        const int pn = u.pn;
        if (pn < 4) {
#pragma unroll
            for (int ai = 0; ai < 2; ++ai)
#pragma unroll
                for (int m = 0; m < 4; ++m) {
                    const int row = u.pm * BM + ai * HALF + wr * 64 + m * 16 + fr;
#pragma unroll
                    for (int bj = 0; bj < 2; ++bj) {
                        const int col = pn * BM + bj * HALF + wc * 32 + 8 * fq;
                        f32x4 v0 = acc[ai][bj][m][0], v1 = acc[ai][bj][m][1];
                        const f32x4 b0 = *(const f32x4*)(w0 + col), b1 = *(const f32x4*)(w0 + col + 4);
#pragma unroll
                        for (int i = 0; i < 4; ++i) { v0[i] = -0.60653065971f * sigmoidf_(v0[i] + b0[i]); v1[i] = -0.60653065971f * sigmoidf_(v1[i] + b1[i]); }
                        u32x4 w; w.x = cvt_pk_bf16(v0[0], v0[1]); w.y = cvt_pk_bf16(v0[2], v0[3]); w.z = cvt_pk_bf16(v1[0], v1[1]); w.w = cvt_pk_bf16(v1[2], v1[3]);
                        *(u32x4*)(LW + (size_t)row * 1024 + col) = w;
                    }
                }
        } else if (pn < 8) {
#pragma unroll
            for (int ai = 0; ai < 2; ++ai)
#pragma unroll
                for (int m = 0; m < 4; ++m) {
                    const int row = u.pm * BM + ai * HALF + wr * 64 + m * 16 + fr;
#pragma unroll
                    for (int bj = 0; bj < 2; ++bj) {
                        const int col = (pn - 4) * BM + bj * HALF + wc * 32 + 8 * fq;
                        f32x4 v0 = acc[ai][bj][m][0], v1 = acc[ai][bj][m][1];
                        const f32x4 b0 = *(const f32x4*)(a0 + col), b1 = *(const f32x4*)(a0 + col + 4);
#pragma unroll
                        for (int i = 0; i < 4; ++i) { v0[i] = sigmoidf_(v0[i] + b0[i]); v1[i] = sigmoidf_(v1[i] + b1[i]); }
                        u32x4 w; w.x = cvt_pk_bf16(v0[0], v0[1]); w.y = cvt_pk_bf16(v0[2], v0[3]); w.z = cvt_pk_bf16(v1[0], v1[1]); w.w = cvt_pk_bf16(v1[2], v1[3]);
                        *(u32x4*)(AA + (size_t)row * 1024 + col) = w;
                    }
                }
        } else {
#pragma unroll
            for (int ai = 0; ai < 2; ++ai)
#pragma unroll
                for (int m = 0; m < 4; ++m) {
                    const int row = u.pm * BM + ai * HALF + wr * 64 + m * 16 + fr;
#pragma unroll
                    for (int bj = 0; bj < 2; ++bj) {
                        const int col = (pn - 8) * BM + bj * HALF + wc * 32 + 8 * fq;
                        const f32x4 v0 = acc[ai][bj][m][0], v1 = acc[ai][bj][m][1];
                        u32x4 w; w.x = cvt_pk_bf16(v0[0], v0[1]); w.y = cvt_pk_bf16(v0[2], v0[3]); w.z = cvt_pk_bf16(v1[0], v1[1]); w.w = cvt_pk_bf16(v1[2], v1[3]);
                        *(u32x4*)(GG + (size_t)row * 1024 + col) = w;
                    }
                }
        }
    }
    __device__ __forceinline__ void mini(int row, int col, f32x4 v0, f32x4 v1, int lane) const {
        const int blk = col >> 10, c = col & 1023;
        if (blk < 2) {
            const long long boff = blk == 0 ? 0ll : (long long)((const char*)a0 - (const char*)w0);
            const float* bp = (const float*)((const char*)w0 + boff) + c;
            const f32x4 b0 = *(const f32x4*)bp, b1 = *(const f32x4*)(bp + 4);
            const float sc = blk == 0 ? -0.60653065971f : 1.0f;
#pragma unroll
            for (int i = 0; i < 4; ++i) { v0[i] = sc * sigmoidf_(v0[i] + b0[i]); v1[i] = sc * sigmoidf_(v1[i] + b1[i]); }
        }
        u32x4 w; w.x = cvt_pk_bf16(v0[0], v0[1]); w.y = cvt_pk_bf16(v0[2], v0[3]); w.z = cvt_pk_bf16(v1[0], v1[1]); w.w = cvt_pk_bf16(v1[2], v1[3]);
        const long long ooff = blk == 0 ? 0ll : (blk == 1 ? (long long)((const char*)AA - (const char*)LW) : (long long)((const char*)GG - (const char*)LW));
        *(u32x4*)((char*)LW + ooff + ((size_t)row * 1024 + c) * 2) = w;
    }
};

template <bool ADD> struct EpiGate {
    static constexpr bool PERM = true, AFTER_DRAIN = false; static constexpr int NPRE = 0;
    bf16_t* MIX; const bf16_t* Z; int gate_off;
    __device__ __forceinline__ void operator()(const f32x4 (&acc)[2][2][4][2], const Unit& u, int wr, int wc, int fr, int fq) const {
#pragma unroll
        for (int ai = 0; ai < 2; ++ai)
#pragma unroll
            for (int m = 0; m < 4; ++m) {
                const int row = u.pm * BM + ai * HALF + wr * 64 + m * 16 + fr;
#pragma unroll
                for (int bj = 0; bj < 2; ++bj) {
                    const int col = u.pn * BM + bj * HALF + wc * 32 + 8 * fq;
                    const u32x4 gz = *(const u32x4*)(Z + (size_t)row * ZC + gate_off + col);
                    f32x4 v0 = acc[ai][bj][m][0], v1 = acc[ai][bj][m][1];
                    v0[0] *= sigmoidf_(bf_lo(gz.x)); v0[1] *= sigmoidf_(bf_hi(gz.x)); v0[2] *= sigmoidf_(bf_lo(gz.y)); v0[3] *= sigmoidf_(bf_hi(gz.y));
                    v1[0] *= sigmoidf_(bf_lo(gz.z)); v1[1] *= sigmoidf_(bf_hi(gz.z)); v1[2] *= sigmoidf_(bf_lo(gz.w)); v1[3] *= sigmoidf_(bf_hi(gz.w));
                    bf16_t* d = MIX + (size_t)row * 1024 + col;
                    if (ADD) { const u32x4 o = *(const u32x4*)d;
                        v0[0] += bf_lo(o.x); v0[1] += bf_hi(o.x); v0[2] += bf_lo(o.y); v0[3] += bf_hi(o.y);
                        v1[0] += bf_lo(o.z); v1[1] += bf_hi(o.z); v1[2] += bf_lo(o.w); v1[3] += bf_hi(o.w); }
                    u32x4 w; w.x = cvt_pk_bf16(v0[0], v0[1]); w.y = cvt_pk_bf16(v0[2], v0[3]); w.z = cvt_pk_bf16(v1[0], v1[1]); w.w = cvt_pk_bf16(v1[2], v1[3]);
                    *(u32x4*)d = w;
                }
            }
    }
    __device__ __forceinline__ void mini(int row, int col, f32x4 v0, f32x4 v1, int lane) const {
        const u32x4 gz = *(const u32x4*)(Z + (size_t)row * ZC + gate_off + col);
        v0[0] *= sigmoidf_(bf_lo(gz.x)); v0[1] *= sigmoidf_(bf_hi(gz.x)); v0[2] *= sigmoidf_(bf_lo(gz.y)); v0[3] *= sigmoidf_(bf_hi(gz.y));
        v1[0] *= sigmoidf_(bf_lo(gz.z)); v1[1] *= sigmoidf_(bf_hi(gz.z)); v1[2] *= sigmoidf_(bf_lo(gz.w)); v1[3] *= sigmoidf_(bf_hi(gz.w));
        bf16_t* d = MIX + (size_t)row * 1024 + col;
        if (ADD) { const u32x4 o = *(const u32x4*)d;
            v0[0] += bf_lo(o.x); v0[1] += bf_hi(o.x); v0[2] += bf_lo(o.y); v0[3] += bf_hi(o.y);
            v1[0] += bf_lo(o.z); v1[1] += bf_hi(o.z); v1[2] += bf_lo(o.w); v1[3] += bf_hi(o.w); }
        u32x4 w; w.x = cvt_pk_bf16(v0[0], v0[1]); w.y = cvt_pk_bf16(v0[2], v0[3]); w.z = cvt_pk_bf16(v1[0], v1[1]); w.w = cvt_pk_bf16(v1[2], v1[3]);
        *(u32x4*)d = w;
    }
};

template <int SRC> struct EpiRes {
    static constexpr bool PERM = true, AFTER_DRAIN = false; static constexpr int NPRE = 0;
    bf16_t* XB; float* ss; const float* xp; const float* xs;
    __device__ __forceinline__ float core(int row, int col, f32x4 v0, f32x4 v1) const {
        bf16_t* d = XB + (size_t)row * 1024 + col;
        if (SRC == 0) { const float* brow = (row < NTOK_P ? xp + (size_t)row * 1024 : xs + (size_t)(row - NTOK_P) * 1024) + col; v0 += *(const f32x4*)brow; v1 += *(const f32x4*)(brow + 4); }
        else { const u32x4 o = *(const u32x4*)d; v0[0] += bf_lo(o.x); v0[1] += bf_hi(o.x); v0[2] += bf_lo(o.y); v0[3] += bf_hi(o.y); v1[0] += bf_lo(o.z); v1[1] += bf_hi(o.z); v1[2] += bf_lo(o.w); v1[3] += bf_hi(o.w); }
        u32x4 w; w.x = cvt_pk_bf16(v0[0], v0[1]); w.y = cvt_pk_bf16(v0[2], v0[3]); w.z = cvt_pk_bf16(v1[0], v1[1]); w.w = cvt_pk_bf16(v1[2], v1[3]);
        *(u32x4*)d = w;
        return ((v0[0] * v0[0] + v0[1] * v0[1]) + (v0[2] * v0[2] + v0[3] * v0[3])) + ((v1[0] * v1[0] + v1[1] * v1[1]) + (v1[2] * v1[2] + v1[3] * v1[3]));
    }
    __device__ __forceinline__ void operator()(const f32x4 (&acc)[2][2][4][2], const Unit& u, int wr, int wc, int fr, int fq) const {
#pragma unroll
        for (int ai = 0; ai < 2; ++ai)
#pragma unroll
            for (int m = 0; m < 4; ++m) {
                const int row = u.pm * BM + ai * HALF + wr * 64 + m * 16 + fr;
                float q = 0.f;
#pragma unroll
                for (int bj = 0; bj < 2; ++bj) q += core(row, u.pn * BM + bj * HALF + wc * 32 + 8 * fq, acc[ai][bj][m][0], acc[ai][bj][m][1]);
                q += __shfl_xor(q, 16); q += __shfl_xor(q, 32);
                if (fq == 0) atomicAdd(ss + row, q);
            }
    }
    __device__ __forceinline__ void mini(int row, int col, f32x4 v0, f32x4 v1, int lane) const {
        float q = core(row, col, v0, v1);
        q += __shfl_xor(q, 1); q += __shfl_xor(q, 2);
        if ((lane & 3) == 0) atomicAdd(ss + row, q);
    }
};

struct EpiFF1 {
    static constexpr bool PERM = true, AFTER_DRAIN = false; static constexpr int NPRE = 8;
    bf16_t* H; const float* ss;
    __device__ __forceinline__ const float* pre_base(const Unit& u, int wr) const { return ss + u.pm * BM + wr * 64; }
    __device__ __forceinline__ void operator()(const f32x4 (&acc)[2][2][4][2], const Unit& u, int wr, int wc, int fr, int fq, const PG8_LAS float* pre) const {
#pragma unroll
        for (int ai = 0; ai < 2; ++ai)
#pragma unroll
            for (int m = 0; m < 4; ++m) {
                const int row = u.pm * BM + ai * HALF + wr * 64 + m * 16 + fr;
                const float rs = __builtin_amdgcn_rsqf(pre[ai * 64 + m * 16 + fr] * (1.0f / 1024.0f) + 1e-6f);
#pragma unroll
                for (int bj = 0; bj < 2; ++bj) {
                    const int col = u.pn * BM + bj * HALF + wc * 32 + 8 * fq;
                    f32x4 v0 = acc[ai][bj][m][0] * rs, v1 = acc[ai][bj][m][1] * rs;
#pragma unroll
                    for (int i = 0; i < 4; ++i) { const float a = fmaxf(v0[i], 0.f), b = fmaxf(v1[i], 0.f); v0[i] = a * a; v1[i] = b * b; }
                    u32x4 w; w.x = cvt_pk_bf16(v0[0], v0[1]); w.y = cvt_pk_bf16(v0[2], v0[3]); w.z = cvt_pk_bf16(v1[0], v1[1]); w.w = cvt_pk_bf16(v1[2], v1[3]);
                    *(u32x4*)(H + (size_t)row * 4096 + col) = w;
                }
            }
    }
    __device__ __forceinline__ void mini(int row, int col, f32x4 v0, f32x4 v1, int lane) const {
        const float rs = __builtin_amdgcn_rsqf(ss[row] * (1.0f / 1024.0f) + 1e-6f);
        v0 = v0 * rs; v1 = v1 * rs;
#pragma unroll
        for (int i = 0; i < 4; ++i) { const float a = fmaxf(v0[i], 0.f), b = fmaxf(v1[i], 0.f); v0[i] = a * a; v1[i] = b * b; }
        u32x4 w; w.x = cvt_pk_bf16(v0[0], v0[1]); w.y = cvt_pk_bf16(v0[2], v0[3]); w.z = cvt_pk_bf16(v1[0], v1[1]); w.w = cvt_pk_bf16(v1[2], v1[3]);
        *(u32x4*)(H + (size_t)row * 4096 + col) = w;
    }
};

struct EpiT2 {
    static constexpr bool PERM = true, AFTER_DRAIN = false; static constexpr int NPRE = 0;
    bf16_t* T2;
    __device__ __forceinline__ void core(int row, int col, f32x4 v0, f32x4 v1) const {
        u32x4 w; w.x = cvt_pk_bf16(v0[0], v0[1]); w.y = cvt_pk_bf16(v0[2], v0[3]); w.z = cvt_pk_bf16(v1[0], v1[1]); w.w = cvt_pk_bf16(v1[2], v1[3]);
        *(u32x4*)(T2 + (size_t)row * 1024 + col) = w;
    }
    __device__ __forceinline__ void operator()(const f32x4 (&acc)[2][2][4][2], const Unit& u, int wr, int wc, int fr, int fq) const {
#pragma unroll
        for (int ai = 0; ai < 2; ++ai)
#pragma unroll
            for (int m = 0; m < 4; ++m) {
                const int row = u.pm * BM + ai * HALF + wr * 64 + m * 16 + fr;
#pragma unroll
                for (int bj = 0; bj < 2; ++bj) core(row, u.pn * BM + bj * HALF + wc * 32 + 8 * fq, acc[ai][bj][m][0], acc[ai][bj][m][1]);
            }
    }
    __device__ __forceinline__ void mini(int row, int col, f32x4 v0, f32x4 v1, int lane) const { core(row, col, v0, v1); }
};

struct EpiPle {
    static constexpr bool PERM = true, AFTER_DRAIN = false; static constexpr int NPRE = 0;
    const bf16_t* XB; bf16_t* X3; const bf16_t* T2; const float* ss2; float* ss3;
    __device__ __forceinline__ float core(int row, int col, f32x4 v0, f32x4 v1, float rs) const {
        const u32x4 t = *(const u32x4*)(T2 + (size_t)row * 1024 + col), b = *(const u32x4*)(XB + (size_t)row * 1024 + col);
        v0 = v0 * rs; v1 = v1 * rs;
        f32x4 a0, a1;
        a0[0] = bf_lo(b.x) + sigmoidf_(v0[0]) * bf_lo(t.x); a0[1] = bf_hi(b.x) + sigmoidf_(v0[1]) * bf_hi(t.x); a0[2] = bf_lo(b.y) + sigmoidf_(v0[2]) * bf_lo(t.y); a0[3] = bf_hi(b.y) + sigmoidf_(v0[3]) * bf_hi(t.y);
        a1[0] = bf_lo(b.z) + sigmoidf_(v1[0]) * bf_lo(t.z); a1[1] = bf_hi(b.z) + sigmoidf_(v1[1]) * bf_hi(t.z); a1[2] = bf_lo(b.w) + sigmoidf_(v1[2]) * bf_lo(t.w); a1[3] = bf_hi(b.w) + sigmoidf_(v1[3]) * bf_hi(t.w);
        u32x4 w; w.x = cvt_pk_bf16(a0[0], a0[1]); w.y = cvt_pk_bf16(a0[2], a0[3]); w.z = cvt_pk_bf16(a1[0], a1[1]); w.w = cvt_pk_bf16(a1[2], a1[3]);
        *(u32x4*)(X3 + (size_t)row * 1024 + col) = w;
        return ((a0[0] * a0[0] + a0[1] * a0[1]) + (a0[2] * a0[2] + a0[3] * a0[3])) + ((a1[0] * a1[0] + a1[1] * a1[1]) + (a1[2] * a1[2] + a1[3] * a1[3]));
    }
    __device__ __forceinline__ void operator()(const f32x4 (&acc)[2][2][4][2], const Unit& u, int wr, int wc, int fr, int fq) const {
#pragma unroll
        for (int ai = 0; ai < 2; ++ai)
#pragma unroll
            for (int m = 0; m < 4; ++m) {
                const int row = u.pm * BM + ai * HALF + wr * 64 + m * 16 + fr;
                const float rs = __builtin_amdgcn_rsqf(ss2[row] * (1.0f / 1024.0f) + 1e-6f);
                float q = 0.f;
#pragma unroll
                for (int bj = 0; bj < 2; ++bj) q += core(row, u.pn * BM + bj * HALF + wc * 32 + 8 * fq, acc[ai][bj][m][0], acc[ai][bj][m][1], rs);
                q += __shfl_xor(q, 16); q += __shfl_xor(q, 32);
                if (fq == 0) atomicAdd(ss3 + row, q);
            }
    }
    __device__ __forceinline__ void mini(int row, int col, f32x4 v0, f32x4 v1, int lane) const {
        const float rs = __builtin_amdgcn_rsqf(ss2[row] * (1.0f / 1024.0f) + 1e-6f);
        float q = core(row, col, v0, v1, rs);
        q += __shfl_xor(q, 1); q += __shfl_xor(q, 2);
        if ((lane & 3) == 0) atomicAdd(ss3 + row, q);
    }
};

template <class BarFn>
struct EpiPleF {
    static constexpr bool PERM = true, AFTER_DRAIN = true; static constexpr int NPRE = 0;
    EpiPle base; const float* nfin; float* yout; const BarFn& barrier;
    __device__ __forceinline__ void fused(f32x4 (&acc)[2][2][4][2], const Unit& u, int wr, int wc, int fr, int fq, PG8_LAS unsigned char*, int, int) const {
#pragma unroll
        for (int ai = 0; ai < 2; ++ai)
#pragma unroll
            for (int m = 0; m < 4; ++m) {
                const int row = u.pm * BM + ai * HALF + wr * 64 + m * 16 + fr;
                const float rs = __builtin_amdgcn_rsqf(base.ss2[row] * (1.0f / 1024.0f) + 1e-6f);
                float q = 0.f;
#pragma unroll
                for (int bj = 0; bj < 2; ++bj) {
                    const int col = u.pn * BM + bj * HALF + wc * 32 + 8 * fq;
                    const u32x4 t = *(const u32x4*)(base.T2 + (size_t)row * 1024 + col), b = *(const u32x4*)(base.XB + (size_t)row * 1024 + col);
                    const f32x4 v0 = acc[ai][bj][m][0] * rs, v1 = acc[ai][bj][m][1] * rs;
                    f32x4 a0, a1;
                    a0[0] = bf_lo(b.x) + sigmoidf_(v0[0]) * bf_lo(t.x); a0[1] = bf_hi(b.x) + sigmoidf_(v0[1]) * bf_hi(t.x); a0[2] = bf_lo(b.y) + sigmoidf_(v0[2]) * bf_lo(t.y); a0[3] = bf_hi(b.y) + sigmoidf_(v0[3]) * bf_hi(t.y);
                    a1[0] = bf_lo(b.z) + sigmoidf_(v1[0]) * bf_lo(t.z); a1[1] = bf_hi(b.z) + sigmoidf_(v1[1]) * bf_hi(t.z); a1[2] = bf_lo(b.w) + sigmoidf_(v1[2]) * bf_lo(t.w); a1[3] = bf_hi(b.w) + sigmoidf_(v1[3]) * bf_hi(t.w);
                    acc[ai][bj][m][0] = a0; acc[ai][bj][m][1] = a1;
                    q += ((a0[0] * a0[0] + a0[1] * a0[1]) + (a0[2] * a0[2] + a0[3] * a0[3])) + ((a1[0] * a1[0] + a1[1] * a1[1]) + (a1[2] * a1[2] + a1[3] * a1[3]));
                }
                q += __shfl_xor(q, 16); q += __shfl_xor(q, 32);
                if (fq == 0) atomicAdd(base.ss3 + row, q);
            }
        barrier();
        f32x4 nf[2][2];
#pragma unroll
        for (int bj = 0; bj < 2; ++bj) { const int col = u.pn * BM + bj * HALF + wc * 32 + 8 * fq; nf[bj][0] = *(const f32x4*)(nfin + col); nf[bj][1] = *(const f32x4*)(nfin + col + 4); }
#pragma unroll
        for (int ai = 0; ai < 2; ++ai)
#pragma unroll
            for (int m = 0; m < 4; ++m) {
                const int row = u.pm * BM + ai * HALF + wr * 64 + m * 16 + fr;
                const float r3 = 1.0f / sqrtf(base.ss3[row] * (1.0f / 1024.0f) + 1e-6f);
#pragma unroll
                for (int bj = 0; bj < 2; ++bj) {
                    float* yp = yout + (size_t)row * 1024 + u.pn * BM + bj * HALF + wc * 32 + 8 * fq;
                    *(f32x4*)yp = acc[ai][bj][m][0] * r3 * nf[bj][0]; *(f32x4*)(yp + 4) = acc[ai][bj][m][1] * r3 * nf[bj][1];
                }
            }
    }
    __device__ __forceinline__ void mini(int row, int col, f32x4 v0, f32x4 v1, int lane) const { base.mini(row, col, v0, v1, lane); }
};

template <class Epi, int KT, int NU>
__device__ __forceinline__ void mini_gemm_nu(int wave_idx, PG8_LAS unsigned char* lds, const bf16_t* A, const bf16_t* Bt, int N, int row_base, int first, int stride, const Epi& E) {
    int tid_ = mk_tid(wave_idx); asm volatile("" : "+v"(tid_));
    const int tid = tid_, w = __builtin_amdgcn_readfirstlane(tid >> 6), lane = tid & 63, r = lane & 15, q = lane >> 4;
    constexpr int KW = KT / 8, NKS = KW / 32, NBK = (NU * NKS <= 8) ? NKS : (8 / NU >= 1 ? 8 / NU : 1);
    static_assert(NKS % NBK == 0, "mini_gemm_nu: batch must divide the k-steps");
    PG8_LAS float* red = (PG8_LAS float*)lds;
    const int nunits = (N / 32) * 8;
    for (int u0 = first; u0 < nunits; u0 += NU * stride) {
        f32x4 acc0[NU], acc1[NU];
#pragma unroll
        for (int j = 0; j < NU; ++j) { acc0[j] = (f32x4){0.f, 0.f, 0.f, 0.f}; acc1[j] = (f32x4){0.f, 0.f, 0.f, 0.f}; }
#pragma unroll
        for (int k0 = 0; k0 < NKS; k0 += NBK) {
            bf16x8 af[NU][NBK], b0[NU][NBK], b1[NU][NBK];
#pragma unroll
            for (int j = 0; j < NU; ++j) { const int u = u0 + j * stride;
                if (u < nunits) { const int n0 = (u >> 3) * 32, r0 = row_base + 16 * (u & 7);
                    const bf16_t* ap = A + (size_t)(r0 + r) * KT + w * KW + 8 * q; const bf16_t* bp = Bt + (size_t)(n0 + r) * KT + w * KW + 8 * q;
#pragma unroll
                    for (int i = 0; i < NBK; ++i) { af[j][i] = *(const bf16x8*)(ap + 32 * (k0 + i)); b0[j][i] = *(const bf16x8*)(bp + 32 * (k0 + i)); b1[j][i] = *(const bf16x8*)(bp + (size_t)16 * KT + 32 * (k0 + i)); } } }
#pragma unroll
            for (int j = 0; j < NU; ++j) { if (u0 + j * stride < nunits) {
#pragma unroll
                for (int i = 0; i < NBK; ++i) { acc0[j] = __builtin_amdgcn_mfma_f32_16x16x32_bf16(af[j][i], b0[j][i], acc0[j], 0, 0, 0); acc1[j] = __builtin_amdgcn_mfma_f32_16x16x32_bf16(af[j][i], b1[j][i], acc1[j], 0, 0, 0); } } }
        }
#pragma unroll
        for (int j = 0; j < NU; ++j) { if (u0 + j * stride < nunits) {
#pragma unroll
            for (int rg = 0; rg < 4; ++rg) { red[((j * 8 + w) * 16 + 4 * q + rg) * 32 + r] = acc0[j][rg]; red[((j * 8 + w) * 16 + 4 * q + rg) * 32 + 16 + r] = acc1[j][rg]; } } }
        __syncthreads();
        if (w < NU && u0 + w * stride < nunits) {
            const int u = u0 + w * stride, n0 = (u >> 3) * 32, r0 = row_base + 16 * (u & 7);
            const int row = lane >> 2, c8 = (lane & 3) * 8;
            f32x4 v0 = (f32x4){0.f, 0.f, 0.f, 0.f}, v1 = (f32x4){0.f, 0.f, 0.f, 0.f};
#pragma unroll
            for (int ww = 0; ww < 8; ++ww) { const PG8_LAS f32x4* p = (const PG8_LAS f32x4*)(red + ((w * 8 + ww) * 16 + row) * 32 + c8); v0 += p[0]; v1 += p[1]; }
            E.mini(r0 + row, n0 + c8, v0, v1, lane);
        }
        __syncthreads();
    }
}
template <class Epi, int KT>
__device__ __forceinline__ void mini_gemm(int wave_idx, PG8_LAS unsigned char* lds, const bf16_t* A, const bf16_t* Bt, int N, int row_base, int first, int stride, const Epi& E) {
    int tid_ = mk_tid(wave_idx); asm volatile("" : "+v"(tid_));
    const int tid = tid_, w = __builtin_amdgcn_readfirstlane(tid >> 6), lane = tid & 63, r = lane & 15, q = lane >> 4;
    constexpr int KW = KT / 8, NKS = KW / 32, NB = NKS < 8 ? NKS : 8;
    PG8_LAS float* red = (PG8_LAS float*)lds;
    const int nunits = (N / 32) * 8;
    for (int u = first; u < nunits; u += stride) {
        const int n0 = (u >> 3) * 32, r0 = row_base + 16 * (u & 7);
        f32x4 acc0 = (f32x4){0.f, 0.f, 0.f, 0.f}, acc1 = (f32x4){0.f, 0.f, 0.f, 0.f};
        const bf16_t* ap = A + (size_t)(r0 + r) * KT + w * KW + 8 * q;
        const bf16_t* bp = Bt + (size_t)(n0 + r) * KT + w * KW + 8 * q;
#pragma unroll
        for (int k0 = 0; k0 < NKS; k0 += NB) {
            bf16x8 af[NB], b0[NB], b1[NB];
#pragma unroll
            for (int i = 0; i < NB; ++i) { af[i] = *(const bf16x8*)(ap + 32 * (k0 + i)); b0[i] = *(const bf16x8*)(bp + 32 * (k0 + i)); b1[i] = *(const bf16x8*)(bp + (size_t)16 * KT + 32 * (k0 + i)); }
#pragma unroll
            for (int i = 0; i < NB; ++i) { acc0 = __builtin_amdgcn_mfma_f32_16x16x32_bf16(af[i], b0[i], acc0, 0, 0, 0); acc1 = __builtin_amdgcn_mfma_f32_16x16x32_bf16(af[i], b1[i], acc1, 0, 0, 0); }
        }
#pragma unroll
        for (int rg = 0; rg < 4; ++rg) { red[(w * 16 + 4 * q + rg) * 32 + r] = acc0[rg]; red[(w * 16 + 4 * q + rg) * 32 + 16 + r] = acc1[rg]; }
        __syncthreads();
        if (tid < 64) {
            const int row = tid >> 2, c8 = (tid & 3) * 8;
            f32x4 v0 = (f32x4){0.f, 0.f, 0.f, 0.f}, v1 = (f32x4){0.f, 0.f, 0.f, 0.f};
#pragma unroll
            for (int ww = 0; ww < 8; ++ww) { const PG8_LAS f32x4* p = (const PG8_LAS f32x4*)(red + (ww * 16 + row) * 32 + c8); v0 += p[0]; v1 += p[1]; }
            E.mini(r0 + row, n0 + c8, v0, v1, lane);
        }
        __syncthreads();
    }
}
template <class Epi, class Sched, bool ALIGN_EPI = false, bool SP2 = false>
__device__ __forceinline__ void gemm_phase(int wave_idx, PG8_LAS unsigned char* lds, const Gemm g, const Sched& S, const Epi& E) {
    int tid_ = mk_tid(wave_idx); asm volatile("" : "+v"(tid_));
    const int tid = tid_, wid = __builtin_amdgcn_readfirstlane(tid >> 6), lane = tid & 63, wr = wid >> 2, wc = wid & 3, fr = lane & 15, fq = lane >> 4;
    int K_ = g.K; asm volatile("" : "+s"(K_));
    const int K = K_, nt = K / BK;
    unsigned voffA[2], voffB[2];
#pragma unroll
    for (int i = 0; i < 2; ++i) { int R, C; stage_rc(tid * 16 + i * 8192, R, C); const int Rb = Epi::PERM ? ((R & ~31) + perm32(R & 31)) : R;
        voffA[i] = (unsigned)(R * K + C) * 2u; voffB[i] = (unsigned)(Rb * K + C) * 2u; }
    const size_t kstep = (size_t)(BK * 2);
    const size_t hstep = (size_t)HALF * K * 2;
    const size_t tstep = 2 * hstep;
    const unsigned ldsw = (unsigned)wid * 1024u;
    const int aoff = lds_byte(wr * 64 + fr, fq * 8), boff = lds_byte(wc * 32 + fr, fq * 8);
#define PG8_SA(b, h) (((b) * 2 + (h)) * HTB)
#define PG8_SB(b, h) ((4 + (b) * 2 + (h)) * HTB)
#define PG8_STAGE(bufoff, gbase, voff) do { _Pragma("unroll") for (int _i = 0; _i < 2; ++_i) \
        __builtin_amdgcn_global_load_lds((const unsigned*)((const char*)(gbase) + (voff)[_i]), (PG8_LAS unsigned*)(lds + (bufoff) + ldsw + _i * 8192), 16, 0, 0); } while (0)
#define PG8_LDA(dst, b, h) do { _Pragma("unroll") for (int m = 0; m < 4; ++m) _Pragma("unroll") for (int k = 0; k < 2; ++k) dst[m][k] = *(const PG8_LAS bf16x8*)(lds + PG8_SA(b, h) + aoff + m * 2048 + k * 1024); } while (0)
#define PG8_LDB(dst, b, h) do { _Pragma("unroll") for (int n = 0; n < 2; ++n) _Pragma("unroll") for (int k = 0; k < 2; ++k) dst[n][k] = *(const PG8_LAS bf16x8*)(lds + PG8_SB(b, h) + boff + n * 2048 + k * 1024); } while (0)
#define PG8_MMA(ai, bj, At, Bt) do { __builtin_amdgcn_s_setprio(1); _Pragma("unroll") for (int m = 0; m < 4; ++m) _Pragma("unroll") for (int n = 0; n < 2; ++n) _Pragma("unroll") for (int k = 0; k < 2; ++k) \
        acc[ai][bj][m][n] = __builtin_amdgcn_mfma_f32_16x16x32_bf16(Bt[n][k], At[m][k], acc[ai][bj][m][n], 0, 0, 0); __builtin_amdgcn_s_setprio(0); } while (0)
#define PG8_WAIT_V(n) asm volatile("s_waitcnt vmcnt(" #n ")" ::: "memory")
#define PG8_WAIT_L(n) asm volatile("s_waitcnt lgkmcnt(" #n ")" ::: "memory")
#define PG8_BAR __builtin_amdgcn_s_barrier()
#define PG8_SCHED __builtin_amdgcn_sched_barrier(0)
    Unit cur, nxt; int ui = 0;
    if (!S.next(0, cur)) return;
    f32x4 acc[2][2][4][2];
#pragma unroll
    for (int a = 0; a < 2; ++a)
#pragma unroll
        for (int b = 0; b < 2; ++b)
#pragma unroll
            for (int m = 0; m < 4; ++m)
#pragma unroll
                for (int n = 0; n < 2; ++n) acc[a][b][m][n] = (f32x4){0.f, 0.f, 0.f, 0.f};
    bf16x8 At[4][2], B0[2][2], B1[2][2];
    const char* cA = (const char*)g.A + (size_t)cur.pm * tstep; const char* cB = (const char*)g.Bt + (size_t)cur.pn * tstep;
    S.a_ready(cur);
    if constexpr (SP2) {
        PG8_STAGE(PG8_SB(0, 0), cB, voffB); PG8_STAGE(PG8_SB(0, 1), cB + hstep, voffB); PG8_STAGE(PG8_SA(0, 0), cA, voffA); PG8_STAGE(PG8_SA(0, 1), cA + hstep, voffA);
        if (wr == 1) PG8_BAR;
        PG8_WAIT_V(2); PG8_BAR;
        PG8_STAGE(PG8_SB(1, 0), cB + kstep, voffB); PG8_STAGE(PG8_SA(1, 0), cA + kstep, voffA); PG8_STAGE(PG8_SB(1, 1), cB + hstep + kstep, voffB);
        PG8_WAIT_V(6); PG8_BAR;
    } else {
        PG8_STAGE(PG8_SB(0, 0), cB, voffB); PG8_STAGE(PG8_SA(0, 0), cA, voffA); PG8_STAGE(PG8_SB(0, 1), cB + hstep, voffB); PG8_STAGE(PG8_SA(0, 1), cA + hstep, voffA);
        if (wr == 1) PG8_BAR;
        PG8_WAIT_V(4); PG8_BAR;
        PG8_STAGE(PG8_SB(1, 0), cB + kstep, voffB); PG8_STAGE(PG8_SA(1, 0), cA + kstep, voffA); PG8_STAGE(PG8_SB(1, 1), cB + hstep + kstep, voffB);
        PG8_WAIT_V(6); PG8_BAR;
    }
    for (;;) {
        const bool has_next = S.next(ui + 1, nxt);
        if constexpr (Epi::NPRE > 0) {
            const float* pp = E.pre_base(cur, wr) + lane;
            __builtin_amdgcn_global_load_lds((const unsigned*)pp, (PG8_LAS unsigned*)(lds + PRE_OFF + wid * 512), 4, 0, 0);
            __builtin_amdgcn_global_load_lds((const unsigned*)(pp + 128), (PG8_LAS unsigned*)(lds + PRE_OFF + wid * 512 + 256), 4, 0, 0);
        }
        const char* nA = has_next ? (const char*)g.A + (size_t)nxt.pm * tstep : cA; const char* nB = has_next ? (const char*)g.Bt + (size_t)nxt.pn * tstep : cB;
        for (int t = 0; t < nt; t += 2) {
            const bool last = (t == nt - 2);
            const char* a1 = cA + (size_t)(t + 1) * kstep;
            const char* a2 = last ? nA : cA + (size_t)(t + 2) * kstep; const char* b2 = last ? nB : cB + (size_t)(t + 2) * kstep;
            const char* a3 = a2 + kstep; const char* b3 = b2 + kstep;
            if (last && has_next) S.a_ready(nxt);
            if constexpr (SP2) {
            PG8_LDB(B0, 0, 0); PG8_LDB(B1, 0, 1); PG8_SCHED; PG8_LDA(At, 0, 0); PG8_STAGE(PG8_SA(1, 1), a1 + hstep, voffA);
            PG8_WAIT_V(8); PG8_WAIT_L(0); PG8_BAR; PG8_MMA(0, 0, At, B0); PG8_MMA(0, 1, At, B1); PG8_BAR; PG8_SCHED;
            PG8_LDA(At, 0, 1); PG8_STAGE(PG8_SB(0, 0), b2, voffB); PG8_STAGE(PG8_SB(0, 1), b2 + hstep, voffB); PG8_STAGE(PG8_SA(0, 0), a2, voffA);
            PG8_WAIT_V(8); PG8_WAIT_L(0); PG8_BAR; PG8_MMA(1, 0, At, B0); PG8_MMA(1, 1, At, B1); PG8_BAR; PG8_SCHED;
            PG8_LDB(B0, 1, 0); PG8_LDB(B1, 1, 1); PG8_SCHED; PG8_LDA(At, 1, 0); PG8_STAGE(PG8_SA(0, 1), a2 + hstep, voffA);
            PG8_WAIT_V(8); PG8_WAIT_L(0); PG8_BAR; PG8_MMA(0, 0, At, B0); PG8_MMA(0, 1, At, B1); PG8_BAR; PG8_SCHED;
            PG8_LDA(At, 1, 1); PG8_STAGE(PG8_SB(1, 0), b3, voffB); PG8_STAGE(PG8_SB(1, 1), b3 + hstep, voffB); PG8_STAGE(PG8_SA(1, 0), a3, voffA);
            PG8_WAIT_V(8); PG8_WAIT_L(0); PG8_BAR; PG8_MMA(1, 0, At, B0); PG8_MMA(1, 1, At, B1); PG8_BAR; PG8_SCHED;
            } else {
            PG8_LDB(B0, 0, 0); PG8_SCHED; PG8_LDA(At, 0, 0); PG8_STAGE(PG8_SA(1, 1), a1 + hstep, voffA);
            PG8_WAIT_L(8); PG8_BAR; PG8_WAIT_L(0); PG8_MMA(0, 0, At, B0); PG8_BAR; PG8_SCHED;
            PG8_LDB(B1, 0, 1); PG8_STAGE(PG8_SB(0, 0), b2, voffB);
            PG8_BAR; PG8_WAIT_L(0); PG8_MMA(0, 1, At, B1); PG8_BAR;
            PG8_LDA(At, 0, 1); PG8_STAGE(PG8_SA(0, 0), a2, voffA);
            PG8_BAR; PG8_WAIT_L(0); PG8_MMA(1, 0, At, B0); PG8_BAR; PG8_SCHED;
            PG8_STAGE(PG8_SB(0, 1), b2 + hstep, voffB);
            PG8_WAIT_V(6); PG8_BAR; PG8_MMA(1, 1, At, B1); PG8_BAR;
            PG8_LDB(B0, 1, 0); PG8_SCHED; PG8_LDA(At, 1, 0); PG8_STAGE(PG8_SA(0, 1), a2 + hstep, voffA);
            PG8_WAIT_L(8); PG8_BAR; PG8_WAIT_L(0); PG8_MMA(0, 0, At, B0); PG8_BAR; PG8_SCHED;
            PG8_LDB(B1, 1, 1); PG8_STAGE(PG8_SB(1, 0), b3, voffB);
            PG8_BAR; PG8_WAIT_L(0); PG8_MMA(0, 1, At, B1); PG8_BAR;
            PG8_LDA(At, 1, 1); PG8_STAGE(PG8_SA(1, 0), a3, voffA);
            PG8_BAR; PG8_WAIT_L(0); PG8_MMA(1, 0, At, B0); PG8_BAR; PG8_SCHED;
            PG8_STAGE(PG8_SB(1, 1), b3 + hstep, voffB);
            PG8_WAIT_V(6); PG8_BAR; PG8_MMA(1, 1, At, B1); PG8_BAR;
            }
        }
        if constexpr (ALIGN_EPI) { if (wr == 0) PG8_BAR; }
        if constexpr (Epi::NPRE > 0) { E(acc, cur, wr, wc, fr, fq, (const PG8_LAS float*)(lds + PRE_OFF + wid * 512)); S.done(cur); } else
        if constexpr (!Epi::AFTER_DRAIN) { E(acc, cur, wr, wc, fr, fq); S.done(cur); }
        if (!has_next) break;
#pragma unroll
        for (int a = 0; a < 2; ++a)
#pragma unroll
            for (int b = 0; b < 2; ++b)
#pragma unroll
                for (int m = 0; m < 4; ++m)
#pragma unroll
                    for (int n = 0; n < 2; ++n) acc[a][b][m][n] = (f32x4){0.f, 0.f, 0.f, 0.f};
        cur = nxt; cA = nA; cB = nB; ++ui;
        if constexpr (ALIGN_EPI) { if (wr == 1) PG8_BAR; }
    }
    PG8_WAIT_V(0);
    if constexpr (!ALIGN_EPI) { if (wr == 0) PG8_BAR; }
    PG8_BAR;
    if constexpr (Epi::AFTER_DRAIN) { E.fused(acc, cur, wr, wc, fr, fq, lds, wid, lane); S.done(cur); }
#undef PG8_SA
#undef PG8_SB
#undef PG8_STAGE
#undef PG8_LDA
#undef PG8_LDB
#undef PG8_MMA
#undef PG8_WAIT_V
#undef PG8_WAIT_L
#undef PG8_BAR
#undef PG8_SCHED
}
}
#define GAS __attribute__((address_space(1)))
#define LAS __attribute__((address_space(3)))
typedef unsigned short bf16;
typedef unsigned v4u __attribute__((ext_vector_type(4)));
typedef float f32x4 __attribute__((ext_vector_type(4)));
typedef short bf16x8 __attribute__((ext_vector_type(8)));
typedef GAS unsigned gu32;
typedef GAS unsigned long long gu64;
#define RLX_AGENT __ATOMIC_RELAXED, __HIP_MEMORY_SCOPE_AGENT
#define LDS_WAIT() asm volatile("s_waitcnt lgkmcnt(0)" ::: "memory")
#define VM_WAIT() asm volatile("s_waitcnt vmcnt(0)" ::: "memory")
__device__ __forceinline__ unsigned long long rt() { return __builtin_amdgcn_s_memrealtime(); }
__device__ __forceinline__ unsigned f2bf(float f) { unsigned u = __builtin_bit_cast(unsigned, f); return (u + 0x7fffu + ((u >> 16) & 1u)) >> 16; }
typedef float f32x2_cv __attribute__((ext_vector_type(2))); typedef __bf16 bf16x2_cv __attribute__((ext_vector_type(2)));
__device__ __forceinline__ unsigned pk2(float lo, float hi) { const f32x2_cv v = {lo, hi}; return __builtin_bit_cast(unsigned, __builtin_convertvector(v, bf16x2_cv)); }
__device__ __forceinline__ unsigned f2bf_hw(float f) { return pk2(f, f) & 0xffffu; }

#define XB_TMO      128
#define XB_XCNT(j)  (256  + 64 * (j))
#define XB_XSUB(j)  (1280 + 64 * (j))
#define XB_XGEN(j)  (2304 + 64 * (j))
#define XB_TOP      3328
#define XB_TOPGEN   3392
#define XCD_BAR_WORDS 3456
#define XB_SPIN_CAP (1u << 18)

__device__ __forceinline__ unsigned xb_ld(unsigned* p)              { return __hip_atomic_load(p, __ATOMIC_RELAXED, __HIP_MEMORY_SCOPE_AGENT); }
__device__ __forceinline__ unsigned xb_add(unsigned* p, unsigned v) { return __hip_atomic_fetch_add(p, v, __ATOMIC_RELAXED, __HIP_MEMORY_SCOPE_AGENT); }
__device__ __forceinline__ unsigned xb_xcc_id() { return (unsigned)__builtin_amdgcn_s_getreg((3 << 11) | 20) & 0xFu; }
#define XB_SPIN(cond, bar) do { unsigned _sp = 0; while (cond) { __builtin_amdgcn_s_sleep(1); \
    if ((++_sp & 255u) == 0u) { if (xb_ld(&(bar)[XB_TMO])) break; if (_sp > XB_SPIN_CAP) { atomicAdd(&(bar)[XB_TMO], 1u); break; } } } } while (0)

struct XcdBarrier {
    unsigned* bar; unsigned x;
    volatile LAS unsigned* st;
};

__device__ __forceinline__ XcdBarrier xcd_barrier_post(unsigned* bar, volatile LAS unsigned* st) {
    XcdBarrier b; b.bar = bar; b.x = xb_xcc_id(); b.st = st;
    if (threadIdx.x == 0) (void)xb_add(&bar[XB_XCNT(b.x)], 1u);
    return b;
}
__device__ __forceinline__ void xcd_barrier_complete(unsigned* bar, unsigned x, unsigned& nloc, unsigned& nx) {
    const unsigned G = gridDim.x * gridDim.y * gridDim.z;
    unsigned sum, cnt, mine, sp = 0u;
    for (;;) {
        sum = 0u; cnt = 0u; mine = 0u;
#pragma unroll
        for (unsigned j = 0; j < 16; ++j) { const unsigned c = xb_ld(&bar[XB_XCNT(j)]); sum += c; cnt += (c > 0u) ? 1u : 0u; mine = (j == x) ? c : mine; }
        if (sum == G) break;
        __builtin_amdgcn_s_sleep(1);
        if ((++sp & 255u) == 0u) { if (xb_ld(&bar[XB_TMO])) break; if (sp > XB_SPIN_CAP) { atomicAdd(&bar[XB_TMO], 1u); break; } }
    }
    nloc = mine > 0u ? mine : 1u; nx = cnt > 0u ? cnt : 1u;
}

__device__ __forceinline__ void xcd_barrier(const XcdBarrier& b, int tid) {
    asm volatile("s_waitcnt vmcnt(0)" ::: "memory");
    __syncthreads();
    if (tid == 0) {
        unsigned* bar = b.bar;
        __builtin_amdgcn_s_waitcnt(0);
        unsigned nloc = b.st[0], nx = b.st[1];
        if (nloc == 0u) { xcd_barrier_complete(bar, b.x, nloc, nx); b.st[0] = nloc; b.st[1] = nx; }
        const unsigned old = xb_add(&bar[XB_XSUB(b.x)], 1u);
        const unsigned gen = old / nloc;
        if (old + 1u == (gen + 1u) * nloc) {
            __builtin_amdgcn_fence(__ATOMIC_RELEASE, "agent");
            asm volatile("s_waitcnt vmcnt(0)" ::: "memory");
            const unsigned og = xb_add(&bar[XB_TOP], 1u);
            const unsigned tg = og / nx;
            if (og + 1u == (tg + 1u) * nx) xb_add(&bar[XB_TOPGEN], 1u);
            else XB_SPIN(xb_ld(&bar[XB_TOPGEN]) == tg, bar);
            __builtin_amdgcn_fence(__ATOMIC_ACQUIRE, "agent");
            xb_add(&bar[XB_XGEN(b.x)], 1u);
            asm volatile("s_waitcnt vmcnt(0)" ::: "memory");
        } else {
            XB_SPIN(xb_ld(&bar[XB_XGEN(b.x)]) == gen, bar);
            __builtin_amdgcn_fence(__ATOMIC_ACQUIRE, "agent");
            asm volatile("s_waitcnt vmcnt(0)" ::: "memory");
        }
    }
    __syncthreads();
}

#define LB_SUB(j)  (64 * (j))
#define LB_GEN(j)  (1024 + 64 * (j))
#define LB_MISM    2048
__device__ __forceinline__ void xcd_local_barrier(const XcdBarrier& b, unsigned* lbar, int tid) {
    asm volatile("s_waitcnt vmcnt(0)" ::: "memory");
    __syncthreads();
    if (tid == 0) {
        __builtin_amdgcn_s_waitcnt(0);
        const unsigned nloc = b.st[0];
        const unsigned old = xb_add(&lbar[LB_SUB(b.x)], 1u);
        const unsigned gen = old / nloc;
        if (old + 1u == (gen + 1u) * nloc) xb_add(&lbar[LB_GEN(b.x)], 1u);
        else XB_SPIN(xb_ld(&lbar[LB_GEN(b.x)]) == gen, b.bar);
        __builtin_amdgcn_fence(__ATOMIC_ACQUIRE, "agent");
        asm volatile("s_waitcnt vmcnt(0)" ::: "memory");
    }
    __syncthreads();
}
typedef unsigned u32x2_t __attribute__((ext_vector_type(2)));
typedef unsigned u32x4_t __attribute__((ext_vector_type(4)));
typedef float f32x2_t __attribute__((ext_vector_type(2)));

constexpr int NWAVES = 8;
constexpr int NTOK_P = pg8::NTOK_P, NTOK = pg8::NTOK, MPAD = pg8::MPAD, ZC = pg8::ZC;
constexpr int DM = 1024, DFF = 4096, SEQ = 8192;
constexpr int ZQ = 3328, ZK = 4096, ZV = 4864, ZGA = 5632, ZGB = 6656;
using pg8::OFF_Y_P; using pg8::OFF_Y_S; using pg8::OFF_WKV_P; using pg8::OFF_WKV_S; using pg8::OUT_TOTAL;

constexpr size_t MiB = 1u << 20;
constexpr size_t WS_CTL = 0, CTL_ZERO_BYTES = 1 * MiB;
constexpr size_t WS_WIN = 1 * MiB, WS_WLORA = 16 * MiB, WS_WBR = 18 * MiB, WS_WBA = 20 * MiB, WS_WOUT = 21 * MiB, WS_WFF1 = 23 * MiB, WS_WFF2 = 31 * MiB, WS_WPG = 39 * MiB, WS_WPLE = 41 * MiB;
constexpr size_t WS_STAT = 42 * MiB;
constexpr size_t WS_LSE = 43 * MiB;
constexpr size_t WS_XB = 44 * MiB;
constexpr size_t WS_OBUF = 44 * MiB;
constexpr size_t WS_Z = 77 * MiB;
constexpr size_t WS_X1 = 77 * MiB, WS_X1B = 142 * MiB, WS_HDN = 175 * MiB, WS_T2 = 175 * MiB;
constexpr size_t WS_ALORA = 321 * MiB;
constexpr size_t WS_ATTN = 321 * MiB;
constexpr size_t WS_LW = 330 * MiB;
constexpr size_t WS_MIX = 330 * MiB;
constexpr size_t WS_PG = 363 * MiB;
constexpr size_t WS_AA = 395 * MiB;
constexpr size_t WS_RO = 395 * MiB;
constexpr size_t WS_GG = 428 * MiB;
constexpr size_t WS_GT = 461 * MiB;
constexpr size_t WS_PB = 494 * MiB, WS_GAM = 503 * MiB, WS_RK = 504 * MiB, WS_END = 505 * MiB;
static_assert(WS_Z + (size_t)MPAD * ZC * 2 <= WS_ALORA && WS_HDN + (size_t)MPAD * DFF * 2 <= WS_ALORA && WS_X1 + (size_t)MPAD * DM * 4 <= WS_X1B && WS_X1B + (size_t)MPAD * DM * 2 <= WS_HDN, "ws map");
static_assert(WS_LW + (size_t)MPAD * DM * 2 <= WS_PG && WS_PG + (size_t)4096 * 8192 <= WS_AA && WS_AA + (size_t)MPAD * DM * 2 <= WS_GG && WS_GG + (size_t)MPAD * DM * 2 <= WS_GT && WS_GT + (size_t)4096 * 8192 <= WS_PB && WS_PB + (size_t)MPAD * 256 * 2 <= WS_GAM, "ws map 2");
static_assert(WS_XB + (size_t)MPAD * DM * 2 <= WS_Z && WS_ALORA + (size_t)MPAD * 256 * 2 <= WS_LW && WS_LSE + (size_t)MPAD * 12 * 4 <= WS_XB && WS_STAT + (size_t)MPAD * 16 <= WS_LSE, "ws map 3");
constexpr int CW_TMO = 0, CW_CODE = 1, CW_BAR = 4096, CW_QUEUE = 8192, CW_QUEUE2 = 8192 + 64, CW_PROG = 12288, CW_XS = 16384, CW_LBAR = 20480;

constexpr int RING_OFF = 0, RING_BYTES = 131072;
constexpr int LDSCTL_OFF = RING_BYTES, MISC_OFF = LDSCTL_OFF + 320;
constexpr int LDS_BYTES = 147456;

struct Frame {
    LAS unsigned char* lds;
    volatile LAS unsigned* MISC;
    gu32* ctl;
    int tid, lane, wave;
    int vcu, G;
};

__device__ __forceinline__ float wave_sum(float v) {
#pragma unroll
    for (int o = 1; o < 64; o <<= 1) v += __shfl_xor(v, o);
    return v;
}
__device__ __forceinline__ float wave_max(float v) {
#pragma unroll
    for (int o = 1; o < 64; o <<= 1) v = fmaxf(v, __shfl_xor(v, o));
    return v;
}
__device__ __forceinline__ float bf2f(bf16 h) { return __uint_as_float((unsigned)h << 16); }
__device__ __forceinline__ float bflo(unsigned w) { return __uint_as_float(w << 16); }
__device__ __forceinline__ float bfhi(unsigned w) { return __uint_as_float(w & 0xffff0000u); }
__device__ __forceinline__ float sigm(float x) { return 1.0f / (1.0f + __expf(-x)); }

__device__ __forceinline__ void p0_transpose_item(const float* W, int K, int N, bf16* WT, const float* gain, LAS float* scr, int item, int lane) {
    const int nblk = N / 32, kb = item / nblk, nb = item % nblk, k0 = 64 * kb, n0 = 32 * nb;
    const int c = lane & 7;
    float v[32];
    const float* wp = W + (size_t)(k0 + (lane >> 5)) * N + n0 + (lane & 31);
#pragma unroll
    for (int i = 0; i < 32; ++i) v[i] = wp[(size_t)(2 * i) * N];
    f32x4 ga = (f32x4){1.f, 1.f, 1.f, 1.f}, gb = ga;
    if (gain) { ga = *(const f32x4*)(gain + k0 + 8 * c); gb = *(const f32x4*)(gain + k0 + 8 * c + 4); }
#pragma unroll
    for (int i = 0; i < 32; ++i) scr[(2 * i + (lane >> 5)) * 33 + (lane & 31)] = v[i];
    LDS_WAIT(); asm volatile("" ::: "memory");
#pragma unroll
    for (int j = 0; j < 4; ++j) { const int n = (lane >> 3) + 8 * j; const LAS float* s = scr + (8 * c) * 33 + n;
        v4u o; o.x = pk2(s[0 * 33] * ga.x, s[1 * 33] * ga.y); o.y = pk2(s[2 * 33] * ga.z, s[3 * 33] * ga.w); o.z = pk2(s[4 * 33] * gb.x, s[5 * 33] * gb.y); o.w = pk2(s[6 * 33] * gb.z, s[7 * 33] * gb.w);
        *(GAS v4u*)(WT + (size_t)(n0 + n) * K + k0 + 8 * c) = o; }
    LDS_WAIT(); asm volatile("" ::: "memory");
}

struct In {
    const float *x_prompt, *x_sample, *cache0, *cache1, *cache2, *state_wkv, *state_shift, *p_prompt, *p_sample, *norm_mix, *w_in, *shift_mu, *decay_w0, *decay_w2, *aaa_a0, *aaa_a2,
                *gate_g2, *k_k, *k_a, *r_k, *lnx_w, *lnx_b, *w_br, *w_ba, *w_out, *norm_mlp, *w_ff1, *w_ff2, *norm_ple, *w_ple, *w_pg, *norm_final;
};
struct Args { In in; float* out; unsigned char* ws; };

__device__ __forceinline__ void p0_prologue(Frame& F, const In& I, unsigned char* ws) {
    LAS float* scr = (LAS float*)(F.lds + RING_OFF + F.wave * 16384);
    const int gw = F.vcu * NWAVES + F.wave, NGW = F.G * NWAVES, lane = F.lane;
    constexpr int I_IN = (1024 / 64) * (7680 / 32);
    for (int it = gw; it < I_IN; it += NGW) p0_transpose_item(I.w_in, 1024, 7680, (bf16*)(ws + WS_WIN), I.norm_mix, scr, it, lane);
    {
        bf16* WL = (bf16*)(ws + WS_WLORA);
        const int gt = gw * 64 + lane, NGT = NGW * 64;
        for (int idx = gt; idx < 3072 * 32; idx += NGT) {
            const int n = idx >> 5, kc = (idx & 31) * 8, blk = n >> 10, nn = n & 1023;
            float v[8];
#pragma unroll
            for (int j = 0; j < 8; ++j) { const int k = kc + j; float x = 0.f;
                if (blk == 0) { if (k < 64) x = I.decay_w2[(size_t)k * 1024 + nn]; }
                else if (blk == 1) { if (k >= 64 && k < 128) x = I.aaa_a2[(size_t)(k - 64) * 1024 + nn]; }
                else { if (k >= 128) x = I.gate_g2[(size_t)(k - 128) * 1024 + nn]; }
                v[j] = x; }
            v4u o; o.x = pk2(v[0], v[1]); o.y = pk2(v[2], v[3]); o.z = pk2(v[4], v[5]); o.w = pk2(v[6], v[7]);
            *(GAS v4u*)(WL + (size_t)n * 256 + kc) = o;
        }
    }
    bf16* XB = (bf16*)(ws + WS_XB); float* stat = (float*)(ws + WS_STAT);
    for (int mb = gw; mb < MPAD; mb += 4 * NGW) {
        f32x4 v[4][4];
#pragma unroll
        for (int u = 0; u < 4; ++u) { const int m = mb + u * NGW;
#pragma unroll
            for (int j = 0; j < 4; ++j) v[u][j] = (f32x4){0.f, 0.f, 0.f, 0.f};
            if (m < NTOK) { const float* xrow = m < NTOK_P ? I.x_prompt + (size_t)m * DM : I.x_sample + (size_t)(m - NTOK_P) * DM; const GAS f32x4* xr = (const GAS f32x4*)xrow + lane;
#pragma unroll
                for (int j = 0; j < 4; ++j) v[u][j] = xr[64 * j]; } }
#pragma unroll
        for (int u = 0; u < 4; ++u) { const int m = mb + u * NGW;
            if (m < MPAD) {
                GAS unsigned long long* o8 = (GAS unsigned long long*)(XB + (size_t)m * DM) + lane;
                float s = 0.f;
#pragma unroll
                for (int j = 0; j < 4; ++j) s += (v[u][j].x * v[u][j].x + v[u][j].y * v[u][j].y) + (v[u][j].z * v[u][j].z + v[u][j].w * v[u][j].w);
                s = wave_sum(s);
                if (lane == 0) stat[m] = m < NTOK ? 1.0f / sqrtf(s * (1.0f / DM) + 1e-6f) : 0.f;
#pragma unroll
                for (int j = 0; j < 4; ++j) o8[64 * j] = (unsigned long long)pk2(v[u][j].x, v[u][j].y) | ((unsigned long long)pk2(v[u][j].z, v[u][j].w) << 32);
                if (lane < 3) stat[(size_t)(1 + lane) * MPAD + m] = 0.f;
            } }
    }
}
__device__ __forceinline__ void p0_late(Frame& F, const In& I, unsigned char* ws, int hw, int nhw, int it_lo, int it_hi, int m_lo, int m_hi) {
    LAS float* scr = (LAS float*)(F.lds + RING_OFF + F.wave * 16384);
    const int lane = F.lane;
    constexpr int I_SQ = (1024 / 64) * (1024 / 32), I_BA = (256 / 64) * (1024 / 32), I_F1 = (1024 / 64) * (4096 / 32), I_F2 = (4096 / 64) * (1024 / 32);
    constexpr int NITEMS = 3 * I_SQ + 2 * I_BA + I_F1 + I_F2;
    for (int it = it_lo + hw; it < (it_hi < NITEMS ? it_hi : NITEMS); it += nhw) {
        int r = it;
        if (r < I_SQ) { p0_transpose_item(I.w_br, 1024, 1024, (bf16*)(ws + WS_WBR), nullptr, scr, r, lane); continue; } r -= I_SQ;
        if (r < I_SQ) { p0_transpose_item(I.w_out, 1024, 1024, (bf16*)(ws + WS_WOUT), nullptr, scr, r, lane); continue; } r -= I_SQ;
        if (r < I_SQ) { p0_transpose_item(I.w_pg, 1024, 1024, (bf16*)(ws + WS_WPG), I.norm_ple, scr, r, lane); continue; } r -= I_SQ;
        if (r < I_BA) { p0_transpose_item(I.w_ba, 256, 1024, (bf16*)(ws + WS_WBA), nullptr, scr, r, lane); continue; } r -= I_BA;
        if (r < I_BA) { p0_transpose_item(I.w_ple, 256, 1024, (bf16*)(ws + WS_WPLE), nullptr, scr, r, lane); continue; } r -= I_BA;
        if (r < I_F1) { p0_transpose_item(I.w_ff1, 1024, 4096, (bf16*)(ws + WS_WFF1), I.norm_mlp, scr, r, lane); continue; } r -= I_F1;
        p0_transpose_item(I.w_ff2, 4096, 1024, (bf16*)(ws + WS_WFF2), nullptr, scr, r, lane);
    }
    bf16* PB = (bf16*)(ws + WS_PB);
    const int m_end = m_hi < MPAD ? m_hi : MPAD;
    for (int mb = m_lo + hw; mb < m_end; mb += 4 * nhw) {
        f32x4 pv[4];
#pragma unroll
        for (int u = 0; u < 4; ++u) { const int m = mb + u * nhw; pv[u] = (f32x4){0.f, 0.f, 0.f, 0.f};
            if (m < NTOK) { const float* prow = m < NTOK_P ? I.p_prompt + (size_t)m * 256 : I.p_sample + (size_t)(m - NTOK_P) * 256; pv[u] = ((const GAS f32x4*)prow)[lane]; } }
#pragma unroll
        for (int u = 0; u < 4; ++u) { const int m = mb + u * nhw;
            if (m < m_end) ((GAS unsigned long long*)(PB + (size_t)m * 256))[lane] = (unsigned long long)pk2(pv[u].x, pv[u].y) | ((unsigned long long)pk2(pv[u].z, pv[u].w) << 32); }
    }
}

struct LoraGroup {
    u32x2_t zr[8], zp; f32x4 pv0, pv4; int kind;
    __device__ __forceinline__ void load(const In& I, const bf16* Z, int grp, int c) {
        kind = 0; pv0 = (f32x4){0.f, 0.f, 0.f, 0.f}; pv4 = pv0; zp = (u32x2_t){0u, 0u};
#pragma unroll
        for (int i = 0; i < 8; ++i) zr[i] = (u32x2_t){0u, 0u};
        if (grp >= MPAD / 8) return;
        const int m0 = grp * 8;
        if (m0 >= NTOK) { kind = 3; return; }
        const bf16* zb = Z + (size_t)m0 * ZC + 3072 + c;
#pragma unroll
        for (int i = 0; i < 8; ++i) zr[i] = *(const u32x2_t*)(zb + (size_t)i * ZC);
        if (m0 >= NTOK_P) { kind = 2; const float* sp = I.state_shift + (size_t)((m0 - NTOK_P) >> 2) * 3328 + 3072 + c; pv0 = *(const f32x4*)sp; pv4 = *(const f32x4*)(sp + 3328); }
        else { kind = 1; if ((m0 & (SEQ - 1)) != 0) zp = *(const u32x2_t*)(zb - ZC); }
    }
    __device__ __forceinline__ void finish(bf16* AL, int grp, int c, const f32x4 mu) const {
        if (kind == 0) return;
        GAS unsigned long long* ao = (GAS unsigned long long*)(AL + (size_t)grp * 8 * 256 + c);
        if (kind == 3) {
#pragma unroll
            for (int i = 0; i < 8; ++i) ao[(size_t)i * 64] = 0ull;
            return;
        }
        const bool ident = c >= 64 && c < 128; const float ka = c < 64 ? 2.0f : 1.0f, kb = c < 64 ? -1.0f : 0.0f;
#pragma unroll
        for (int i = 0; i < 8; ++i) {
            const f32x4 z = (f32x4){bflo(zr[i].x), bfhi(zr[i].x), bflo(zr[i].y), bfhi(zr[i].y)};
            const u32x2_t q = i > 0 ? zr[i > 0 ? i - 1 : 0] : zp;
            f32x4 pr = (f32x4){bflo(q.x), bfhi(q.x), bflo(q.y), bfhi(q.y)};
            if (kind == 2) { if (i == 0) pr = pv0; if (i == 4) pr = pv4; }
            f32x4 zs; zs.x = z.x + (pr.x - z.x) * mu.x; zs.y = z.y + (pr.y - z.y) * mu.y; zs.z = z.z + (pr.z - z.z) * mu.z; zs.w = z.w + (pr.w - z.w) * mu.w;
            float r[4];
#pragma unroll
            for (int e = 0; e < 4; ++e) { const float sg = __builtin_amdgcn_rcpf(1.0f + __expf(-ka * zs[e])); const float t = ka * sg + kb; r[e] = ident ? zs[e] : t; }
            ao[(size_t)i * 64] = (unsigned long long)pk2(r[0], r[1]) | ((unsigned long long)pk2(r[2], r[3]) << 32);
        }
    }
};
__device__ __forceinline__ void p2a_all(Frame& F, const In& I, unsigned char* ws, float* out) {
    const int gw = F.vcu * NWAVES + F.wave, NGW = F.G * NWAVES, lane = F.lane;
    const bf16* Z = (const bf16*)(ws + WS_Z); bf16* AL = (bf16*)(ws + WS_ALORA);
    const int c = 4 * lane;
    const f32x4 mu = *(const f32x4*)(I.shift_mu + 3072 + c);
    constexpr int NKVP = 10752, NKV = NKVP + 768, NIT = NKV + 34 * 13, UN = 6, NGRP = MPAD / 8;
    for (int p = 0; gw + p * UN * NGW < NIT || gw + 2 * p * NGW < NGRP; ++p) {
        const int j0 = gw + p * UN * NGW, g0 = gw + 2 * p * NGW;
        int g1 = g0 + NGW;
        if (NGW * 8 == NTOK_P) { const int cls = gw >> 8, wl_ = gw & 255;
            g1 = wl_ < 2 ? NTOK_P / 8 + 2 * cls + wl_ : (wl_ < 4 ? NTOK / 8 + 2 * cls + wl_ - 2 : NGRP); }
        u32x2_t zv[UN]; size_t doff[UN];
#pragma unroll
        for (int u = 0; u < UN; ++u) {
            const int j = j0 + u * NGW; zv[u] = (u32x2_t){0u, 0u}; doff[u] = 0;
            if (j < NIT) {
                size_t srow; int col;
                if (j < NKVP) { const int b = j / 5376, q = j % 5376, g = q < 256 ? 0 : (q < 1280 ? 1 : 2), q0 = q - (g == 0 ? 0 : (g == 1 ? 256 : 1280)), rr = q0 >> 1, kvsel = q0 & 1, keep = 128 << (2 * g);
                    srow = (size_t)b * SEQ + (SEQ - keep + rr); col = (kvsel ? ZV : ZK) + g * 256;
                    doff[u] = (g == 0 ? pg8::OFF_KVP0 : (g == 1 ? pg8::OFF_KVP1 : pg8::OFF_KVP2)) + ((size_t)(b * keep + rr) * 2 + kvsel) * 256; }
                else if (j < NKV) { const int jj = j - NKVP, sr = jj / 6, kg = jj % 6, kvsel = kg / 3, g = kg % 3;
                    srow = (size_t)NTOK_P + sr; col = (kvsel ? ZV : ZK) + g * 256;
                    doff[u] = (g == 0 ? pg8::OFF_KVS0 : (g == 1 ? pg8::OFF_KVS1 : pg8::OFF_KVS2)) + ((size_t)sr * 2 + kvsel) * 256; }
                else { const int jj = j - NKV, sr = jj / 13, cb = (jj % 13) * 256;
                    srow = sr < 2 ? (size_t)sr * SEQ + SEQ - 1 : (size_t)NTOK_P + (sr - 2) * 4 + 3; col = cb;
                    doff[u] = (sr < 2 ? pg8::OFF_SHIFT_P + (size_t)sr * 3328 : pg8::OFF_SHIFT_S + (size_t)(sr - 2) * 3328) + cb; }
                zv[u] = *(const u32x2_t*)(Z + srow * ZC + col + c);
            }
        }
        LoraGroup A, B; A.load(I, Z, g0, c); B.load(I, Z, g1, c);
        A.finish(AL, g0, c, mu); B.finish(AL, g1, c, mu);
#pragma unroll
        for (int u = 0; u < UN; ++u) if (j0 + u * NGW < NIT) *(f32x4*)(out + doff[u] + c) = (f32x4){bflo(zv[u].x), bfhi(zv[u].x), bflo(zv[u].y), bfhi(zv[u].y)};
    }
}

__device__ __forceinline__ float dpp_f(float v, const int ctrl, const int rmask) { (void)ctrl; (void)rmask; return v; }
#define DPP_ADD(v, ctrl, rmask) v += __builtin_bit_cast(float, __builtin_amdgcn_update_dpp(0, __builtin_bit_cast(int, v), ctrl, rmask, 0xf, false))
__device__ __forceinline__ float wave_sum_dpp(float v) {
    DPP_ADD(v, 0xb1, 0xf);
    DPP_ADD(v, 0x4e, 0xf);
    DPP_ADD(v, 0x114, 0xf);
    DPP_ADD(v, 0x118, 0xf);
    DPP_ADD(v, 0x142, 0xa);
    DPP_ADD(v, 0x143, 0xc);
    return __builtin_bit_cast(float, __builtin_amdgcn_readlane(__builtin_bit_cast(int, v), 63));
}

constexpr int SCAN_TB = 8;
constexpr int SC_NC = 64, SC_L = 128;
struct ScanC { float mu_r, mu_k, mu_v, kk_c, ka_c, rk_c; };

template <int NB, bool NEED_R>
__device__ __forceinline__ void scan_prep(const bf16* Z, const bf16* LW, const bf16* AA, size_t m0, int col, int lane, const ScanC& c, float& pr, float& pk, float& pv, LAS float* wl) {
    LAS float* LA = wl; LAS float* LWv = wl + SCAN_TB * 64; LAS float* LB = wl + 2 * SCAN_TB * 64; LAS float* LK = wl + 3 * SCAN_TB * 64; LAS float* LR = wl + 4 * SCAN_TB * 64; LAS float* LV = wl + 5 * SCAN_TB * 64;
    LAS float* LS = wl + 6 * SCAN_TB * 64;
    float zr_[NB], zk_[NB], zv_[NB], lw_[NB], aa_[NB];
#pragma unroll
    for (int tt = 0; tt < NB; ++tt) { const size_t m = m0 + tt;
        const bf16* zrow = Z + m * ZC; const bf16* lrow = LW + m * 1024; const bf16* arow = AA + m * 1024; const unsigned uc = (unsigned)col;
        zr_[tt] = NEED_R ? bf2f(zrow[uc]) : 0.f; zk_[tt] = bf2f(zrow[uc + 1024u]); zv_[tt] = bf2f(zrow[uc + 2048u]);
        lw_[tt] = bf2f(lrow[uc]); aa_[tt] = bf2f(arow[uc]); }
#pragma unroll
    for (int tt = 0; tt < NB; ++tt) {
        const float zr = zr_[tt], zk = zk_[tt], zv = zv_[tt], aa = aa_[tt];
        const float k = zk + (pk - zk) * c.mu_k, v = zv + (pv - zv) * c.mu_v;
        pk = zk; pv = zv;
        const float w = __expf(lw_[tt]);
        const float kkv = k * c.kk_c;
        const float nrm = sqrtf(wave_sum_dpp(kkv * kkv));
        const float kk = kkv / fmaxf(nrm, 1e-12f);
        const float kp = k * (1.0f + (aa - 1.0f) * c.ka_c);
        LA[tt * 64 + lane] = -kk; LWv[tt * 64 + lane] = w; LB[tt * 64 + lane] = kk * aa; LK[tt * 64 + lane] = kp; LV[tt * 64 + lane] = v;
        if (NEED_R) { const float r = zr + (pr - zr) * c.mu_r; pr = zr; const float rk = wave_sum_dpp(r * kp * c.rk_c); LR[tt * 64 + lane] = r; if (lane == 0) LS[tt] = rk; }
    }
}

__device__ __forceinline__ void scan_pass1(Frame& F, const In& I, unsigned char* ws, float* pq, int unit, LAS float* wl) {
    const int lane = F.lane;
    const int seq = unit / SC_NC, ch = unit % SC_NC, b = seq >> 4, h = seq & 15;
    const int col = h * 64 + lane;
    const size_t row0 = (size_t)b * SEQ + (size_t)ch * SC_L;
    const bf16* Z = (const bf16*)(ws + WS_Z); const bf16* LW = (const bf16*)(ws + WS_LW); const bf16* AA = (const bf16*)(ws + WS_AA);
    ScanC c; c.mu_r = 0.f; c.mu_k = I.shift_mu[1024 + col]; c.mu_v = I.shift_mu[2048 + col]; c.kk_c = I.k_k[col]; c.ka_c = I.k_a[col]; c.rk_c = 0.f;
    float pr = 0.f, pk = 0.f, pv = 0.f;
    if (ch > 0) { pk = bf2f(Z[(row0 - 1) * ZC + 1024 + col]); pv = bf2f(Z[(row0 - 1) * ZC + 2048 + col]); }
    f32x2_t sP[32], sQ[32];
    { int ln = lane; asm volatile("" : "+v"(ln));
#pragma unroll
    for (int j = 0; j < 32; ++j) { sP[j] = (f32x2_t){(2 * j == ln) ? 1.f : 0.f, (2 * j + 1 == ln) ? 1.f : 0.f}; sQ[j] = (f32x2_t){0.f, 0.f}; } }
    LAS float* LA = wl; LAS float* LWv = wl + SCAN_TB * 64; LAS float* LB = wl + 2 * SCAN_TB * 64; LAS float* LK = wl + 3 * SCAN_TB * 64; LAS float* LV = wl + 5 * SCAN_TB * 64;
    for (int t0 = 0; t0 < SC_L; t0 += SCAN_TB) {
        scan_prep<SCAN_TB, false>(Z, LW, AA, row0 + t0, col, lane, c, pr, pk, pv, wl);
        LDS_WAIT(); asm volatile("" ::: "memory");
#pragma unroll 1
        for (int tt = 0; tt < SCAN_TB; ++tt) {
            const float vv = LV[tt * 64 + lane];
            const LAS f32x4* a4 = (const LAS f32x4*)(LA + tt * 64); const LAS f32x4* w4 = (const LAS f32x4*)(LWv + tt * 64); const LAS f32x4* b4 = (const LAS f32x4*)(LB + tt * 64);
            const LAS f32x4* k4 = (const LAS f32x4*)(LK + tt * 64);
            f32x2_t p0 = {0.f, 0.f}, p1 = {0.f, 0.f}, q0 = {0.f, 0.f}, q1 = {0.f, 0.f};
            f32x4 av[4], an[4];
#pragma unroll
            for (int i = 0; i < 4; ++i) av[i] = a4[i];
#pragma unroll
            for (int g = 0; g < 4; ++g) {
                if (g < 3) {
#pragma unroll
                    for (int i = 0; i < 4; ++i) an[i] = a4[4 * (g + 1) + i]; }
                __builtin_amdgcn_sched_barrier(0);
#pragma unroll
                for (int i = 0; i < 4; ++i) { const int j = 4 * g + i; const f32x2_t lo = __builtin_shufflevector(av[i], av[i], 0, 1), hi = __builtin_shufflevector(av[i], av[i], 2, 3);
                    p0 += sP[2 * j] * lo; p1 += sP[2 * j + 1] * hi; q0 += sQ[2 * j] * lo; q1 += sQ[2 * j + 1] * hi; }
#pragma unroll
                for (int i = 0; i < 4; ++i) av[i] = an[i];
            }
            const float saP = (p0.x + p0.y) + (p1.x + p1.y), saQ = (q0.x + q0.y) + (q1.x + q1.y);
            const f32x2_t saP2 = {saP, saP}, saQ2 = {saQ, saQ}, vv2 = {vv, vv};
            f32x4 wv[2], bv[2], kv[2], wn[2], bn[2], kn[2];
#pragma unroll
            for (int i = 0; i < 2; ++i) { wv[i] = w4[i]; bv[i] = b4[i]; kv[i] = k4[i]; }
#pragma unroll
            for (int g = 0; g < 8; ++g) {
                if (g < 7) {
#pragma unroll
                    for (int i = 0; i < 2; ++i) { wn[i] = w4[2 * (g + 1) + i]; bn[i] = b4[2 * (g + 1) + i]; kn[i] = k4[2 * (g + 1) + i]; } }
                __builtin_amdgcn_sched_barrier(0);
#pragma unroll
                for (int i = 0; i < 2; ++i) { const int j = 2 * g + i;
                    const f32x2_t wlo = __builtin_shufflevector(wv[i], wv[i], 0, 1), whi = __builtin_shufflevector(wv[i], wv[i], 2, 3);
                    const f32x2_t blo = __builtin_shufflevector(bv[i], bv[i], 0, 1), bhi = __builtin_shufflevector(bv[i], bv[i], 2, 3);
                    const f32x2_t klo = __builtin_shufflevector(kv[i], kv[i], 0, 1), khi = __builtin_shufflevector(kv[i], kv[i], 2, 3);
                    sP[2 * j] = sP[2 * j] * wlo + saP2 * blo; sP[2 * j + 1] = sP[2 * j + 1] * whi + saP2 * bhi;
                    sQ[2 * j] = sQ[2 * j] * wlo + (saQ2 * blo + vv2 * klo); sQ[2 * j + 1] = sQ[2 * j + 1] * whi + (saQ2 * bhi + vv2 * khi); }
#pragma unroll
                for (int i = 0; i < 2; ++i) { wv[i] = wn[i]; bv[i] = bn[i]; kv[i] = kn[i]; }
            }
        }
        LDS_WAIT(); asm volatile("" ::: "memory");
    }
    float* dP = pq + (size_t)unit * 8192 + (size_t)lane * 64; float* dQ = dP + 4096;
#pragma unroll
    for (int j = 0; j < 16; ++j) { *(f32x4*)(dP + 4 * j) = (f32x4){sP[2 * j].x, sP[2 * j].y, sP[2 * j + 1].x, sP[2 * j + 1].y}; *(f32x4*)(dQ + 4 * j) = (f32x4){sQ[2 * j].x, sQ[2 * j].y, sQ[2 * j + 1].x, sQ[2 * j + 1].y}; }
}

template <bool STORE> __device__ __forceinline__ void scan_chain(Frame& F, float* pq, float* out, int seq, int ct) {
    const int lane = F.lane, a = lane & 15, q = lane >> 4;
    float* base = pq + (size_t)seq * SC_NC * 8192;
    const size_t qoff = (size_t)(16 * ct + a) * 64 + 4 * q, poff = (size_t)(4 * q) * 64 + a;
    f32x4 st[4], qn[4]; float pn[64];
#pragma unroll
    for (int rt2 = 0; rt2 < 4; ++rt2) st[rt2] = *(const f32x4*)(base + 4096 + qoff + 16 * rt2);
#pragma unroll
    for (int rt2 = 0; rt2 < 4; ++rt2) qn[rt2] = *(const f32x4*)(base + 8192 + 4096 + qoff + 16 * rt2);
#pragma unroll
    for (int rt = 0; rt < 4; ++rt)
#pragma unroll
        for (int rg = 0; rg < 4; ++rg)
#pragma unroll
            for (int rt2 = 0; rt2 < 4; ++rt2) pn[(rt * 4 + rg) * 4 + rt2] = base[8192 + poff + (size_t)(16 * rt + rg) * 64 + 16 * rt2];
    for (int c = 1; c < SC_NC; ++c) {
        float* P = base + (size_t)c * 8192; float* Q = P + 4096;
        f32x4 acc[4]; float pc[64];
#pragma unroll
        for (int rt2 = 0; rt2 < 4; ++rt2) acc[rt2] = qn[rt2];
#pragma unroll
        for (int i = 0; i < 64; ++i) pc[i] = pn[i];
        if (c + 1 < SC_NC) {
#pragma unroll
            for (int rt2 = 0; rt2 < 4; ++rt2) qn[rt2] = *(const f32x4*)(Q + 8192 + qoff + 16 * rt2);
#pragma unroll
            for (int rt = 0; rt < 4; ++rt)
#pragma unroll
                for (int rg = 0; rg < 4; ++rg)
#pragma unroll
                    for (int rt2 = 0; rt2 < 4; ++rt2) pn[(rt * 4 + rg) * 4 + rt2] = P[8192 + poff + (size_t)(16 * rt + rg) * 64 + 16 * rt2];
        }
#pragma unroll
        for (int rt2 = 0; rt2 < 4; ++rt2) if (STORE) *(f32x4*)(Q - 8192 + qoff + 16 * rt2) = st[rt2];
#pragma unroll
        for (int rt = 0; rt < 4; ++rt)
#pragma unroll
            for (int rg = 0; rg < 4; ++rg)
#pragma unroll
                for (int rt2 = 0; rt2 < 4; ++rt2) acc[rt2] = __builtin_amdgcn_mfma_f32_16x16x4f32(pc[(rt * 4 + rg) * 4 + rt2], st[rt][rg], acc[rt2], 0, 0, 0);
#pragma unroll
        for (int rt2 = 0; rt2 < 4; ++rt2) st[rt2] = acc[rt2];
    }
    float* dst = out + OFF_WKV_P + (size_t)seq * 4096;
#pragma unroll
    for (int rt2 = 0; rt2 < 4; ++rt2) { if (STORE) *(f32x4*)(dst + qoff + 16 * rt2) = st[rt2]; else asm volatile("" :: "v"(st[rt2])); }
}

template <int NB>
__device__ __forceinline__ void scan_out(Frame& F, const In& I, unsigned char* ws, size_t row0, int T, int h, const float* init, float* fin, float pr, float pk, float pv, LAS float* wl) {
    const int lane = F.lane;
    const int col = h * 64 + lane;
    const bf16* Z = (const bf16*)(ws + WS_Z); const bf16* LW = (const bf16*)(ws + WS_LW); const bf16* AA = (const bf16*)(ws + WS_AA); const bf16* GG = (const bf16*)(ws + WS_GG);
    bf16* RO = (bf16*)(ws + WS_RO);
    ScanC c; c.mu_r = I.shift_mu[col]; c.mu_k = I.shift_mu[1024 + col]; c.mu_v = I.shift_mu[2048 + col]; c.kk_c = I.k_k[col]; c.ka_c = I.k_a[col]; c.rk_c = I.r_k[col];
    const float lnw_c = I.lnx_w[col], lnb_c = I.lnx_b[col];
    f32x2_t s[32];
    if (init) { const f32x4* sp = (const f32x4*)(init + (size_t)lane * 64);
#pragma unroll
        for (int j = 0; j < 16; ++j) { const f32x4 v = sp[j]; s[2 * j] = (f32x2_t){v.x, v.y}; s[2 * j + 1] = (f32x2_t){v.z, v.w}; } }
    else {
#pragma unroll
        for (int j = 0; j < 32; ++j) s[j] = (f32x2_t){0.f, 0.f}; }
    LAS float* LA = wl; LAS float* LWv = wl + SCAN_TB * 64; LAS float* LB = wl + 2 * SCAN_TB * 64; LAS float* LK = wl + 3 * SCAN_TB * 64; LAS float* LR = wl + 4 * SCAN_TB * 64; LAS float* LV = wl + 5 * SCAN_TB * 64;
    LAS float* LS = wl + 6 * SCAN_TB * 64;
    for (int t0 = 0; t0 < T; t0 += NB) {
        scan_prep<NB, true>(Z, LW, AA, row0 + t0, col, lane, c, pr, pk, pv, wl);
        LDS_WAIT(); asm volatile("" ::: "memory");
#pragma unroll 1
        for (int tt = 0; tt < NB; ++tt) {
            const size_t m = row0 + t0 + tt;
            const float vv = LV[tt * 64 + lane];
            const float gg = bf2f(GG[m * 1024 + col]);
            const LAS f32x4* a4 = (const LAS f32x4*)(LA + tt * 64); const LAS f32x4* w4 = (const LAS f32x4*)(LWv + tt * 64); const LAS f32x4* b4 = (const LAS f32x4*)(LB + tt * 64);
            const LAS f32x4* k4 = (const LAS f32x4*)(LK + tt * 64); const LAS f32x4* r4 = (const LAS f32x4*)(LR + tt * 64);
            f32x2_t p0 = {0.f, 0.f}, p1 = {0.f, 0.f};
            f32x4 av[4], an[4];
#pragma unroll
            for (int i = 0; i < 4; ++i) av[i] = a4[i];
#pragma unroll
            for (int g = 0; g < 4; ++g) {
                if (g < 3) {
#pragma unroll
                    for (int i = 0; i < 4; ++i) an[i] = a4[4 * (g + 1) + i]; }
                __builtin_amdgcn_sched_barrier(0);
#pragma unroll
                for (int i = 0; i < 4; ++i) { const int j = 4 * g + i; const f32x2_t lo = __builtin_shufflevector(av[i], av[i], 0, 1), hi = __builtin_shufflevector(av[i], av[i], 2, 3);
                    p0 += s[2 * j] * lo; p1 += s[2 * j + 1] * hi; }
#pragma unroll
                for (int i = 0; i < 4; ++i) av[i] = an[i];
            }
            const float sa = (p0.x + p0.y) + (p1.x + p1.y);
            const f32x2_t sa2 = {sa, sa}, vv2 = {vv, vv};
            f32x2_t y0 = {0.f, 0.f}, y1 = {0.f, 0.f};
            f32x4 wv[2], bv[2], kv[2], rv[2], wn[2], bn[2], kn[2], rn[2];
#pragma unroll
            for (int i = 0; i < 2; ++i) { wv[i] = w4[i]; bv[i] = b4[i]; kv[i] = k4[i]; rv[i] = r4[i]; }
#pragma unroll
            for (int g = 0; g < 8; ++g) {
                if (g < 7) {
#pragma unroll
                    for (int i = 0; i < 2; ++i) { wn[i] = w4[2 * (g + 1) + i]; bn[i] = b4[2 * (g + 1) + i]; kn[i] = k4[2 * (g + 1) + i]; rn[i] = r4[2 * (g + 1) + i]; } }
                __builtin_amdgcn_sched_barrier(0);
#pragma unroll
                for (int i = 0; i < 2; ++i) { const int j = 2 * g + i;
                    const f32x2_t wlo = __builtin_shufflevector(wv[i], wv[i], 0, 1), whi = __builtin_shufflevector(wv[i], wv[i], 2, 3);
                    const f32x2_t blo = __builtin_shufflevector(bv[i], bv[i], 0, 1), bhi = __builtin_shufflevector(bv[i], bv[i], 2, 3);
                    const f32x2_t klo = __builtin_shufflevector(kv[i], kv[i], 0, 1), khi = __builtin_shufflevector(kv[i], kv[i], 2, 3);
                    const f32x2_t rlo = __builtin_shufflevector(rv[i], rv[i], 0, 1), rhi = __builtin_shufflevector(rv[i], rv[i], 2, 3);
                    s[2 * j] = s[2 * j] * wlo + (sa2 * blo + vv2 * klo); s[2 * j + 1] = s[2 * j + 1] * whi + (sa2 * bhi + vv2 * khi);
                    y0 += s[2 * j] * rlo; y1 += s[2 * j + 1] * rhi; }
#pragma unroll
                for (int i = 0; i < 2; ++i) { wv[i] = wn[i]; bv[i] = bn[i]; kv[i] = kn[i]; rv[i] = rn[i]; }
            }
            const float y = (y0.x + y0.y) + (y1.x + y1.y);
            const float mean = wave_sum_dpp(y) * (1.0f / 64.0f), d = y - mean;
            const float var = wave_sum_dpp(d * d) * (1.0f / 64.0f);
            const float yn = d * (1.0f / sqrtf(var + 64e-5f)) * lnw_c + lnb_c;
            const float o = (yn + LS[tt] * vv) * gg;
            RO[m * 1024 + col] = (bf16)pk2(o, o);
        }
        LDS_WAIT(); asm volatile("" ::: "memory");
    }
    if (fin) { float* dst = fin + (size_t)lane * 64;
#pragma unroll
        for (int j = 0; j < 16; ++j) *(f32x4*)(dst + 4 * j) = (f32x4){s[2 * j].x, s[2 * j].y, s[2 * j + 1].x, s[2 * j + 1].y}; }
}

__device__ __forceinline__ void attn_sample_item(Frame& F, const In& I, unsigned char* ws, int item, LAS float* wl) {
    const int lane = F.lane;
    const int h = item & 3, g = (item >> 2) % 3, nt = item / 12, n = nt >> 2, t = nt & 3;
    const int d = g == 0 ? 1 : (g == 1 ? 4 : 16), L = g == 0 ? 128 : (g == 1 ? 512 : 2048);
    const float* cache = g == 0 ? I.cache0 : (g == 1 ? I.cache1 : I.cache2);
    const bf16* Z = (const bf16*)(ws + WS_Z);
    const size_t mq = (size_t)(NTOK_P + nt);
    const int hc = g * 256 + h * 64;
    wl[lane] = bf2f(Z[mq * ZC + ZQ + hc + lane]) * 0.125f;
    LDS_WAIT(); asm volatile("" ::: "memory");
    float sc[3];
#pragma unroll
    for (int jj = 0; jj < 3; ++jj) {
        const int j = lane + 64 * jj;
        float s = -1e30f;
        if (j <= 128) {
            const int idx = L + t - d * j;
            float acc = 0.f;
            if (idx >= L) { const bf16* kr = Z + (size_t)(NTOK_P + n * 4 + idx - L) * ZC + ZK + hc;
#pragma unroll
                for (int e8 = 0; e8 < 8; ++e8) { const v4u kv = *(const v4u*)(kr + 8 * e8); const LAS f32x4* qq = (const LAS f32x4*)(wl + 8 * e8); const f32x4 q0 = qq[0], q1 = qq[1];
                    acc += bflo(kv.x) * q0.x + bfhi(kv.x) * q0.y + bflo(kv.y) * q0.z + bfhi(kv.y) * q0.w + bflo(kv.z) * q1.x + bfhi(kv.z) * q1.y + bflo(kv.w) * q1.z + bfhi(kv.w) * q1.w; } }
            else { const float* kr = cache + (((size_t)n * L + idx) * 2 + 0) * 256 + h * 64;
#pragma unroll
                for (int e4 = 0; e4 < 16; ++e4) { const f32x4 kv = *(const f32x4*)(kr + 4 * e4); const f32x4 q0 = ((const LAS f32x4*)wl)[e4];
                    acc += kv.x * q0.x + kv.y * q0.y + kv.z * q0.z + kv.w * q0.w; } }
            s = acc;
        }
        sc[jj] = s;
    }
    const float mx = wave_max(fmaxf(fmaxf(sc[0], sc[1]), sc[2]));
    float den = 0.f;
#pragma unroll
    for (int jj = 0; jj < 3; ++jj) { const int j = lane + 64 * jj; const float p = (j <= 128) ? __expf(sc[jj] - mx) : 0.f; den += p; if (j <= 128) wl[64 + j] = p; }
    den = wave_sum(den);
    LDS_WAIT(); asm volatile("" ::: "memory");
    float o = 0.f;
    {
#pragma unroll
        for (int j = 0; j < 4; ++j) { const int idx = L + t - d * j; float v;
            if (idx >= L) v = bf2f(Z[(size_t)(NTOK_P + n * 4 + idx - L) * ZC + ZV + hc + lane]); else v = cache[(((size_t)n * L + idx) * 2 + 1) * 256 + h * 64 + lane];
            o += wl[64 + j] * v; }
        const float* cv = cache + ((size_t)n * L * 2 + 1) * 256 + h * 64 + lane;
        for (int j0 = 4; j0 < 124; j0 += 8) {
            float v[8];
#pragma unroll
            for (int u = 0; u < 8; ++u) v[u] = cv[(size_t)(L + t - d * (j0 + u)) * 512];
#pragma unroll
            for (int u = 0; u < 8; ++u) o += wl[64 + j0 + u] * v[u];
        }
#pragma unroll
        for (int j = 124; j <= 128; ++j) o += wl[64 + j] * cv[(size_t)(L + t - d * j) * 512];
    }
    bf16* OB = (bf16*)(ws + WS_OBUF); float* LSE = (float*)(ws + WS_LSE);
    OB[mq * 768 + hc + lane] = (bf16)pk2(o / den, o / den);
    if (lane == 0) LSE[mq * 12 + g * 4 + h] = mx + __logf(den);
    LDS_WAIT(); asm volatile("" ::: "memory");
}

constexpr int AQ_PITCH = 144, AK_PITCH = 144, AV_PITCH = 528;
constexpr int A_QS = 0, A_KS = 128 * AQ_PITCH, A_VT = A_KS + 256 * AK_PITCH, A_END = A_VT + 64 * AV_PITCH;
static_assert(A_END <= RING_BYTES, "attention LDS");
typedef short s16x4 __attribute__((ext_vector_type(4)));
__device__ __forceinline__ void attn_prompt_unit(Frame& F, unsigned char* ws, int unit) {
    const int tid = F.tid, lane = F.lane, w = F.wave;
    const int sub = unit & 63, bgh = unit >> 6, h = bgh & 3, g = (bgh >> 2) % 3, b = bgh / 12;
    const int dsh = 2 * g, d = 1 << dsh, nblk = 64 >> dsh;
    const int r = sub / nblk, blk = sub % nblk;
    const bf16* Z = (const bf16*)(ws + WS_Z);
    const int hc = g * 256 + h * 64;
    LAS unsigned char* lds = F.lds + RING_OFF;
    const size_t rowb = (size_t)b * SEQ;
    for (int ch = tid; ch < 128 * 8; ch += 512) { const int i = ch >> 3, c8 = ch & 7; const int pos = r + d * (128 * blk + i);
        const v4u v = *(const v4u*)(Z + (rowb + pos) * ZC + ZQ + hc + 8 * c8); *(LAS v4u*)(lds + A_QS + i * AQ_PITCH + 16 * c8) = v; }
    for (int ch = tid; ch < 256 * 8; ch += 512) { const int j = ch >> 3, c8 = ch & 7; const int pos = r + d * (128 * (blk - 1) + j);
        v4u kv = (v4u){0u, 0u, 0u, 0u}, vv = (v4u){0u, 0u, 0u, 0u};
        if (pos >= 0) { kv = *(const v4u*)(Z + (rowb + pos) * ZC + ZK + hc + 8 * c8); vv = *(const v4u*)(Z + (rowb + pos) * ZC + ZV + hc + 8 * c8); }
        *(LAS v4u*)(lds + A_KS + j * AK_PITCH + 16 * c8) = kv;
        LAS unsigned short* vt = (LAS unsigned short*)(lds + A_VT) + j;
        const int e0 = 8 * c8;
        vt[(e0 + 0) * (AV_PITCH / 2)] = (unsigned short)(vv.x & 0xffffu); vt[(e0 + 1) * (AV_PITCH / 2)] = (unsigned short)(vv.x >> 16);
        vt[(e0 + 2) * (AV_PITCH / 2)] = (unsigned short)(vv.y & 0xffffu); vt[(e0 + 3) * (AV_PITCH / 2)] = (unsigned short)(vv.y >> 16);
        vt[(e0 + 4) * (AV_PITCH / 2)] = (unsigned short)(vv.z & 0xffffu); vt[(e0 + 5) * (AV_PITCH / 2)] = (unsigned short)(vv.z >> 16);
        vt[(e0 + 6) * (AV_PITCH / 2)] = (unsigned short)(vv.w & 0xffffu); vt[(e0 + 7) * (AV_PITCH / 2)] = (unsigned short)(vv.w >> 16); }
    __syncthreads();
    const int l15 = lane & 15, lq = lane >> 4;
    bf16x8 qf[2];
#pragma unroll
    for (int es = 0; es < 2; ++es) qf[es] = *(const LAS bf16x8*)(lds + A_QS + (16 * w + l15) * AQ_PITCH + es * 64 + 16 * lq);
    f32x4 sacc[9];
#pragma unroll
    for (int kt = 0; kt < 9; ++kt) {
        f32x4 a = (f32x4){0.f, 0.f, 0.f, 0.f};
#pragma unroll
        for (int es = 0; es < 2; ++es) { const bf16x8 kf = *(const LAS bf16x8*)(lds + A_KS + (16 * (w + kt) + l15) * AK_PITCH + es * 64 + 16 * lq);
            a = __builtin_amdgcn_mfma_f32_16x16x32_bf16(kf, qf[es], a, 0, 0, 0); }
        sacc[kt] = a;
    }
    const int qi = 16 * w + l15;
    float mx = -1e30f;
#pragma unroll
    for (int kt = 0; kt < 9; ++kt)
#pragma unroll
        for (int rg = 0; rg < 4; ++rg) { const int kj = 16 * (w + kt) + 4 * lq + rg; const int dist = qi + 128 - kj;
            const bool ok = (dist >= 0) && (dist <= 128) && (blk > 0 || kj >= 128);
            const float sv = ok ? sacc[kt][rg] * 0.125f : -1e30f; sacc[kt][rg] = sv; mx = fmaxf(mx, sv); }
    mx = fmaxf(mx, __shfl_xor(mx, 16)); mx = fmaxf(mx, __shfl_xor(mx, 32));
    float den = 0.f;
#pragma unroll
    for (int kt = 0; kt < 9; ++kt)
#pragma unroll
        for (int rg = 0; rg < 4; ++rg) { const float p = __expf(sacc[kt][rg] - mx); sacc[kt][rg] = p; den += p; }
    den += __shfl_xor(den, 16); den += __shfl_xor(den, 32);
    f32x4 oacc[4];
#pragma unroll
    for (int et = 0; et < 4; ++et) oacc[et] = (f32x4){0.f, 0.f, 0.f, 0.f};
#pragma unroll
    for (int ks = 0; ks < 5; ++ks) {
        const int k0 = 2 * ks, k1 = 2 * ks + 1;
        u32x4_t pw;
        pw.x = pk2(sacc[k0][0], sacc[k0][1]); pw.y = pk2(sacc[k0][2], sacc[k0][3]);
        if (k1 < 9) { pw.z = pk2(sacc[k1 < 9 ? k1 : 8][0], sacc[k1 < 9 ? k1 : 8][1]); pw.w = pk2(sacc[k1 < 9 ? k1 : 8][2], sacc[k1 < 9 ? k1 : 8][3]); } else { pw.z = 0u; pw.w = 0u; }
        const bf16x8 pf = __builtin_bit_cast(bf16x8, pw);
#pragma unroll
        for (int et = 0; et < 4; ++et) {
            const LAS unsigned char* vrow = lds + A_VT + (16 * et + l15) * AV_PITCH;
            const s16x4 lo = *(const LAS s16x4*)(vrow + (16 * (w + k0) + 4 * lq) * 2);
            s16x4 hi = (s16x4){0, 0, 0, 0};
            if (k1 < 9) hi = *(const LAS s16x4*)(vrow + (16 * (w + (k1 < 9 ? k1 : 8)) + 4 * lq) * 2);
            const bf16x8 vf = (bf16x8){lo[0], lo[1], lo[2], lo[3], hi[0], hi[1], hi[2], hi[3]};
            oacc[et] = __builtin_amdgcn_mfma_f32_16x16x32_bf16(vf, pf, oacc[et], 0, 0, 0);
        }
    }
    const float rden = 1.0f / den;
    const size_t mq = rowb + (size_t)(r + d * (128 * blk + qi));
    bf16* OB = (bf16*)(ws + WS_OBUF); float* LSE = (float*)(ws + WS_LSE);
#pragma unroll
    for (int et = 0; et < 4; ++et) { const f32x4 o = oacc[et] * rden;
        *(GAS unsigned long long*)(OB + mq * 768 + hc + 16 * et + 4 * lq) = (unsigned long long)pk2(o[0], o[1]) | ((unsigned long long)pk2(o[2], o[3]) << 32); }
    if (lq == 0) LSE[mq * 12 + g * 4 + h] = mx + __logf(den);
    __syncthreads();
}

__device__ __forceinline__ void p2d_attn_merge(Frame& F, unsigned char* ws) {
    const int gw = F.vcu * NWAVES + F.wave, NGW = F.G * NWAVES, lane = F.lane;
    const bf16* OB = (const bf16*)(ws + WS_OBUF); const float* LSE = (const float*)(ws + WS_LSE); bf16* AT = (bf16*)(ws + WS_ATTN);
    const int c = 4 * lane, h = lane >> 4;
    const bool cls_map = NGW * 8 == NTOK_P; const int cls_w = NGW / 8 > 0 ? NGW / 8 : 1, cls = gw / cls_w, wl_ = gw - cls * cls_w;
    const int npass = cls_map ? 3 : (MPAD + 4 * NGW - 1) / (4 * NGW);
    for (int pass = 0; pass < npass; ++pass) {
        int mrow[4];
#pragma unroll
        for (int u = 0; u < 4; ++u) { mrow[u] = MPAD;
            if (!cls_map) mrow[u] = gw + (4 * pass + u) * NGW;
            else if (pass < 2) mrow[u] = gw * 8 + 4 * pass + u;
            else if (u == 0 && wl_ < 16) mrow[u] = NTOK_P + 16 * cls + wl_;
            else if (u == 0 && wl_ < 32) mrow[u] = NTOK + 16 * cls + wl_ - 16; }
        float l[4][3]; u32x2_t ob[4][3];
#pragma unroll
        for (int u = 0; u < 4; ++u) { const int m = mrow[u];
#pragma unroll
            for (int g = 0; g < 3; ++g) { l[u][g] = 0.f; ob[u][g] = (u32x2_t){0u, 0u}; }
            if (m < NTOK) {
#pragma unroll
                for (int g = 0; g < 3; ++g) { l[u][g] = LSE[(size_t)m * 12 + 4 * g + h]; ob[u][g] = *(const u32x2_t*)(OB + (size_t)m * 768 + 256 * g + c); } } }
#pragma unroll
        for (int u = 0; u < 4; ++u) { const int m = mrow[u];
            if (m < MPAD) {
                unsigned long long o = 0ull;
                if (m < NTOK) {
                    const float l0 = l[u][0], l1 = l[u][1], l2 = l[u][2];
                    const u32x2_t o0 = ob[u][0], o1 = ob[u][1], o2 = ob[u][2];
                    const float mx = fmaxf(fmaxf(l0, l1), l2);
                    float a0 = __expf(l0 - mx), a1 = __expf(l1 - mx), a2 = __expf(l2 - mx);
                    const float rs = 1.0f / (a0 + a1 + a2); a0 *= rs; a1 *= rs; a2 *= rs;
                    const float v0 = a0 * bflo(o0.x) + a1 * bflo(o1.x) + a2 * bflo(o2.x), v1 = a0 * bfhi(o0.x) + a1 * bfhi(o1.x) + a2 * bfhi(o2.x);
                    const float v2 = a0 * bflo(o0.y) + a1 * bflo(o1.y) + a2 * bflo(o2.y), v3 = a0 * bfhi(o0.y) + a1 * bfhi(o1.y) + a2 * bfhi(o2.y);
                    o = (unsigned long long)pk2(v0, v1) | ((unsigned long long)pk2(v2, v3) << 32);
                }
                *(GAS unsigned long long*)(AT + (size_t)m * 256 + c) = o;
            } }
    }
}

__device__ __forceinline__ void p8_final(Frame& F, const In& I, unsigned char* ws, float* out, bool sample_only = false) {
    const int gw = F.vcu * NWAVES + F.wave, NGW = F.G * NWAVES, lane = F.lane;
    const bf16* X3 = (const bf16*)(ws + WS_X1); const float* ss3 = (const float*)(ws + WS_STAT) + 3 * (size_t)MPAD;
    f32x4 nf[4];
#pragma unroll
    for (int j = 0; j < 4; ++j) nf[j] = ((const f32x4*)I.norm_final)[lane + 64 * j];
    const bool cls_map = NGW * 8 == NTOK_P;
    const int cls_w = NGW / 8 > 0 ? NGW / 8 : 1, cls = gw / cls_w, wl_ = gw - cls * cls_w;
    const int npass = cls_map ? 3 : (NTOK + 4 * NGW - 1) / (4 * NGW);
    for (int pass = (sample_only && cls_map) ? 2 : 0; pass < npass; ++pass) {
        int mrow[4];
#pragma unroll
        for (int u = 0; u < 4; ++u) { mrow[u] = -1;
            if (!cls_map) { const int m = gw + (4 * pass + u) * NGW; mrow[u] = m < NTOK ? m : -1; }
            else if (pass < 2) mrow[u] = gw * 8 + 4 * pass + u;
            else if (u == 0 && wl_ < 16) mrow[u] = NTOK_P + 16 * cls + wl_; }
        u32x2_t v[4][4]; float q[4];
#pragma unroll
        for (int u = 0; u < 4; ++u) { const int m = mrow[u]; q[u] = 1.f;
#pragma unroll
            for (int j = 0; j < 4; ++j) v[u][j] = (u32x2_t){0u, 0u};
            if (m >= 0) { q[u] = ss3[m]; const u32x2_t* xr = (const u32x2_t*)(X3 + (size_t)m * DM) + lane;
#pragma unroll
                for (int j = 0; j < 4; ++j) v[u][j] = xr[64 * j]; } }
#pragma unroll
        for (int u = 0; u < 4; ++u) { const int m = mrow[u];
            if (m >= 0) {
                const float rs = 1.0f / sqrtf(q[u] * (1.0f / DM) + 1e-6f);
                f32x4* orow = (f32x4*)(out + (m < NTOK_P ? OFF_Y_P + (size_t)m * DM : OFF_Y_S + (size_t)(m - NTOK_P) * DM)) + lane;
#pragma unroll
                for (int j = 0; j < 4; ++j) orow[64 * j] = (f32x4){bflo(v[u][j].x), bfhi(v[u][j].x), bflo(v[u][j].y), bfhi(v[u][j].y)} * rs * nf[j];
            } }
    }
}
constexpr int PA_P = 144;
constexpr int PA_AT = 0, PA_RT = 9216, PA_BT = 18432, PA_KT = 27648;
constexpr int PA_AC = 36864, PA_BGC = 46080, PA_KGC = 55296, PA_VC = 64512;
constexpr int PA_NT = 73728;
constexpr int PA_N01 = 82944;
constexpr int PA_MKA = 85504, PA_NR = 94720, PA_MKR = 103936;
constexpr int PA_TR = 113152;
constexpr int PA_XU = 118272;
constexpr int PA_ND2 = 127488;
constexpr int PA_TT = PA_AT, PA_W1 = PA_BT, PA_U0 = PA_KT;
static_assert(PA_ND2 + 2560 <= RING_BYTES && PA_XU + 9216 <= PA_ND2, "pass A LDS");
constexpr int CH = 64;
constexpr int NUNIT = 32 * (SEQ / CH);
typedef __attribute__((address_space(3))) unsigned char* ldsp_t;
__device__ __forceinline__ bf16x8 lfrag(ldsp_t base, int row, int kbyte) { return *(const LAS bf16x8*)(base + row * PA_P + kbyte); }
typedef short s16x4_t __attribute__((ext_vector_type(4)));
__device__ __forceinline__ bf16x8 cat4(s16x4_t lo, s16x4_t hi) { return (bf16x8){lo[0], lo[1], lo[2], lo[3], hi[0], hi[1], hi[2], hi[3]}; }
__device__ __forceinline__ unsigned short f2bf16(float f) { return (unsigned short)pk2(f, f); }
__device__ __forceinline__ float dppsum16(float v) {
    DPP_ADD(v, 0xb1, 0xf); DPP_ADD(v, 0x4e, 0xf); DPP_ADD(v, 0x141, 0xf); DPP_ADD(v, 0x140, 0xf); return v; }

struct PaBufs { bf16* Pg; bf16* Qg; bf16* Gg; bf16* Yb; float* gam; float* rk; };

struct PaRaw { unsigned short zr[8], zk[8], zv[8], lw[8], aa[8]; unsigned short pr, pk, pv; float mu_r, mu_k, mu_v, kk_c, ka_c, rk_c; };
__device__ __forceinline__ void pa_load(PaRaw& R, const In& I, const bf16* Z, const bf16* LW, const bf16* AA, int unit, int w, int c) {
    const int seq = unit >> 7, ch = unit & 127, b = seq >> 4, h = seq & 15;
    const size_t m0 = (size_t)b * SEQ + (size_t)ch * CH + 8 * w; const unsigned uc = (unsigned)(h * 64 + c);
#pragma unroll
    for (int tt = 0; tt < 8; ++tt) { const bf16* zrow = Z + (m0 + tt) * ZC;
        R.zr[tt] = zrow[uc]; R.zk[tt] = zrow[uc + 1024u]; R.zv[tt] = zrow[uc + 2048u]; R.lw[tt] = LW[(m0 + tt) * 1024 + uc]; R.aa[tt] = AA[(m0 + tt) * 1024 + uc]; }
    if (ch == 0 && w == 0) { R.pr = 0; R.pk = 0; R.pv = 0; }
    else { const bf16* zrow = Z + (m0 - 1) * ZC; R.pr = zrow[uc]; R.pk = zrow[uc + 1024u]; R.pv = zrow[uc + 2048u]; }
    R.mu_r = I.shift_mu[uc]; R.mu_k = I.shift_mu[1024u + uc]; R.mu_v = I.shift_mu[2048u + uc]; R.kk_c = I.k_k[uc]; R.ka_c = I.k_a[uc]; R.rk_c = I.r_k[uc];
}

__device__ __forceinline__ void passA_unit(Frame& F, const In& I, const PaBufs& B, int unit, PaRaw& R, int next_unit, const bf16* Zc, const bf16* LWc, const bf16* AAc) {
    int lane = F.lane; asm volatile("" : "+v"(lane));
    const int w = F.wave; int r = lane & 15, q = lane >> 4;
    const int seq = unit >> 7, ch = unit & 127, bb_ = seq >> 4, h = seq & 15;
    const size_t row0 = (size_t)bb_ * SEQ + (size_t)ch * CH;
    ldsp_t L = F.lds + RING_OFF;
#ifdef PROBE_PA_REP
#define REP_BEGIN(n) _Pragma("unroll 1") for (int rep_ = 0; rep_ < ((n) == PROBE_PA_REP ? 2 : 1); ++rep_) {
#define REP_END() }
#else
#define REP_BEGIN(n) {
#define REP_END() }
#endif
#define PA_RELAUNDER() do { asm volatile("" : "+v"(lane)); r = lane & 15; q = lane >> 4; } while (0)
    REP_BEGIN(1)
    {
        const int c = lane, col = h * 64 + c;
        const float mu_r = R.mu_r, mu_k = R.mu_k, mu_v = R.mu_v, kk_c = R.kk_c, ka_c = R.ka_c, rk_c = R.rk_c;
        float rr[8], kkn[8], kp[8], bb[8], vv[8], lw[8], ll[8], s1[8], s2[8], kkv[8];
        float pr = bf2f(R.pr), pk = bf2f(R.pk), pv = bf2f(R.pv), run = 0.f;
#pragma unroll
        for (int tt = 0; tt < 8; ++tt) {
            const float zr = bf2f(R.zr[tt]), zk = bf2f(R.zk[tt]), zv = bf2f(R.zv[tt]), aa = bf2f(R.aa[tt]);
            const float rv = zr + (pr - zr) * mu_r, kv = zk + (pk - zk) * mu_k; vv[tt] = zv + (pv - zv) * mu_v; pr = zr; pk = zk; pv = zv;
            kkv[tt] = kv * kk_c; kp[tt] = kv * (1.0f + (aa - 1.0f) * ka_c); rr[tt] = rv; bb[tt] = aa;
            s1[tt] = kkv[tt] * kkv[tt]; s2[tt] = rv * kp[tt] * rk_c;
            lw[tt] = bf2f(R.lw[tt]); run += lw[tt]; ll[tt] = run;
        }
#define PA_DPP8(x, ctrl, rmask) _Pragma("unroll") for (int tt = 0; tt < 8; ++tt) DPP_ADD(x[tt], ctrl, rmask)
        PA_DPP8(s1, 0xb1, 0xf); PA_DPP8(s2, 0xb1, 0xf); PA_DPP8(s1, 0x4e, 0xf); PA_DPP8(s2, 0x4e, 0xf); PA_DPP8(s1, 0x114, 0xf); PA_DPP8(s2, 0x114, 0xf);
        PA_DPP8(s1, 0x118, 0xf); PA_DPP8(s2, 0x118, 0xf); PA_DPP8(s1, 0x142, 0xa); PA_DPP8(s2, 0x142, 0xa); PA_DPP8(s1, 0x143, 0xc); PA_DPP8(s2, 0x143, 0xc);
#undef PA_DPP8
#pragma unroll
        for (int tt = 0; tt < 8; ++tt) {
            const float n2 = __builtin_bit_cast(float, __builtin_amdgcn_readlane(__builtin_bit_cast(int, s1[tt]), 63)), rk = __builtin_bit_cast(float, __builtin_amdgcn_readlane(__builtin_bit_cast(int, s2[tt]), 63));
            kkn[tt] = kkv[tt] / fmaxf(sqrtf(n2), 1e-12f); bb[tt] = kkn[tt] * bb[tt];
            if (lane == 0) B.rk[(row0 + 8 * w + tt) * 16 + h] = rk;
        }
        LAS float* pre = (LAS float*)(L + PA_NT);
        pre[w * 64 + c] = run;
        __syncthreads();
        float off = 0.f, tot = 0.f;
#pragma unroll
        for (int ww = 0; ww < 8; ++ww) { const float p = pre[ww * 64 + c]; tot += p; if (ww < w) off += p; }
        const float etot = __expf(tot);
        if (w == 0) B.gam[(size_t)unit * 64 + c] = etot;
        unsigned short a_[8], r_[8], b_[8], k_[8], bg_[8], kg_[8], v_[8];
        float e1 = __expf(off);
#pragma unroll
        for (int tt = 0; tt < 8; ++tt) {
            const float Lc = off + ll[tt], e3 = __expf(Lc), e2 = __expf(-Lc), eg = etot * e2;
            a_[tt] = f2bf16(-kkn[tt] * e1); r_[tt] = f2bf16(rr[tt] * e3); b_[tt] = f2bf16(bb[tt] * e2); k_[tt] = f2bf16(kp[tt] * e2);
            bg_[tt] = f2bf16(bb[tt] * eg); kg_[tt] = f2bf16(kp[tt] * eg); v_[tt] = f2bf16(vv[tt]);
            e1 = e3;
            const int t = 8 * w + tt;
            *(LAS unsigned short*)(L + PA_AT + t * PA_P + 2 * c) = a_[tt]; *(LAS unsigned short*)(L + PA_RT + t * PA_P + 2 * c) = r_[tt];
            *(LAS unsigned short*)(L + PA_BT + t * PA_P + 2 * c) = b_[tt]; *(LAS unsigned short*)(L + PA_KT + t * PA_P + 2 * c) = k_[tt];
        }
#define PK8(x) (v4u){(unsigned)x[0] | ((unsigned)x[1] << 16), (unsigned)x[2] | ((unsigned)x[3] << 16), (unsigned)x[4] | ((unsigned)x[5] << 16), (unsigned)x[6] | ((unsigned)x[7] << 16)}
        *(LAS v4u*)(L + PA_AC + c * PA_P + 16 * w) = PK8(a_); *(LAS v4u*)(L + PA_BGC + c * PA_P + 16 * w) = PK8(bg_);
        *(LAS v4u*)(L + PA_KGC + c * PA_P + 16 * w) = PK8(kg_); *(LAS v4u*)(L + PA_VC + c * PA_P + 16 * w) = PK8(v_);
#undef PK8
    }
    __syncthreads(); PA_RELAUNDER();
    REP_END()
    REP_BEGIN(2)
    {
        const int job = w >> 1, half = w & 1;
        ldsp_t Am = L + (job < 2 ? PA_AT : PA_RT), Bm = L + ((job & 1) ? PA_KT : PA_BT);
#pragma unroll
        for (int t2 = 0; t2 < 2; ++t2) {
            const int tt = 2 * half + t2;
            const bf16x8 a0 = lfrag(Am, 16 * tt + r, 16 * q), a1 = lfrag(Am, 16 * tt + r, 64 + 16 * q);
#pragma unroll
            for (int it = 0; it < 4; ++it) {
                f32x4 acc = (f32x4){0.f, 0.f, 0.f, 0.f};
                if (job == 0) {
                    if (it <= tt) { const bf16x8 b0 = lfrag(Bm, 16 * it + r, 16 * q), b1 = lfrag(Bm, 16 * it + r, 64 + 16 * q);
                        acc = __builtin_amdgcn_mfma_f32_16x16x32_bf16(a0, b0, acc, 0, 0, 0); acc = __builtin_amdgcn_mfma_f32_16x16x32_bf16(a1, b1, acc, 0, 0, 0); }
                    const int i = 16 * it + r;
#pragma unroll
                    for (int rg = 0; rg < 4; ++rg) { const int t = 16 * tt + 4 * q + rg; if (!(i < t)) acc[rg] = 0.f; }
                    *(LAS u32x2_t*)(L + PA_NT + i * PA_P + (16 * tt + 4 * q) * 2) = (u32x2_t){pk2(acc[0], acc[1]), pk2(acc[2], acc[3])};
                    if (it == tt) *(LAS f32x4*)(L + (tt < 2 ? PA_N01 + tt * 1280 : PA_ND2 + (tt - 2) * 1280) + r * 80 + 16 * q) = acc;
                } else {
                    if (it <= tt) { const bf16x8 b0 = lfrag(Bm, 16 * it + r, 16 * q), b1 = lfrag(Bm, 16 * it + r, 64 + 16 * q);
                        acc = __builtin_amdgcn_mfma_f32_16x16x32_bf16(b0, a0, acc, 0, 0, 0); acc = __builtin_amdgcn_mfma_f32_16x16x32_bf16(b1, a1, acc, 0, 0, 0); }
                    const int t = 16 * tt + r;
#pragma unroll
                    for (int rg = 0; rg < 4; ++rg) { const int i = 16 * it + 4 * q + rg; const bool keep = (job == 1) ? (i < t) : (i <= t); if (!keep) acc[rg] = 0.f; }
                    ldsp_t Om = L + (job == 1 ? PA_MKA : (job == 2 ? PA_NR : PA_MKR));
                    *(LAS u32x2_t*)(Om + t * PA_P + (16 * it + 4 * q) * 2) = (u32x2_t){pk2(acc[0], acc[1]), pk2(acc[2], acc[3])};
                }
            }
        }
    }
    __syncthreads(); PA_RELAUNDER();
    REP_END()
    REP_BEGIN(3)
    if (w == 0) {
        const int blk = lane >> 4, i = lane & 15;
        f32x2_t tr[8];
#pragma unroll
        for (int p2 = 0; p2 < 8; ++p2) tr[p2] = (f32x2_t){(2 * p2 == i) ? 1.f : 0.f, (2 * p2 + 1 == i) ? 1.f : 0.f};
        const LAS float* nb = (const LAS float*)(L + (blk < 2 ? PA_N01 + blk * 1280 : PA_ND2 + (blk - 2) * 1280));
#pragma unroll
        for (int j = 0; j < 15; ++j) {
            const LAS float* nbj = nb;
            if (j > 2) { const float dep = ((j - 3) & 1) ? tr[(j - 3) >> 1].y : tr[(j - 3) >> 1].x; asm volatile("" : "+v"(nbj) : "v"(dep)); } else asm volatile("" : "+v"(nbj));
            f32x4 cur[4];
#pragma unroll
            for (int q4 = (j + 1) / 4; q4 < 4; ++q4) cur[q4] = *(const LAS f32x4*)(nbj + j * 20 + 4 * q4);
            const float sc = (j & 1) ? tr[j >> 1].y : tr[j >> 1].x;
            const f32x2_t sc2 = {sc, sc};
#pragma unroll
            for (int p2 = (j + 1) >> 1; p2 < 8; ++p2) tr[p2] += sc2 * ((p2 & 1) ? __builtin_shufflevector(cur[p2 >> 1], cur[p2 >> 1], 2, 3) : __builtin_shufflevector(cur[p2 >> 1], cur[p2 >> 1], 0, 1));
        }
        unsigned tp[8];
#pragma unroll
        for (int p2 = 0; p2 < 8; ++p2) { tp[p2] = pk2(tr[p2].x, tr[p2].y);
            *(LAS unsigned short*)(L + PA_TT + (16 * blk + 2 * p2) * PA_P + (16 * blk + i) * 2) = (unsigned short)(tp[p2] & 0xffffu);
            *(LAS unsigned short*)(L + PA_TT + (16 * blk + 2 * p2 + 1) * PA_P + (16 * blk + i) * 2) = (unsigned short)(tp[p2] >> 16); }
        *(LAS v4u*)(L + PA_TR + blk * 768 + i * 48) = (v4u){tp[0], tp[1], tp[2], tp[3]}; *(LAS v4u*)(L + PA_TR + blk * 768 + i * 48 + 16) = (v4u){tp[4], tp[5], tp[6], tp[7]};
    } else if (w == 1) {
        const int t = lane;
#pragma unroll
        for (int bb2 = 0; bb2 < 4; ++bb2) if (bb2 != (t >> 4)) { *(LAS v4u*)(L + PA_TT + t * PA_P + 32 * bb2) = (v4u){0u, 0u, 0u, 0u}; *(LAS v4u*)(L + PA_TT + t * PA_P + 32 * bb2 + 16) = (v4u){0u, 0u, 0u, 0u}; }
    } else if (w >= 4) {
        const int vt = w - 4;
        const bf16x8 a0 = lfrag(L + PA_VC, 16 * vt + r, 16 * q), a1 = lfrag(L + PA_VC, 16 * vt + r, 64 + 16 * q);
#pragma unroll
        for (int tt = 0; tt < 4; ++tt) {
            const bf16x8 b0 = lfrag(L + PA_MKA, 16 * tt + r, 16 * q), b1 = lfrag(L + PA_MKA, 16 * tt + r, 64 + 16 * q);
            f32x4 acc = (f32x4){0.f, 0.f, 0.f, 0.f};
            acc = __builtin_amdgcn_mfma_f32_16x16x32_bf16(b0, a0, acc, 0, 0, 0); acc = __builtin_amdgcn_mfma_f32_16x16x32_bf16(b1, a1, acc, 0, 0, 0);
            *(LAS u32x2_t*)(L + PA_XU + (16 * vt + r) * PA_P + (16 * tt + 4 * q) * 2) = (u32x2_t){pk2(acc[0], acc[1]), pk2(acc[2], acc[3])};
        }
    }
    __syncthreads(); PA_RELAUNDER();
    REP_END()
    REP_BEGIN(4)
#pragma unroll
    for (int lev = 1; lev <= 3; ++lev) {
        if (w + lev <= 3) {
            const int a = w, b = w + lev;
            f32x4 m = (f32x4){0.f, 0.f, 0.f, 0.f};
            if (a == 0) m = __builtin_amdgcn_mfma_f32_16x16x32_bf16(lfrag(L + PA_NT, 16 * a + r, 16 * q), lfrag(L + PA_TT, 16 * b + r, 16 * q), m, 0, 0, 0);
            if (a >= 1 || b >= 2) m = __builtin_amdgcn_mfma_f32_16x16x32_bf16(lfrag(L + PA_NT, 16 * a + r, 64 + 16 * q), lfrag(L + PA_TT, 16 * b + r, 64 + 16 * q), m, 0, 0, 0);
            const u32x4_t mp = (u32x4_t){pk2(m[0], m[1]), pk2(m[2], m[3]), 0u, 0u};
            const s16x4_t alo = *(const LAS s16x4_t*)(L + PA_TR + a * 768 + r * 48 + (4 * q) * 2);
            f32x4 acc = (f32x4){0.f, 0.f, 0.f, 0.f};
            acc = __builtin_amdgcn_mfma_f32_16x16x32_bf16(cat4(alo, (s16x4_t){0, 0, 0, 0}), __builtin_bit_cast(bf16x8, mp), acc, 0, 0, 0);
            *(LAS u32x2_t*)(L + PA_TT + (16 * b + r) * PA_P + (16 * a + 4 * q) * 2) = (u32x2_t){pk2(acc[0], acc[1]), pk2(acc[2], acc[3])};
        }
        __syncthreads(); PA_RELAUNDER();
    }
    REP_END()
    if (next_unit < NUNIT) pa_load(R, I, Zc, LWc, AAc, next_unit, w, lane);
    REP_BEGIN(5)
    {
        const int rt = w & 3;
        ldsp_t Am = L + (w < 4 ? PA_AC : PA_XU), Om = L + (w < 4 ? PA_W1 : PA_U0);
        const bf16x8 a0 = lfrag(Am, 16 * rt + r, 16 * q), a1 = lfrag(Am, 16 * rt + r, 64 + 16 * q);
#pragma unroll
        for (int tt = 0; tt < 4; ++tt) {
            const bf16x8 b0 = lfrag(L + PA_TT, 16 * tt + r, 16 * q), b1 = lfrag(L + PA_TT, 16 * tt + r, 64 + 16 * q);
            f32x4 acc = (f32x4){0.f, 0.f, 0.f, 0.f};
            acc = __builtin_amdgcn_mfma_f32_16x16x32_bf16(b0, a0, acc, 0, 0, 0); acc = __builtin_amdgcn_mfma_f32_16x16x32_bf16(b1, a1, acc, 0, 0, 0);
            *(LAS u32x2_t*)(Om + (16 * rt + r) * PA_P + (16 * tt + 4 * q) * 2) = (u32x2_t){pk2(acc[0], acc[1]), pk2(acc[2], acc[3])};
        }
    }
    __syncthreads(); PA_RELAUNDER();
    REP_END()
    REP_BEGIN(6)
    if (w < 4) {
        const int kt = w;
        {
            const bf16x8 a0 = lfrag(L + PA_W1, 16 * kt + r, 16 * q), a1 = lfrag(L + PA_W1, 16 * kt + r, 64 + 16 * q);
#pragma unroll
            for (int k2 = 0; k2 < 4; ++k2) {
                const bf16x8 b0 = lfrag(L + PA_BGC, 16 * k2 + r, 16 * q), b1 = lfrag(L + PA_BGC, 16 * k2 + r, 64 + 16 * q);
                f32x4 acc = (f32x4){0.f, 0.f, 0.f, 0.f};
                acc = __builtin_amdgcn_mfma_f32_16x16x32_bf16(a0, b0, acc, 0, 0, 0); acc = __builtin_amdgcn_mfma_f32_16x16x32_bf16(a1, b1, acc, 0, 0, 0);
                *(LAS u32x2_t*)(L + PA_AC + (16 * k2 + r) * PA_P + (32 * (kt >> 1) + 8 * q + 4 * (kt & 1)) * 2) = (u32x2_t){pk2(acc[0], acc[1]), pk2(acc[2], acc[3])};
            }
        }
        {
            const bf16x8 a0 = lfrag(L + PA_BGC, 16 * kt + r, 16 * q), a1 = lfrag(L + PA_BGC, 16 * kt + r, 64 + 16 * q), a2 = lfrag(L + PA_KGC, 16 * kt + r, 16 * q), a3 = lfrag(L + PA_KGC, 16 * kt + r, 64 + 16 * q);
#pragma unroll
            for (int vt = 0; vt < 4; ++vt) {
                const bf16x8 b0 = lfrag(L + PA_U0, 16 * vt + r, 16 * q), b1 = lfrag(L + PA_U0, 16 * vt + r, 64 + 16 * q), b2 = lfrag(L + PA_VC, 16 * vt + r, 16 * q), b3 = lfrag(L + PA_VC, 16 * vt + r, 64 + 16 * q);
                f32x4 acc = (f32x4){0.f, 0.f, 0.f, 0.f};
                acc = __builtin_amdgcn_mfma_f32_16x16x32_bf16(a0, b0, acc, 0, 0, 0); acc = __builtin_amdgcn_mfma_f32_16x16x32_bf16(a1, b1, acc, 0, 0, 0);
                acc = __builtin_amdgcn_mfma_f32_16x16x32_bf16(a2, b2, acc, 0, 0, 0); acc = __builtin_amdgcn_mfma_f32_16x16x32_bf16(a3, b3, acc, 0, 0, 0);
                *(LAS u32x2_t*)(L + PA_NT + (16 * vt + r) * PA_P + (16 * kt + 4 * q) * 2) = (u32x2_t){pk2(acc[0], acc[1]), pk2(acc[2], acc[3])};
            }
        }
    } else {
        const int xt = w - 4;
        {
            const bf16x8 a0 = lfrag(L + PA_W1, 16 * xt + r, 16 * q), a1 = lfrag(L + PA_W1, 16 * xt + r, 64 + 16 * q);
#pragma unroll
            for (int tt = 0; tt < 4; ++tt) {
                const bf16x8 b0 = lfrag(L + PA_NR, 16 * tt + r, 16 * q), b1 = lfrag(L + PA_NR, 16 * tt + r, 64 + 16 * q);
                const u32x2_t rv = *(const LAS u32x2_t*)(L + PA_RT + (16 * tt + r) * PA_P + (16 * xt + 4 * q) * 2);
                f32x4 acc = (f32x4){bflo(rv.x), bfhi(rv.x), bflo(rv.y), bfhi(rv.y)};
                acc = __builtin_amdgcn_mfma_f32_16x16x32_bf16(a0, b0, acc, 0, 0, 0); acc = __builtin_amdgcn_mfma_f32_16x16x32_bf16(a1, b1, acc, 0, 0, 0);
                *(LAS u32x2_t*)(L + PA_MKA + (16 * tt + r) * PA_P + (16 * xt + 4 * q) * 2) = (u32x2_t){pk2(acc[0], acc[1]), pk2(acc[2], acc[3])};
            }
        }
        {
            const bf16x8 a0 = lfrag(L + PA_U0, 16 * xt + r, 16 * q), a1 = lfrag(L + PA_U0, 16 * xt + r, 64 + 16 * q), a2 = lfrag(L + PA_VC, 16 * xt + r, 16 * q), a3 = lfrag(L + PA_VC, 16 * xt + r, 64 + 16 * q);
#pragma unroll
            for (int tt = 0; tt < 4; ++tt) {
                const bf16x8 b0 = lfrag(L + PA_NR, 16 * tt + r, 16 * q), b1 = lfrag(L + PA_NR, 16 * tt + r, 64 + 16 * q), b2 = lfrag(L + PA_MKR, 16 * tt + r, 16 * q), b3 = lfrag(L + PA_MKR, 16 * tt + r, 64 + 16 * q);
                f32x4 acc = (f32x4){0.f, 0.f, 0.f, 0.f};
                acc = __builtin_amdgcn_mfma_f32_16x16x32_bf16(a0, b0, acc, 0, 0, 0); acc = __builtin_amdgcn_mfma_f32_16x16x32_bf16(a1, b1, acc, 0, 0, 0);
                acc = __builtin_amdgcn_mfma_f32_16x16x32_bf16(a2, b2, acc, 0, 0, 0); acc = __builtin_amdgcn_mfma_f32_16x16x32_bf16(a3, b3, acc, 0, 0, 0);
                *(LAS u32x2_t*)(L + PA_XU + (16 * tt + r) * PA_P + (16 * xt + 4 * q) * 2) = (u32x2_t){pk2(acc[0], acc[1]), pk2(acc[2], acc[3])};
            }
        }
    }
    __syncthreads(); PA_RELAUNDER();
    {
        const int row = 8 * w + (lane >> 3), cb = (lane & 7) * 16;
        *(v4u*)((char*)(B.Pg + (size_t)unit * 4096) + row * 128 + cb) = *(const LAS v4u*)(L + PA_AC + row * PA_P + cb);
        *(v4u*)((char*)(B.Qg + (size_t)unit * 4096) + row * 128 + cb) = *(const LAS v4u*)(L + PA_NT + row * PA_P + cb);
        *(v4u*)((char*)(B.Gg + (size_t)unit * 4096) + row * 128 + cb) = *(const LAS v4u*)(L + PA_MKA + row * PA_P + cb);
        *(v4u*)((char*)(B.Yb + (size_t)unit * 4096) + row * 128 + cb) = *(const LAS v4u*)(L + PA_XU + row * PA_P + cb);
    }
    __syncthreads();
    REP_END()
#undef PA_RELAUNDER
#undef REP_BEGIN
#undef REP_END
}

struct ChOp { bf16x8 pf[4][2]; u32x2_t qv[4]; f32x4 g4[4]; };
__device__ __forceinline__ void ch_load(ChOp& o, const PaBufs& B, size_t unit, int ct, int a, int q) {
    const bf16* Pg = B.Pg + unit * 4096; const bf16* Qg = B.Qg + unit * 4096; const float* gm = B.gam + unit * 64;
#pragma unroll
    for (int rt = 0; rt < 4; ++rt) {
        o.qv[rt] = *(const u32x2_t*)(Qg + (16 * ct + a) * 64 + 16 * rt + 4 * q); o.g4[rt] = *(const f32x4*)(gm + 16 * rt + 4 * q);
#pragma unroll
        for (int ks = 0; ks < 2; ++ks) o.pf[rt][ks] = *(const bf16x8*)(Pg + (16 * rt + a) * 64 + 32 * ks + 8 * q);
    }
}
template <bool STORE> __device__ __forceinline__ void ch_step(f32x4 (&st)[4], const ChOp& o, const PaBufs& B, size_t unit, int ct, int a, int q) {
    bf16x8 sf[2]; u32x2_t sb[4];
#pragma unroll
    for (int rt = 0; rt < 4; ++rt) sb[rt] = (u32x2_t){pk2(st[rt][0], st[rt][1]), pk2(st[rt][2], st[rt][3])};
#pragma unroll
    for (int ks = 0; ks < 2; ++ks) sf[ks] = __builtin_bit_cast(bf16x8, (u32x4_t){sb[2 * ks].x, sb[2 * ks].y, sb[2 * ks + 1].x, sb[2 * ks + 1].y});
    bf16* Qg = B.Qg + unit * 4096;
#pragma unroll
    for (int rt = 0; rt < 4; ++rt) if (STORE) *(u32x2_t*)(Qg + (16 * ct + a) * 64 + 16 * rt + 4 * q) = sb[rt];
    f32x4 nw[4];
#pragma unroll
    for (int rt = 0; rt < 4; ++rt) {
        f32x4 acc = (f32x4){bflo(o.qv[rt].x), bfhi(o.qv[rt].x), bflo(o.qv[rt].y), bfhi(o.qv[rt].y)} + st[rt] * o.g4[rt];
#pragma unroll
        for (int ks = 0; ks < 2; ++ks) acc = __builtin_amdgcn_mfma_f32_16x16x32_bf16(o.pf[rt][ks], sf[ks], acc, 0, 0, 0);
        nw[rt] = acc;
    }
#pragma unroll
    for (int rt = 0; rt < 4; ++rt) st[rt] = nw[rt];
}
template <bool STORE> __device__ __forceinline__ void chain2(Frame& F, const PaBufs& B, float* out, int seq, int ct, unsigned* prog) {
    const int lane = F.lane, a = lane & 15, q = lane >> 4;
    f32x4 st[4];
#pragma unroll
    for (int rt = 0; rt < 4; ++rt) st[rt] = (f32x4){0.f, 0.f, 0.f, 0.f};
    const size_t u0 = (size_t)seq * (SEQ / CH);
    ChOp oa, ob, oc;
    ch_load(oa, B, u0, ct, a, q); ch_load(ob, B, u0 + 1, ct, a, q);
    int c = 0;
    for (; c + 3 <= SEQ / CH - 2; c += 3) {
        ch_load(oc, B, u0 + c + 2, ct, a, q); ch_step<STORE>(st, oa, B, u0 + c, ct, a, q);
        ch_load(oa, B, u0 + c + 3, ct, a, q); ch_step<STORE>(st, ob, B, u0 + c + 1, ct, a, q);
        ch_load(ob, B, u0 + c + 4, ct, a, q); ch_step<STORE>(st, oc, B, u0 + c + 2, ct, a, q);
    }
    ch_step<STORE>(st, oa, B, u0 + c, ct, a, q); ch_step<STORE>(st, ob, B, u0 + c + 1, ct, a, q);
    float* dst = out + OFF_WKV_P + (size_t)seq * 4096 + (size_t)(16 * ct + a) * 64 + 4 * q;
#pragma unroll
    for (int rt = 0; rt < 4; ++rt) { if (STORE) *(f32x4*)(dst + 16 * rt) = st[rt]; else asm volatile("" :: "v"(st[rt])); }
}

struct ChOp3 { bf16x8 pf[4][2]; u32x2_t qv[4]; };
__device__ __forceinline__ void ch_load3(ChOp3& o, const PaBufs& B, size_t unit, int ct, int a, int q) {
    const bf16* Pg = B.Pg + unit * 4096; const bf16* Qg = B.Qg + unit * 4096;
#pragma unroll
    for (int rt = 0; rt < 4; ++rt) {
        o.qv[rt] = *(const u32x2_t*)(Qg + (16 * ct + a) * 64 + 16 * rt + 4 * q);
#pragma unroll
        for (int ks = 0; ks < 2; ++ks) o.pf[rt][ks] = *(const bf16x8*)(Pg + (16 * rt + a) * 64 + 32 * ks + 8 * q);
    }
}
__device__ __forceinline__ void ch_gam_stage(LAS float* tbl, const float* gm, int lane) {
    f32x4 v[16];
#pragma unroll
    for (int i = 0; i < 16; ++i) v[i] = *(const f32x4*)(gm + (size_t)(i * 64 + lane) * 4);
#pragma unroll
    for (int i = 0; i < 16; ++i) *(LAS f32x4*)(tbl + (i * 64 + lane) * 4) = v[i];
}
__device__ __forceinline__ void ch_gam_read(f32x4 (&g)[4], const LAS float* tbl, int c, int q) {
#pragma unroll
    for (int rt = 0; rt < 4; ++rt) g[rt] = *(const LAS f32x4*)(tbl + (c & 63) * 64 + 16 * rt + 4 * q);
}
__device__ __forceinline__ void ch_step3(f32x4 (&st)[4], const ChOp3& o, const f32x4 (&g4)[4], const PaBufs& B, size_t unit, int ct, int a, int q) {
    bf16x8 sf[2]; u32x2_t sb[4];
#pragma unroll
    for (int rt = 0; rt < 4; ++rt) sb[rt] = (u32x2_t){pk2(st[rt][0], st[rt][1]), pk2(st[rt][2], st[rt][3])};
#pragma unroll
    for (int ks = 0; ks < 2; ++ks) sf[ks] = __builtin_bit_cast(bf16x8, (u32x4_t){sb[2 * ks].x, sb[2 * ks].y, sb[2 * ks + 1].x, sb[2 * ks + 1].y});
    bf16* Qg = B.Qg + unit * 4096;
#pragma unroll
    for (int rt = 0; rt < 4; ++rt) *(u32x2_t*)(Qg + (16 * ct + a) * 64 + 16 * rt + 4 * q) = sb[rt];
    f32x4 nw[4];
#pragma unroll
    for (int rt = 0; rt < 4; ++rt) nw[rt] = (f32x4){bflo(o.qv[rt].x), bfhi(o.qv[rt].x), bflo(o.qv[rt].y), bfhi(o.qv[rt].y)} + st[rt] * g4[rt];
#pragma unroll
    for (int rt = 0; rt < 4; ++rt) nw[rt] = __builtin_amdgcn_mfma_f32_16x16x32_bf16(o.pf[rt][0], sf[0], nw[rt], 0, 0, 0);
#pragma unroll
    for (int rt = 0; rt < 4; ++rt) nw[rt] = __builtin_amdgcn_mfma_f32_16x16x32_bf16(o.pf[rt][1], sf[1], nw[rt], 0, 0, 0);
#pragma unroll
    for (int rt = 0; rt < 4; ++rt) st[rt] = nw[rt];
}
__device__ __forceinline__ void chain3(Frame& F, const PaBufs& B, float* out, int seq, int ct, LAS float* tbl) {
    const int lane = F.lane, a = lane & 15, q = lane >> 4;
    constexpr int NS = SEQ / CH;
    f32x4 st[4];
#pragma unroll
    for (int rt = 0; rt < 4; ++rt) st[rt] = (f32x4){0.f, 0.f, 0.f, 0.f};
    const size_t u0 = (size_t)seq * NS;
    const float* gm0 = B.gam + u0 * 64;
    ch_gam_stage(tbl, gm0, lane);
    ChOp3 o0, o1, o2, o3; f32x4 g[4];
    ch_load3(o0, B, u0, ct, a, q); ch_load3(o1, B, u0 + 1, ct, a, q); ch_load3(o2, B, u0 + 2, ct, a, q);
#define CH_CL(i) (u0 + ((i) < NS ? (i) : NS - 1))
#pragma unroll 1
    for (int c = 0; c < NS; c += 4) {
        const bool rs = c >= 16 && c < 80; const int cq = c & ~15, sub = (c & 15) >> 2;
        f32x4 gv = (f32x4){0.f, 0.f, 0.f, 0.f};
        if (rs) gv = *(const f32x4*)(gm0 + (size_t)(cq + 48) * 64 + (sub * 64 + lane) * 4);
        ch_load3(o3, B, CH_CL(c + 3), ct, a, q); ch_gam_read(g, tbl, c, q);     ch_step3(st, o0, g, B, u0 + c, ct, a, q);
        ch_load3(o0, B, CH_CL(c + 4), ct, a, q); ch_gam_read(g, tbl, c + 1, q); ch_step3(st, o1, g, B, u0 + c + 1, ct, a, q);
        ch_load3(o1, B, CH_CL(c + 5), ct, a, q); ch_gam_read(g, tbl, c + 2, q); ch_step3(st, o2, g, B, u0 + c + 2, ct, a, q);
        ch_load3(o2, B, CH_CL(c + 6), ct, a, q); ch_gam_read(g, tbl, c + 3, q); ch_step3(st, o3, g, B, u0 + c + 3, ct, a, q);
        if (rs) *(LAS f32x4*)(tbl + ((cq + 48) & 63) * 64 + (sub * 64 + lane) * 4) = gv;
    }
#undef CH_CL
    float* dst = out + OFF_WKV_P + (size_t)seq * 4096 + (size_t)(16 * ct + a) * 64 + 4 * q;
#pragma unroll
    for (int rt = 0; rt < 4; ++rt) *(f32x4*)(dst + 16 * rt) = st[rt];
}

struct FinOp { bf16x8 g0, g1; u32x2_t y0[4], zv[4], zp[4], gv[4]; float rk; };
__device__ __forceinline__ void wkv_finish_unit(Frame& F, const In& I, unsigned char* ws, const PaBufs& B, bf16* RO, int unit) {
    const int lane = F.lane, r = lane & 15, q = lane >> 4;
    const int seq = unit >> 7, ch = unit & 127, bb_ = seq >> 4, h = seq & 15;
    const size_t row0 = (size_t)bb_ * SEQ + (size_t)ch * CH;
    const bf16* Z = (const bf16*)(ws + WS_Z); const bf16* GG = (const bf16*)(ws + WS_GG);
    const bf16* Sg = B.Qg + (size_t)unit * 4096; const bf16* Gg = B.Gg + (size_t)unit * 4096;
    auto fin_load = [&](FinOp& o, int tt) {
        const size_t m = row0 + 16 * tt + r;
        o.g0 = *(const bf16x8*)(Gg + (16 * tt + r) * 64 + 8 * q); o.g1 = *(const bf16x8*)(Gg + (16 * tt + r) * 64 + 32 + 8 * q);
        const bool first = (m & (SEQ - 1)) == 0;
#pragma unroll
        for (int vt = 0; vt < 4; ++vt) { const int c = h * 64 + 16 * vt + 4 * q;
            o.y0[vt] = *(const u32x2_t*)(B.Yb + (size_t)unit * 4096 + (16 * tt + r) * 64 + 16 * vt + 4 * q);
            o.zv[vt] = *(const u32x2_t*)(Z + m * ZC + 2048 + c);
            o.zp[vt] = (u32x2_t){0u, 0u};
            if (r == 0 && !first) o.zp[vt] = *(const u32x2_t*)(Z + (m - 1) * ZC + 2048 + c);
            o.gv[vt] = *(const u32x2_t*)(GG + m * 1024 + c); }
        o.rk = B.rk[m * 16 + h];
    };
    bf16x8 sfr[4][2];
#pragma unroll
    for (int vt = 0; vt < 4; ++vt)
#pragma unroll
        for (int ks = 0; ks < 2; ++ks) sfr[vt][ks] = *(const bf16x8*)(Sg + (16 * vt + r) * 64 + 32 * ks + 8 * q);
    const f32x4 mu[4] = {*(const f32x4*)(I.shift_mu + 2048 + h * 64 + 4 * q), *(const f32x4*)(I.shift_mu + 2048 + h * 64 + 16 + 4 * q), *(const f32x4*)(I.shift_mu + 2048 + h * 64 + 32 + 4 * q), *(const f32x4*)(I.shift_mu + 2048 + h * 64 + 48 + 4 * q)};
    auto fin_compute = [&](const FinOp& o, int tt) {
        const size_t m = row0 + 16 * tt + r;
        f32x4 y[4];
#pragma unroll
        for (int vt = 0; vt < 4; ++vt) {
            f32x4 acc = (f32x4){bflo(o.y0[vt].x), bfhi(o.y0[vt].x), bflo(o.y0[vt].y), bfhi(o.y0[vt].y)};
            if (ch > 0) { acc = __builtin_amdgcn_mfma_f32_16x16x32_bf16(sfr[vt][0], o.g0, acc, 0, 0, 0); acc = __builtin_amdgcn_mfma_f32_16x16x32_bf16(sfr[vt][1], o.g1, acc, 0, 0, 0); }
            y[vt] = acc;
        }
        float sm = 0.f;
#pragma unroll
        for (int vt = 0; vt < 4; ++vt) sm += (y[vt][0] + y[vt][1]) + (y[vt][2] + y[vt][3]);
        sm += __shfl_xor(sm, 16); sm += __shfl_xor(sm, 32);
        const float mean = sm * (1.0f / 64.0f);
        float sq = 0.f;
#pragma unroll
        for (int vt = 0; vt < 4; ++vt) { y[vt] = y[vt] - mean; sq += (y[vt][0] * y[vt][0] + y[vt][1] * y[vt][1]) + (y[vt][2] * y[vt][2] + y[vt][3] * y[vt][3]); }
        sq += __shfl_xor(sq, 16); sq += __shfl_xor(sq, 32);
        const float rs = 1.0f / sqrtf(sq * (1.0f / 64.0f) + 64e-5f);
        const float rk = o.rk;
#pragma unroll
        for (int vt = 0; vt < 4; ++vt) {
            const int c = h * 64 + 16 * vt + 4 * q;
            const u32x2_t zv = o.zv[vt]; u32x2_t zp = o.zp[vt];
            float v0 = bflo(zv.x), v1 = bfhi(zv.x), v2 = bflo(zv.y), v3 = bfhi(zv.y);
            zp.x = (unsigned)__builtin_amdgcn_update_dpp((int)zp.x, (int)zv.x, 0x111, 0xf, 0xf, false); zp.y = (unsigned)__builtin_amdgcn_update_dpp((int)zp.y, (int)zv.y, 0x111, 0xf, 0xf, false);
            const float p0 = bflo(zp.x), p1 = bfhi(zp.x), p2 = bflo(zp.y), p3 = bfhi(zp.y);
            v0 += (p0 - v0) * mu[vt].x; v1 += (p1 - v1) * mu[vt].y; v2 += (p2 - v2) * mu[vt].z; v3 += (p3 - v3) * mu[vt].w;
            const f32x4 lw4 = *(const f32x4*)(I.lnx_w + c), lb4 = *(const f32x4*)(I.lnx_b + c);
            const u32x2_t gv = o.gv[vt];
            const float o0 = (y[vt][0] * rs * lw4.x + lb4.x + rk * v0) * bflo(gv.x), o1 = (y[vt][1] * rs * lw4.y + lb4.y + rk * v1) * bfhi(gv.x);
            const float o2 = (y[vt][2] * rs * lw4.z + lb4.z + rk * v2) * bflo(gv.y), o3 = (y[vt][3] * rs * lw4.w + lb4.w + rk * v3) * bfhi(gv.y);
            *(u32x2_t*)(RO + m * 1024 + c) = (u32x2_t){pk2(o0, o1), pk2(o2, o3)};
        }
    };
    FinOp oa, ob;
    fin_load(oa, 0); fin_load(ob, 1); fin_compute(oa, 0); fin_load(oa, 2); fin_compute(ob, 1); fin_load(ob, 3); fin_compute(oa, 2); fin_compute(ob, 3);
}
#define HELPERS_OFF_CHAIN 1
#ifndef P1_SP2
#define P1_SP2 true
#endif

__global__ void __launch_bounds__(NWAVES * 64, 2) mk_fwd(Args args) {
    extern __shared__ __attribute__((aligned(16))) unsigned char lds[];
    Frame F;
    F.lds = (LAS unsigned char*)lds;
    F.MISC = (volatile LAS unsigned*)(F.lds + MISC_OFF);
    F.tid = threadIdx.x; F.lane = F.tid & 63; F.wave = __builtin_amdgcn_readfirstlane(F.tid >> 6);
    const int wave_idx = F.wave;
    F.G = gridDim.x; { const int bx = blockIdx.x; F.vcu = (F.G % 8 == 0) ? (bx % 8) * (F.G / 8) + bx / 8 : bx; }
    unsigned char* ws = args.ws; float* out = args.out; const In& I = args.in;
    F.ctl = (gu32*)(ws + WS_CTL);
    for (int u = F.tid; u < (LDS_BYTES - LDSCTL_OFF) / 4; u += NWAVES * 64) ((LAS unsigned*)(F.lds + LDSCTL_OFF))[u] = 0u;
    __syncthreads();
    XcdBarrier bar = xcd_barrier_post((unsigned*)(F.ctl + CW_BAR), F.MISC + 8);
    unsigned* const lbar = (unsigned*)(F.ctl + CW_LBAR);
    if (threadIdx.x == 0 && (bar.x != (blockIdx.x & 7u) || (gridDim.x & 7u) != 0u || gridDim.x * NWAVES * 8u != (unsigned)NTOK_P)) (void)xb_add(&lbar[LB_MISM], 1u);
#define GRID_BAR() do { xcd_barrier(bar, mk_tid(wave_idx)); int t_ = mk_tid(wave_idx); asm volatile("" : "+v"(t_)); F.tid = t_; F.lane = t_ & 63; F.wave = wave_idx; } while (0)
#define GROUP_BAR() do { if (F.MISC[10] != 0u) xcd_local_barrier(bar, lbar, mk_tid(wave_idx)); else xcd_barrier(bar, mk_tid(wave_idx)); int t_ = mk_tid(wave_idx); asm volatile("" : "+v"(t_)); F.tid = t_; F.lane = t_ & 63; F.wave = wave_idx; } while (0)
    const int bx = (int)blockIdx.x;
#ifdef PROBE_HALF
#define GP_SEL(n) ((n) == PROBE_HALF || (PROBE_HALF == 3 && (n) == 4) || (PROBE_HALF == 8 && (n) == 9))
#define GP_G(n) (GP_SEL(n) ? F.G / 2 : F.G)
#define GP_C(n) (GP_SEL(n) ? (bx < F.G / 2 ? bx : (1 << 28)) : bx)
#else
#define GP_G(n) F.G
#define GP_C(n) bx
#endif
    bf16* XB = (bf16*)(ws + WS_XB); bf16* Zb = (bf16*)(ws + WS_Z); float* stat = (float*)(ws + WS_STAT);
    float* ss1 = stat + MPAD; float* ss2 = stat + 2 * (size_t)MPAD; float* ss3 = stat + 3 * (size_t)MPAD;

    p0_prologue(F, I, ws);
#ifdef P0LATE_IN_P0
    p0_late(F, I, ws, F.vcu * NWAVES + F.wave, F.G * NWAVES, 0, 1 << 30, 0, 1 << 30);
#endif
#ifdef PROBE_P0
    __syncthreads(); p0_prologue(F, I, ws);
#endif
    GRID_BAR();
    if (F.tid == 0) F.MISC[10] = (xb_ld(&lbar[LB_MISM]) == 0u && F.MISC[9] == 8u && F.MISC[8] * 8u == gridDim.x) ? 1u : 0u;
    __syncthreads();
    constexpr int LATE_SPLIT_IT = 2944, LATE_SPLIT_M = 8320;
    {
        pg8::Gemm g{XB, (const bf16*)(ws + WS_WIN), MPAD, ZC, DM}; pg8::StaticOrder S; S.init(MPAD, ZC, GP_G(1), GP_C(1));
        pg8::EpiZ E{Zb, stat, out};
        pg8::gemm_phase<pg8::EpiZ, pg8::StaticOrder, true, true>(wave_idx, F.lds + RING_OFF, g, S, E);
#ifdef PROBE_P1
        VM_WAIT(); __syncthreads();
        pg8::gemm_phase<pg8::EpiZ, pg8::StaticOrder, true, true>(wave_idx, F.lds + RING_OFF, g, S, E);
#endif
    }
    GRID_BAR();
    p2a_all(F, I, ws, out);
#ifdef PROBE_P2A
    for (int rep = 0; rep < 4; ++rep) { asm volatile("" ::: "memory"); p2a_all(F, I, ws, out); }
#endif
    GROUP_BAR();
    {
        pg8::Gemm g{(const bf16*)(ws + WS_ALORA), (const bf16*)(ws + WS_WLORA), NTOK_P, 3072, 256}; pg8::StaticOrder S; S.init(NTOK_P, 3072, GP_G(2), GP_C(2));
        pg8::EpiLora E{(bf16*)(ws + WS_LW), (bf16*)(ws + WS_AA), (bf16*)(ws + WS_GG), I.decay_w0, I.aaa_a0};
        pg8::mini_gemm_nu<pg8::EpiLora, 256, 3>(wave_idx, F.lds + RING_OFF, g.A, g.Bt, g.N, NTOK_P, GP_C(2), GP_G(2), E);
        pg8::gemm_phase<pg8::EpiLora, pg8::StaticOrder, true, true>(wave_idx, F.lds + RING_OFF, g, S, E);
#ifdef PROBE_P2B
        VM_WAIT(); __syncthreads();
        pg8::gemm_phase<pg8::EpiLora, pg8::StaticOrder, true, true>(wave_idx, F.lds + RING_OFF, g, S, E);
#endif
    }
    GROUP_BAR();
    PaBufs PB_; PB_.Pg = (bf16*)(ws + WS_PG); PB_.Gg = (bf16*)(ws + WS_GT); PB_.Yb = (bf16*)(out + OFF_Y_P); PB_.Qg = PB_.Yb + (size_t)NTOK_P * 1024; PB_.gam = (float*)(ws + WS_GAM); PB_.rk = (float*)(ws + WS_RK);
    {
        const bf16* Zc = (const bf16*)(ws + WS_Z); const bf16* LWc = (const bf16*)(ws + WS_LW); const bf16* AAc = (const bf16*)(ws + WS_AA);
        PaRaw raw;
#ifdef PROBE_PASSA
#pragma unroll 1
        for (int rep = 0; rep < 2; ++rep) {
#endif
        const bool pa_cls = F.G * NWAVES * 8 == NTOK_P;
        auto pa_unit = [&](int k) -> int {
            if (pa_cls) { if (k >= 16) return NUNIT; const int c = bx & 7, j = bx >> 3; return (((c >> 2) * 16 + k) * 128) + 32 * (c & 3) + j; }
            const long u = (long)bx + (long)k * F.G; return u < NUNIT ? (int)u : NUNIT; };
        if (pa_unit(0) < NUNIT) pa_load(raw, I, Zc, LWc, AAc, pa_unit(0), F.wave, F.lane);
        for (int k = 0; pa_unit(k) < NUNIT; ++k) passA_unit(F, I, PB_, pa_unit(k), raw, pa_unit(k + 1), Zc, LWc, AAc);
#ifdef PROBE_PASSA
        }
#endif
    }
    GRID_BAR();
    {
        LAS float* wl = (LAS float*)(F.lds + RING_OFF + F.wave * 16384);
        const int NCH = 128, NCW = 1;
#ifdef HELPERS_OFF_CHAIN
        const int nhw = (F.G - NCH) * NWAVES;
#else
        const int nhw = NCH * (NWAVES - NCW) + (F.G - NCH) * NWAVES;
#endif
        int hw = -1;
        if (bx < NCH) { if (F.wave < NCW) {
#ifdef PROBE_CHAIN
            chain2<false>(F, PB_, out, bx >> 2, bx & 3, (unsigned*)(F.ctl + CW_PROG));
#endif
            chain3(F, PB_, out, bx >> 2, bx & 3, wl); }
#ifdef HELPERS_OFF_CHAIN
            }
        else hw = (bx - NCH) * NWAVES + F.wave;
#else
            else hw = bx * (NWAVES - NCW) + F.wave - NCW; }
        else hw = NCH * (NWAVES - NCW) + (bx - NCH) * NWAVES + F.wave;
#endif
        if (hw >= 0) {
#ifndef P0LATE_IN_P0
            p0_late(F, I, ws, hw, nhw, 0, 1 << 30, 0, 1 << 30);
#endif
#ifdef PROBE_SAMPLE
            for (int rep = 0; rep < 2; ++rep)
#endif
            for (int item = hw; item < 1536 + 512; item += nhw) {
                if (item < 1536) attn_sample_item(F, I, ws, item, wl);
                else { const int q = item - 1536, n = q >> 4, h = q & 15; const float* sp = I.state_shift + (size_t)n * 3328 + h * 64 + F.lane;
                    scan_out<4>(F, I, ws, (size_t)(NTOK_P + n * 4), 4, h, I.state_wkv + (size_t)q * 4096, out + OFF_WKV_S + (size_t)q * 4096, sp[0], sp[1024], sp[2048], wl); }
            }

        }
        __syncthreads();
        gu32* queue = F.ctl + CW_QUEUE;
        for (;;) {
            if (F.tid == 0) F.MISC[16] = __hip_atomic_fetch_add(queue, 1u, RLX_AGENT);
            __syncthreads();
            const int unit = (int)F.MISC[16];
            __syncthreads();
            if (unit >= 1536) break;
            attn_prompt_unit(F, ws, unit);
        }
    }
    GRID_BAR();
    {
        if (F.G * NWAVES * 8 == NTOK_P) {
            const int c = bx & 7, j = bx >> 3, bb = c >> 2, ch = 32 * (c & 3) + j;
            wkv_finish_unit(F, I, ws, PB_, (bf16*)(ws + WS_RO), (bb * 16 + F.wave) * 128 + ch);
            wkv_finish_unit(F, I, ws, PB_, (bf16*)(ws + WS_RO), (bb * 16 + F.wave + 8) * 128 + ch);
        } else
        for (int i = bx * NWAVES + F.wave; i < NUNIT; i += F.G * NWAVES) {
            const int h = 8 * ((i >> 3) & 1) + (i & 7), rest = i >> 4, ch = rest & 127, bb = rest >> 7;
            wkv_finish_unit(F, I, ws, PB_, (bf16*)(ws + WS_RO), (bb * 16 + h) * 128 + ch);
        }
        p2d_attn_merge(F, ws);
    }
    GROUP_BAR();
    {
        pg8::Gemm g{(const bf16*)(ws + WS_RO), (const bf16*)(ws + WS_WBR), NTOK_P, DM, DM}; pg8::StaticOrder S; S.init(NTOK_P, DM, GP_G(3), GP_C(3));
        pg8::EpiGate<false> E{(bf16*)(ws + WS_MIX), Zb, ZGA};
        pg8::mini_gemm<pg8::EpiGate<false>, 1024>(wave_idx, F.lds + RING_OFF, g.A, g.Bt, g.N, NTOK_P, GP_C(3), GP_G(3), E);
        pg8::gemm_phase<pg8::EpiGate<false>, pg8::StaticOrder, true, true>(wave_idx, F.lds + RING_OFF, g, S, E);
    }
    VM_WAIT(); __syncthreads();
    {
        pg8::Gemm g{(const bf16*)(ws + WS_ATTN), (const bf16*)(ws + WS_WBA), NTOK_P, DM, 256}; pg8::StaticOrder S; S.init(NTOK_P, DM, GP_G(4), GP_C(4));
        pg8::EpiGate<true> E{(bf16*)(ws + WS_MIX), Zb, ZGB};
        pg8::mini_gemm<pg8::EpiGate<true>, 256>(wave_idx, F.lds + RING_OFF, g.A, g.Bt, g.N, NTOK_P, GP_C(4), GP_G(4), E);
        pg8::gemm_phase<pg8::EpiGate<true>, pg8::StaticOrder, true, true>(wave_idx, F.lds + RING_OFF, g, S, E);
    }
    GROUP_BAR();
    {
        pg8::Gemm g{(const bf16*)(ws + WS_MIX), (const bf16*)(ws + WS_WOUT), NTOK_P, DM, DM}; pg8::StaticOrder S; S.init(NTOK_P, DM, GP_G(5), GP_C(5));
        pg8::EpiRes<0> E{(bf16*)(ws + WS_X1B), ss1, I.x_prompt, I.x_sample};
        pg8::mini_gemm<pg8::EpiRes<0>, 1024>(wave_idx, F.lds + RING_OFF, g.A, g.Bt, g.N, NTOK_P, GP_C(5), GP_G(5), E);
        pg8::gemm_phase<pg8::EpiRes<0>, pg8::StaticOrder, true, true>(wave_idx, F.lds + RING_OFF, g, S, E);
    }
    GROUP_BAR();
    {
        pg8::Gemm g{(const bf16*)(ws + WS_X1B), (const bf16*)(ws + WS_WFF1), NTOK_P, DFF, DM}; pg8::StaticOrder S; S.init(NTOK_P, DFF, GP_G(6), GP_C(6));
        pg8::EpiFF1 E{(bf16*)(ws + WS_HDN), ss1};
        pg8::mini_gemm_nu<pg8::EpiFF1, 1024, 4>(wave_idx, F.lds + RING_OFF, g.A, g.Bt, g.N, NTOK_P, GP_C(6), GP_G(6), E);
        pg8::gemm_phase<pg8::EpiFF1, pg8::StaticOrder, true, true>(wave_idx, F.lds + RING_OFF, g, S, E);
#ifdef PROBE_P5
        VM_WAIT(); __syncthreads();
        pg8::gemm_phase<pg8::EpiFF1, pg8::StaticOrder, true, true>(wave_idx, F.lds + RING_OFF, g, S, E);
#endif
    }
    GROUP_BAR();
    {
        pg8::Gemm g{(const bf16*)(ws + WS_HDN), (const bf16*)(ws + WS_WFF2), NTOK_P, DM, DFF}; pg8::StaticOrder S; S.init(NTOK_P, DM, GP_G(7), GP_C(7));
        pg8::EpiRes<1> E{(bf16*)(ws + WS_X1B), ss2, nullptr, nullptr};
        pg8::mini_gemm<pg8::EpiRes<1>, 4096>(wave_idx, F.lds + RING_OFF, g.A, g.Bt, g.N, NTOK_P, GP_C(7), GP_G(7), E);
        pg8::gemm_phase<pg8::EpiRes<1>, pg8::StaticOrder, true, true>(wave_idx, F.lds + RING_OFF, g, S, E);
    }
    GROUP_BAR();
    {
        pg8::Gemm g{(const bf16*)(ws + WS_PB), (const bf16*)(ws + WS_WPLE), NTOK_P, DM, 256}; pg8::StaticOrder S; S.init(NTOK_P, DM, GP_G(8), GP_C(8));
        pg8::EpiT2 E{(bf16*)(ws + WS_T2)};
        pg8::mini_gemm<pg8::EpiT2, 256>(wave_idx, F.lds + RING_OFF, g.A, g.Bt, g.N, NTOK_P, GP_C(8), GP_G(8), E);
        pg8::gemm_phase<pg8::EpiT2, pg8::StaticOrder, true, true>(wave_idx, F.lds + RING_OFF, g, S, E);
    }
    VM_WAIT(); __syncthreads();
    {
        pg8::Gemm g{(const bf16*)(ws + WS_X1B), (const bf16*)(ws + WS_WPG), NTOK_P, DM, DM}; pg8::StaticOrder S; S.init(NTOK_P, DM, GP_G(9), GP_C(9));
        pg8::EpiPle E{(const bf16*)(ws + WS_X1B), (bf16*)(ws + WS_X1), (const bf16*)(ws + WS_T2), ss2, ss3};
        pg8::mini_gemm<pg8::EpiPle, 1024>(wave_idx, F.lds + RING_OFF, g.A, g.Bt, g.N, NTOK_P, GP_C(9), GP_G(9), E);
        if (F.G * 64 == NTOK_P) {
            auto grp_bar = [&]() { if (F.MISC[10] != 0u) xcd_local_barrier(bar, lbar, mk_tid(wave_idx)); else xcd_barrier(bar, mk_tid(wave_idx)); };
            pg8::EpiPleF<decltype(grp_bar)> EF{E, I.norm_final, out + OFF_Y_P, grp_bar};
            pg8::gemm_phase<pg8::EpiPleF<decltype(grp_bar)>, pg8::StaticOrder, true, true>(wave_idx, F.lds + RING_OFF, g, S, EF);
            { int t_ = mk_tid(wave_idx); asm volatile("" : "+v"(t_)); F.tid = t_; F.lane = t_ & 63; F.wave = wave_idx; }
            p8_final(F, I, ws, out, true);
        } else {
            pg8::gemm_phase<pg8::EpiPle, pg8::StaticOrder, true, true>(wave_idx, F.lds + RING_OFF, g, S, E);
            GROUP_BAR();
            p8_final(F, I, ws, out);
        }
    }
#ifdef PROBE_P8
    p8_final(F, I, ws, out);
#endif
#undef GRID_BAR
}

extern "C" void kernel_launch(void* const* d_in, const int* in_sizes, int n_in, void* d_out, int out_size, void* d_ws, size_t ws_size, hipStream_t stream) {
    static int grid = 0;
    if (grid == 0) {
        if (n_in != 32 || (size_t)out_size != OUT_TOTAL || ws_size < WS_END) { fprintf(stderr, "kernel_launch: unexpected shapes: n_in %d out %d ws %zu\n", n_in, out_size, ws_size); grid = -1; return; }
        int dev = 0, cus = 0, per_cu = 0;
        if (hipGetDevice(&dev) != hipSuccess || hipDeviceGetAttribute(&cus, hipDeviceAttributeMultiprocessorCount, dev) != hipSuccess) { fprintf(stderr, "kernel_launch: device query failed\n"); grid = -1; return; }
        if (hipFuncSetAttribute((const void*)mk_fwd, hipFuncAttributeMaxDynamicSharedMemorySize, LDS_BYTES) != hipSuccess) { fprintf(stderr, "kernel_launch: hipFuncSetAttribute failed\n"); grid = -1; return; }
        if (hipOccupancyMaxActiveBlocksPerMultiprocessor(&per_cu, (const void*)mk_fwd, NWAVES * 64, LDS_BYTES) != hipSuccess || per_cu < 1) { fprintf(stderr, "kernel_launch: occupancy query says %d blocks per CU\n", per_cu); per_cu = 1; }
        (void)hipGetLastError();
        grid = cus;
    }
    if (grid < 0) return;
    if (hipMemsetAsync((char*)d_ws + WS_CTL, 0, CTL_ZERO_BYTES, stream) != hipSuccess) { fprintf(stderr, "kernel_launch: memset failed\n"); return; }
    Args a{};
    const float** ip = (const float**)&a.in;
    for (int i = 0; i < 32; ++i) ip[i] = (const float*)d_in[i];
    a.out = (float*)d_out; a.ws = (unsigned char*)d_ws;
    void* kargs[] = {&a};
    hipError_t e = hipLaunchCooperativeKernel((const void*)mk_fwd, dim3(grid), dim3(NWAVES * 64), kargs, LDS_BYTES, stream);
    if (e != hipSuccess) fprintf(stderr, "kernel_launch: cooperative launch failed: %s (grid %d)\n", hipGetErrorString(e), grid);
}
```

```cpp
#include <hip/hip_runtime.h>
#include <cstdio>
#include <cstdint>
__device__ __forceinline__ int mk_lane_id() { unsigned z = 0u; asm volatile("" : "+v"(z)); return (int)__builtin_amdgcn_mbcnt_hi(0xffffffffu, __builtin_amdgcn_mbcnt_lo(0xffffffffu, z)); }
__device__ __forceinline__ int mk_tid(int wave) { return wave * 64 + mk_lane_id(); }
namespace pg8 {
#define PG8_LAS __attribute__((address_space(3)))
typedef unsigned short bf16_t;
typedef short bf16x8 __attribute__((ext_vector_type(8)));
typedef float f32x4 __attribute__((ext_vector_type(4)));
typedef unsigned u32x4 __attribute__((ext_vector_type(4)));
constexpr int BM = 256, BK = 64, HALF = 128, HTB = HALF * BK * 2  , STAGE_BYTES = 8 * HTB, NXCD = 8, WGM = 4, PRE_OFF = STAGE_BYTES + 4096  ;

__host__ __device__ __forceinline__ int lds_byte(int r, int c) { const int st = (r >> 4) * 2 + (c >> 5), rr = r & 15, cc = c & 31, ob = rr * 64 + cc * 2; return st * 1024 + (ob ^ (((ob >> 9) & 1) << 5)); }
__host__ __device__ __forceinline__ void stage_rc(int b, int& R, int& C) { const int st = b / 1024, sb = b % 1024, swz = sb ^ (((sb >> 9) & 1) << 5); R = (st >> 1) * 16 + swz / 64; C = (st & 1) * 32 + (swz % 64) / 2; }
__host__ __device__ __forceinline__ int perm32(int rho) { const int n = rho >> 4, i = rho & 15; return 8 * (i >> 2) + 4 * n + (i & 3); }

struct Unit { int pm, pn; };
struct Gemm { const bf16_t* A; const bf16_t* Bt; int M, N, K; };

struct StaticOrder {
    int nM, nN, nwg, G, c;
    __host__ __device__ void init(int M, int N, int G_, int c_) { nM = M / BM; nN = N / BM; nwg = nM * nN; G = G_; c = c_; }
    __host__ __device__ bool next(int i, Unit& u) const {
        const long L = (long)i * G + c; if (L >= nwg) return false;
        int wgid = (int)L; { const int q = nwg / NXCD, r = nwg % NXCD, xcd = wgid % NXCD, off = wgid / NXCD; wgid = (xcd < r ? xcd * (q + 1) : r * (q + 1) + (xcd - r) * q) + off; }
        const int nig = WGM * nN, gid = wgid / nig, fm = gid * WGM, gsz = (nM - fm) < WGM ? (nM - fm) : WGM;
        u.pm = fm + ((wgid % nig) % gsz); u.pn = (wgid % nig) / gsz; return true;
    }
    __device__ __forceinline__ void a_ready(const Unit&) const {}
    __device__ __forceinline__ void done(const Unit&) const {}
};
struct StaticOrderX {
    StaticOrder base; int nN, nbase, nextra, G, c;
    __host__ __device__ void init(int Mmain, int N, int G_, int c_) { base.init(Mmain, N, G_, c_); nN = N / BM; nbase = base.nwg; nextra = nN; G = G_; c = c_; }
    __host__ __device__ bool next(int i, Unit& u) const {
        const long L = (long)i * G + c;
        if (L < nbase) return base.next(i, u);
        if (L < nbase + nextra) { u.pm = base.nM; u.pn = (int)(L - nbase); return true; }
        return false;
    }
    __device__ __forceinline__ void a_ready(const Unit&) const {}
    __device__ __forceinline__ void done(const Unit&) const {}
};

__device__ __forceinline__ unsigned cvt_pk_bf16(float lo, float hi) { unsigned r; asm volatile("v_cvt_pk_bf16_f32 %0, %1, %2" : "=v"(r) : "v"(lo), "v"(hi)); return r; }
typedef float f32x2 __attribute__((ext_vector_type(2)));
typedef unsigned u32x2 __attribute__((ext_vector_type(2)));
__device__ __forceinline__ float bf_lo(unsigned w) { return __uint_as_float(w << 16); }
__device__ __forceinline__ float bf_hi(unsigned w) { return __uint_as_float(w & 0xffff0000u); }
__device__ __forceinline__ float sigmoidf_(float x) { return __builtin_amdgcn_rcpf(1.0f + __expf(-x)); }

constexpr int NTOK_P = 16384, NTOK = 16512, MPAD = 16640, ZC = 7680;
constexpr size_t OFF_Y_P = 0, OFF_Y_S = 16777216, OFF_KVP0 = 16908288, OFF_KVP1 = 17039360, OFF_KVP2 = 17563648, OFF_WKV_P = 19660800, OFF_SHIFT_P = 19791872,
                 OFF_KVS0 = 19798528, OFF_KVS1 = 19864064, OFF_KVS2 = 19929600, OFF_WKV_S = 19995136, OFF_SHIFT_S = 22092288, OUT_TOTAL = 22198784;

struct EpiZ {
    static constexpr bool PERM = true, AFTER_DRAIN = false; static constexpr int NPRE = 8;
    bf16_t* Z; const float* rstd0; float* out;
    __device__ __forceinline__ const float* pre_base(const Unit& u, int wr) const { return rstd0 + u.pm * BM + wr * 64; }
    __device__ __forceinline__ void operator()(const f32x4 (&acc)[2][2][4][2], const Unit& u, int wr, int wc, int fr, int fq, const PG8_LAS float* pre) const {
        const int pn = u.pn, pm = u.pm;
#pragma unroll
        for (int ai = 0; ai < 2; ++ai)
#pragma unroll
            for (int m = 0; m < 4; ++m) {
                const int row = pm * BM + ai * HALF + wr * 64 + m * 16 + fr;
                const float rs = pre[ai * 64 + m * 16 + fr];
                bf16_t* zrow = Z + (size_t)row * ZC;
#pragma unroll
                for (int bj = 0; bj < 2; ++bj) {
                    const int col = pn * BM + bj * HALF + wc * 32 + 8 * fq;
                    const f32x4 v0 = acc[ai][bj][m][0] * rs, v1 = acc[ai][bj][m][1] * rs;
                    u32x4 w; w.x = cvt_pk_bf16(v0[0], v0[1]); w.y = cvt_pk_bf16(v0[2], v0[3]); w.z = cvt_pk_bf16(v1[0], v1[1]); w.w = cvt_pk_bf16(v1[2], v1[3]);
                    *(u32x4*)(zrow + col) = w;
                }
            }
    }
};

struct EpiLora {
    static constexpr bool PERM = true, AFTER_DRAIN = false; static constexpr int NPRE = 0;
    bf16_t* LW; bf16_t* AA; bf16_t* GG; const float* w0; const float* a0;
    __device__ __forceinline__ void operator()(const f32x4 (&acc)[2][2][4][2], const Unit& u, int wr, int wc, int fr, int fq) const {
        const int pn = u.pn;
        if (pn < 4) {
#pragma unroll
            for (int ai = 0; ai < 2; ++ai)
#pragma unroll
                for (int m = 0; m < 4; ++m) {
                    const int row = u.pm * BM + ai * HALF + wr * 64 + m * 16 + fr;
#pragma unroll
                    for (int bj = 0; bj < 2; ++bj) {
                        const int col = pn * BM + bj * HALF + wc * 32 + 8 * fq;
                        f32x4 v0 = acc[ai][bj][m][0], v1 = acc[ai][bj][m][1];
                        const f32x4 b0 = *(const f32x4*)(w0 + col), b1 = *(const f32x4*)(w0 + col + 4);
#pragma unroll
                        for (int i = 0; i < 4; ++i) { v0[i] = -0.60653065971f * sigmoidf_(v0[i] + b0[i]); v1[i] = -0.60653065971f * sigmoidf_(v1[i] + b1[i]); }
                        u32x4 w; w.x = cvt_pk_bf16(v0[0], v0[1]); w.y = cvt_pk_bf16(v0[2], v0[3]); w.z = cvt_pk_bf16(v1[0], v1[1]); w.w = cvt_pk_bf16(v1[2], v1[3]);
                        *(u32x4*)(LW + (size_t)row * 1024 + col) = w;
                    }
                }
        } else if (pn < 8) {
#pragma unroll
            for (int ai = 0; ai < 2; ++ai)
#pragma unroll
                for (int m = 0; m < 4; ++m) {
                    const int row = u.pm * BM + ai * HALF + wr * 64 + m * 16 + fr;
#pragma unroll
                    for (int bj = 0; bj < 2; ++bj) {
                        const int col = (pn - 4) * BM + bj * HALF + wc * 32 + 8 * fq;
                        f32x4 v0 = acc[ai][bj][m][0], v1 = acc[ai][bj][m][1];
                        const f32x4 b0 = *(const f32x4*)(a0 + col), b1 = *(const f32x4*)(a0 + col + 4);
#pragma unroll
                        for (int i = 0; i < 4; ++i) { v0[i] = sigmoidf_(v0[i] + b0[i]); v1[i] = sigmoidf_(v1[i] + b1[i]); }
                        u32x4 w; w.x = cvt_pk_bf16(v0[0], v0[1]); w.y = cvt_pk_bf16(v0[2], v0[3]); w.z = cvt_pk_bf16(v1[0], v1[1]); w.w = cvt_pk_bf16(v1[2], v1[3]);
                        *(u32x4*)(AA + (size_t)row * 1024 + col) = w;
                    }
                }
        } else {
#pragma unroll
            for (int ai = 0; ai < 2; ++ai)
#pragma unroll
                for (int m = 0; m < 4; ++m) {
                    const int row = u.pm * BM + ai * HALF + wr * 64 + m * 16 + fr;
#pragma unroll
                    for (int bj = 0; bj < 2; ++bj) {
                        const int col = (pn - 8) * BM + bj * HALF + wc * 32 + 8 * fq;
                        const f32x4 v0 = acc[ai][bj][m][0], v1 = acc[ai][bj][m][1];
                        u32x4 w; w.x = cvt_pk_bf16(v0[0], v0[1]); w.y = cvt_pk_bf16(v0[2], v0[3]); w.z = cvt_pk_bf16(v1[0], v1[1]); w.w = cvt_pk_bf16(v1[2], v1[3]);
                        *(u32x4*)(GG + (size_t)row * 1024 + col) = w;
                    }
                }
        }
    }
    __device__ __forceinline__ void mini(int row, int col, f32x4 v0, f32x4 v1, int lane) const {
        const int blk = col >> 10, c = col & 1023;
        if (blk < 2) {
            const long long boff = blk == 0 ? 0ll : (long long)((const char*)a0 - (const char*)w0);
            const float* bp = (const float*)((const char*)w0 + boff) + c;
            const f32x4 b0 = *(const f32x4*)bp, b1 = *(const f32x4*)(bp + 4);
            const float sc = blk == 0 ? -0.60653065971f : 1.0f;
#pragma unroll
            for (int i = 0; i < 4; ++i) { v0[i] = sc * sigmoidf_(v0[i] + b0[i]); v1[i] = sc * sigmoidf_(v1[i] + b1[i]); }
        }
        u32x4 w; w.x = cvt_pk_bf16(v0[0], v0[1]); w.y = cvt_pk_bf16(v0[2], v0[3]); w.z = cvt_pk_bf16(v1[0], v1[1]); w.w = cvt_pk_bf16(v1[2], v1[3]);
        const long long ooff = blk == 0 ? 0ll : (blk == 1 ? (long long)((const char*)AA - (const char*)LW) : (long long)((const char*)GG - (const char*)LW));
        *(u32x4*)((char*)LW + ooff + ((size_t)row * 1024 + c) * 2) = w;
    }
};

template <bool ADD> struct EpiGate {
    static constexpr bool PERM = true, AFTER_DRAIN = false; static constexpr int NPRE = 0;
    bf16_t* MIX; const bf16_t* Z; int gate_off;
    __device__ __forceinline__ void operator()(const f32x4 (&acc)[2][2][4][2], const Unit& u, int wr, int wc, int fr, int fq) const {
#pragma unroll
        for (int ai = 0; ai < 2; ++ai) {
            u32x4 gz[4][2], mo[4][2];
#pragma unroll
            for (int m = 0; m < 4; ++m)
#pragma unroll
                for (int bj = 0; bj < 2; ++bj) {
                    const int row = u.pm * BM + ai * HALF + wr * 64 + m * 16 + fr, col = u.pn * BM + bj * HALF + wc * 32 + 8 * fq;
                    gz[m][bj] = *(const u32x4*)(Z + (size_t)row * ZC + gate_off + col);
                    if (ADD) mo[m][bj] = *(const u32x4*)(MIX + (size_t)row * 1024 + col);
                }
#pragma unroll
            for (int m = 0; m < 4; ++m)
#pragma unroll
                for (int bj = 0; bj < 2; ++bj) {
                    const int row = u.pm * BM + ai * HALF + wr * 64 + m * 16 + fr, col = u.pn * BM + bj * HALF + wc * 32 + 8 * fq;
                    const u32x4 g = gz[m][bj];
                    f32x4 v0 = acc[ai][bj][m][0], v1 = acc[ai][bj][m][1];
                    v0[0] *= sigmoidf_(bf_lo(g.x)); v0[1] *= sigmoidf_(bf_hi(g.x)); v0[2] *= sigmoidf_(bf_lo(g.y)); v0[3] *= sigmoidf_(bf_hi(g.y));
                    v1[0] *= sigmoidf_(bf_lo(g.z)); v1[1] *= sigmoidf_(bf_hi(g.z)); v1[2] *= sigmoidf_(bf_lo(g.w)); v1[3] *= sigmoidf_(bf_hi(g.w));
                    if (ADD) { const u32x4 o = mo[m][bj];
                        v0[0] += bf_lo(o.x); v0[1] += bf_hi(o.x); v0[2] += bf_lo(o.y); v0[3] += bf_hi(o.y);
                        v1[0] += bf_lo(o.z); v1[1] += bf_hi(o.z); v1[2] += bf_lo(o.w); v1[3] += bf_hi(o.w); }
                    u32x4 w; w.x = cvt_pk_bf16(v0[0], v0[1]); w.y = cvt_pk_bf16(v0[2], v0[3]); w.z = cvt_pk_bf16(v1[0], v1[1]); w.w = cvt_pk_bf16(v1[2], v1[3]);
                    *(u32x4*)(MIX + (size_t)row * 1024 + col) = w;
                }
        }
    }
    __device__ __forceinline__ void mini(int row, int col, f32x4 v0, f32x4 v1, int lane) const {
        const u32x4 gz = *(const u32x4*)(Z + (size_t)row * ZC + gate_off + col);
        v0[0] *= sigmoidf_(bf_lo(gz.x)); v0[1] *= sigmoidf_(bf_hi(gz.x)); v0[2] *= sigmoidf_(bf_lo(gz.y)); v0[3] *= sigmoidf_(bf_hi(gz.y));
        v1[0] *= sigmoidf_(bf_lo(gz.z)); v1[1] *= sigmoidf_(bf_hi(gz.z)); v1[2] *= sigmoidf_(bf_lo(gz.w)); v1[3] *= sigmoidf_(bf_hi(gz.w));
        bf16_t* d = MIX + (size_t)row * 1024 + col;
        if (ADD) { const u32x4 o = *(const u32x4*)d;
            v0[0] += bf_lo(o.x); v0[1] += bf_hi(o.x); v0[2] += bf_lo(o.y); v0[3] += bf_hi(o.y);
            v1[0] += bf_lo(o.z); v1[1] += bf_hi(o.z); v1[2] += bf_lo(o.w); v1[3] += bf_hi(o.w); }
        u32x4 w; w.x = cvt_pk_bf16(v0[0], v0[1]); w.y = cvt_pk_bf16(v0[2], v0[3]); w.z = cvt_pk_bf16(v1[0], v1[1]); w.w = cvt_pk_bf16(v1[2], v1[3]);
        *(u32x4*)d = w;
    }
};

template <int SRC> struct EpiRes {
    static constexpr bool PERM = true, AFTER_DRAIN = false; static constexpr int NPRE = 0;
    bf16_t* XB; float* ss; const float* xp; const float* xs;
    __device__ __forceinline__ float core(int row, int col, f32x4 v0, f32x4 v1) const {
        bf16_t* d = XB + (size_t)row * 1024 + col;
        if (SRC == 0) { const float* brow = (row < NTOK_P ? xp + (size_t)row * 1024 : xs + (size_t)(row - NTOK_P) * 1024) + col; v0 += *(const f32x4*)brow; v1 += *(const f32x4*)(brow + 4); }
        else { const u32x4 o = *(const u32x4*)d; v0[0] += bf_lo(o.x); v0[1] += bf_hi(o.x); v0[2] += bf_lo(o.y); v0[3] += bf_hi(o.y); v1[0] += bf_lo(o.z); v1[1] += bf_hi(o.z); v1[2] += bf_lo(o.w); v1[3] += bf_hi(o.w); }
        u32x4 w; w.x = cvt_pk_bf16(v0[0], v0[1]); w.y = cvt_pk_bf16(v0[2], v0[3]); w.z = cvt_pk_bf16(v1[0], v1[1]); w.w = cvt_pk_bf16(v1[2], v1[3]);
        *(u32x4*)d = w;
        return ((v0[0] * v0[0] + v0[1] * v0[1]) + (v0[2] * v0[2] + v0[3] * v0[3])) + ((v1[0] * v1[0] + v1[1] * v1[1]) + (v1[2] * v1[2] + v1[3] * v1[3]));
    }
    __device__ __forceinline__ void operator()(const f32x4 (&acc)[2][2][4][2], const Unit& u, int wr, int wc, int fr, int fq) const {
#pragma unroll
        for (int ai = 0; ai < 2; ++ai) {
            f32x4 b0[4][2], b1[4][2];
#pragma unroll
            for (int m = 0; m < 4; ++m)
#pragma unroll
                for (int bj = 0; bj < 2; ++bj) {
                    const int row = u.pm * BM + ai * HALF + wr * 64 + m * 16 + fr, col = u.pn * BM + bj * HALF + wc * 32 + 8 * fq;
                    if (SRC == 0) { const float* brow = (row < NTOK_P ? xp + (size_t)row * 1024 : xs + (size_t)(row - NTOK_P) * 1024) + col; b0[m][bj] = *(const f32x4*)brow; b1[m][bj] = *(const f32x4*)(brow + 4); }
                    else { const u32x4 o = *(const u32x4*)(XB + (size_t)row * 1024 + col); b0[m][bj] = __builtin_bit_cast(f32x4, o); }
                }
#pragma unroll
            for (int m = 0; m < 4; ++m) {
                const int row = u.pm * BM + ai * HALF + wr * 64 + m * 16 + fr;
                float q = 0.f;
#pragma unroll
                for (int bj = 0; bj < 2; ++bj) {
                    const int col = u.pn * BM + bj * HALF + wc * 32 + 8 * fq;
                    f32x4 v0 = acc[ai][bj][m][0], v1 = acc[ai][bj][m][1];
                    if (SRC == 0) { v0 += b0[m][bj]; v1 += b1[m][bj]; }
                    else { const u32x4 o = __builtin_bit_cast(u32x4, b0[m][bj]); v0[0] += bf_lo(o.x); v0[1] += bf_hi(o.x); v0[2] += bf_lo(o.y); v0[3] += bf_hi(o.y); v1[0] += bf_lo(o.z); v1[1] += bf_hi(o.z); v1[2] += bf_lo(o.w); v1[3] += bf_hi(o.w); }
                    u32x4 w; w.x = cvt_pk_bf16(v0[0], v0[1]); w.y = cvt_pk_bf16(v0[2], v0[3]); w.z = cvt_pk_bf16(v1[0], v1[1]); w.w = cvt_pk_bf16(v1[2], v1[3]);
                    *(u32x4*)(XB + (size_t)row * 1024 + col) = w;
                    q += ((v0[0] * v0[0] + v0[1] * v0[1]) + (v0[2] * v0[2] + v0[3] * v0[3])) + ((v1[0] * v1[0] + v1[1] * v1[1]) + (v1[2] * v1[2] + v1[3] * v1[3]));
                }
                q += __shfl_xor(q, 16); q += __shfl_xor(q, 32);
                if (fq == 0) atomicAdd(ss + row, q);
            }
        }
    }
    __device__ __forceinline__ void mini(int row, int col, f32x4 v0, f32x4 v1, int lane) const {
        float q = core(row, col, v0, v1);
        q += __shfl_xor(q, 1); q += __shfl_xor(q, 2);
        if ((lane & 3) == 0) atomicAdd(ss + row, q);
    }
};

struct EpiFF1 {
    static constexpr bool PERM = true, AFTER_DRAIN = false; static constexpr int NPRE = 8;
    bf16_t* H; const float* ss;
    __device__ __forceinline__ const float* pre_base(const Unit& u, int wr) const { return ss + u.pm * BM + wr * 64; }
    __device__ __forceinline__ void operator()(const f32x4 (&acc)[2][2][4][2], const Unit& u, int wr, int wc, int fr, int fq, const PG8_LAS float* pre) const {
#pragma unroll
        for (int ai = 0; ai < 2; ++ai)
#pragma unroll
            for (int m = 0; m < 4; ++m) {
                const int row = u.pm * BM + ai * HALF + wr * 64 + m * 16 + fr;
                const float rs = __builtin_amdgcn_rsqf(pre[ai * 64 + m * 16 + fr] * (1.0f / 1024.0f) + 1e-6f);
#pragma unroll
                for (int bj = 0; bj < 2; ++bj) {
                    const int col = u.pn * BM + bj * HALF + wc * 32 + 8 * fq;
                    f32x4 v0 = acc[ai][bj][m][0] * rs, v1 = acc[ai][bj][m][1] * rs;
#pragma unroll
                    for (int i = 0; i < 4; ++i) { const float a = fmaxf(v0[i], 0.f), b = fmaxf(v1[i], 0.f); v0[i] = a * a; v1[i] = b * b; }
                    u32x4 w; w.x = cvt_pk_bf16(v0[0], v0[1]); w.y = cvt_pk_bf16(v0[2], v0[3]); w.z = cvt_pk_bf16(v1[0], v1[1]); w.w = cvt_pk_bf16(v1[2], v1[3]);
                    *(u32x4*)(H + (size_t)row * 4096 + col) = w;
                }
            }
    }
    __device__ __forceinline__ void mini(int row, int col, f32x4 v0, f32x4 v1, int lane) const {
        const float rs = __builtin_amdgcn_rsqf(ss[row] * (1.0f / 1024.0f) + 1e-6f);
        v0 = v0 * rs; v1 = v1 * rs;
#pragma unroll
        for (int i = 0; i < 4; ++i) { const float a = fmaxf(v0[i], 0.f), b = fmaxf(v1[i], 0.f); v0[i] = a * a; v1[i] = b * b; }
        u32x4 w; w.x = cvt_pk_bf16(v0[0], v0[1]); w.y = cvt_pk_bf16(v0[2], v0[3]); w.z = cvt_pk_bf16(v1[0], v1[1]); w.w = cvt_pk_bf16(v1[2], v1[3]);
        *(u32x4*)(H + (size_t)row * 4096 + col) = w;
    }
};

struct EpiT2 {
    static constexpr bool PERM = true, AFTER_DRAIN = false; static constexpr int NPRE = 0;
    bf16_t* T2;
    __device__ __forceinline__ void core(int row, int col, f32x4 v0, f32x4 v1) const {
        u32x4 w; w.x = cvt_pk_bf16(v0[0], v0[1]); w.y = cvt_pk_bf16(v0[2], v0[3]); w.z = cvt_pk_bf16(v1[0], v1[1]); w.w = cvt_pk_bf16(v1[2], v1[3]);
        *(u32x4*)(T2 + (size_t)row * 1024 + col) = w;
    }
    __device__ __forceinline__ void operator()(const f32x4 (&acc)[2][2][4][2], const Unit& u, int wr, int wc, int fr, int fq) const {
#pragma unroll
        for (int ai = 0; ai < 2; ++ai)
#pragma unroll
            for (int m = 0; m < 4; ++m) {
                const int row = u.pm * BM + ai * HALF + wr * 64 + m * 16 + fr;
#pragma unroll
                for (int bj = 0; bj < 2; ++bj) core(row, u.pn * BM + bj * HALF + wc * 32 + 8 * fq, acc[ai][bj][m][0], acc[ai][bj][m][1]);
            }
    }
    __device__ __forceinline__ void mini(int row, int col, f32x4 v0, f32x4 v1, int lane) const { core(row, col, v0, v1); }
};

struct EpiPle {
    static constexpr bool PERM = true, AFTER_DRAIN = false; static constexpr int NPRE = 0;
    const bf16_t* XB; bf16_t* X3; const bf16_t* T2; const float* ss2; float* ss3;
    __device__ __forceinline__ float core(int row, int col, f32x4 v0, f32x4 v1, float rs) const {
        const u32x4 t = *(const u32x4*)(T2 + (size_t)row * 1024 + col), b = *(const u32x4*)(XB + (size_t)row * 1024 + col);
        v0 = v0 * rs; v1 = v1 * rs;
        f32x4 a0, a1;
        a0[0] = bf_lo(b.x) + sigmoidf_(v0[0]) * bf_lo(t.x); a0[1] = bf_hi(b.x) + sigmoidf_(v0[1]) * bf_hi(t.x); a0[2] = bf_lo(b.y) + sigmoidf_(v0[2]) * bf_lo(t.y); a0[3] = bf_hi(b.y) + sigmoidf_(v0[3]) * bf_hi(t.y);
        a1[0] = bf_lo(b.z) + sigmoidf_(v1[0]) * bf_lo(t.z); a1[1] = bf_hi(b.z) + sigmoidf_(v1[1]) * bf_hi(t.z); a1[2] = bf_lo(b.w) + sigmoidf_(v1[2]) * bf_lo(t.w); a1[3] = bf_hi(b.w) + sigmoidf_(v1[3]) * bf_hi(t.w);
        u32x4 w; w.x = cvt_pk_bf16(a0[0], a0[1]); w.y = cvt_pk_bf16(a0[2], a0[3]); w.z = cvt_pk_bf16(a1[0], a1[1]); w.w = cvt_pk_bf16(a1[2], a1[3]);
        *(u32x4*)(X3 + (size_t)row * 1024 + col) = w;
        return ((a0[0] * a0[0] + a0[1] * a0[1]) + (a0[2] * a0[2] + a0[3] * a0[3])) + ((a1[0] * a1[0] + a1[1] * a1[1]) + (a1[2] * a1[2] + a1[3] * a1[3]));
    }
    __device__ __forceinline__ void operator()(const f32x4 (&acc)[2][2][4][2], const Unit& u, int wr, int wc, int fr, int fq) const {
#pragma unroll
        for (int ai = 0; ai < 2; ++ai)
#pragma unroll
            for (int m = 0; m < 4; ++m) {
                const int row = u.pm * BM + ai * HALF + wr * 64 + m * 16 + fr;
                const float rs = __builtin_amdgcn_rsqf(ss2[row] * (1.0f / 1024.0f) + 1e-6f);
                float q = 0.f;
#pragma unroll
                for (int bj = 0; bj < 2; ++bj) q += core(row, u.pn * BM + bj * HALF + wc * 32 + 8 * fq, acc[ai][bj][m][0], acc[ai][bj][m][1], rs);
                q += __shfl_xor(q, 16); q += __shfl_xor(q, 32);
                if (fq == 0) atomicAdd(ss3 + row, q);
            }
    }
    __device__ __forceinline__ void mini(int row, int col, f32x4 v0, f32x4 v1, int lane) const {
        const float rs = __builtin_amdgcn_rsqf(ss2[row] * (1.0f / 1024.0f) + 1e-6f);
        float q = core(row, col, v0, v1, rs);
        q += __shfl_xor(q, 1); q += __shfl_xor(q, 2);
        if ((lane & 3) == 0) atomicAdd(ss3 + row, q);
    }
};

template <class BarFn>
struct EpiPleF {
    static constexpr bool PERM = true, AFTER_DRAIN = true; static constexpr int NPRE = 0;
    EpiPle base; const float* nfin; float* yout; const BarFn& barrier;
    __device__ __forceinline__ void fused(f32x4 (&acc)[2][2][4][2], const Unit& u, int wr, int wc, int fr, int fq, PG8_LAS unsigned char*, int, int) const {
#pragma unroll
        for (int ai = 0; ai < 2; ++ai)
#pragma unroll
            for (int m = 0; m < 4; ++m) {
                const int row = u.pm * BM + ai * HALF + wr * 64 + m * 16 + fr;
                const float rs = __builtin_amdgcn_rsqf(base.ss2[row] * (1.0f / 1024.0f) + 1e-6f);
                float q = 0.f;
#pragma unroll
                for (int bj = 0; bj < 2; ++bj) {
                    const int col = u.pn * BM + bj * HALF + wc * 32 + 8 * fq;
                    const u32x4 t = *(const u32x4*)(base.T2 + (size_t)row * 1024 + col), b = *(const u32x4*)(base.XB + (size_t)row * 1024 + col);
                    const f32x4 v0 = acc[ai][bj][m][0] * rs, v1 = acc[ai][bj][m][1] * rs;
                    f32x4 a0, a1;
                    a0[0] = bf_lo(b.x) + sigmoidf_(v0[0]) * bf_lo(t.x); a0[1] = bf_hi(b.x) + sigmoidf_(v0[1]) * bf_hi(t.x); a0[2] = bf_lo(b.y) + sigmoidf_(v0[2]) * bf_lo(t.y); a0[3] = bf_hi(b.y) + sigmoidf_(v0[3]) * bf_hi(t.y);
                    a1[0] = bf_lo(b.z) + sigmoidf_(v1[0]) * bf_lo(t.z); a1[1] = bf_hi(b.z) + sigmoidf_(v1[1]) * bf_hi(t.z); a1[2] = bf_lo(b.w) + sigmoidf_(v1[2]) * bf_lo(t.w); a1[3] = bf_hi(b.w) + sigmoidf_(v1[3]) * bf_hi(t.w);
                    acc[ai][bj][m][0] = a0; acc[ai][bj][m][1] = a1;
                    q += ((a0[0] * a0[0] + a0[1] * a0[1]) + (a0[2] * a0[2] + a0[3] * a0[3])) + ((a1[0] * a1[0] + a1[1] * a1[1]) + (a1[2] * a1[2] + a1[3] * a1[3]));
                }
                q += __shfl_xor(q, 16); q += __shfl_xor(q, 32);
                if (fq == 0) atomicAdd(base.ss3 + row, q);
            }
        barrier();
        f32x4 nf[2][2];
#pragma unroll
        for (int bj = 0; bj < 2; ++bj) { const int col = u.pn * BM + bj * HALF + wc * 32 + 8 * fq; nf[bj][0] = *(const f32x4*)(nfin + col); nf[bj][1] = *(const f32x4*)(nfin + col + 4); }
#pragma unroll
        for (int ai = 0; ai < 2; ++ai)
#pragma unroll
            for (int m = 0; m < 4; ++m) {
                const int row = u.pm * BM + ai * HALF + wr * 64 + m * 16 + fr;
                const float r3 = 1.0f / sqrtf(base.ss3[row] * (1.0f / 1024.0f) + 1e-6f);
#pragma unroll
                for (int bj = 0; bj < 2; ++bj) {
                    float* yp = yout + (size_t)row * 1024 + u.pn * BM + bj * HALF + wc * 32 + 8 * fq;
                    *(f32x4*)yp = acc[ai][bj][m][0] * r3 * nf[bj][0]; *(f32x4*)(yp + 4) = acc[ai][bj][m][1] * r3 * nf[bj][1];
                }
            }
    }
    __device__ __forceinline__ void mini(int row, int col, f32x4 v0, f32x4 v1, int lane) const { base.mini(row, col, v0, v1, lane); }
};

template <class Epi, int KT, int NU>
__device__ __forceinline__ void mini_gemm_nu(int wave_idx, PG8_LAS unsigned char* lds, const bf16_t* A, const bf16_t* Bt, int N, int row_base, int first, int stride, const Epi& E) {
    int tid_ = mk_tid(wave_idx); asm volatile("" : "+v"(tid_));
    const int tid = tid_, w = __builtin_amdgcn_readfirstlane(tid >> 6), lane = tid & 63, r = lane & 15, q = lane >> 4;
    constexpr int KW = KT / 8, NKS = KW / 32, NBK = (NU * NKS <= 8) ? NKS : (8 / NU >= 1 ? 8 / NU : 1);
    static_assert(NKS % NBK == 0, "mini_gemm_nu: batch must divide the k-steps");
    PG8_LAS float* red = (PG8_LAS float*)lds;
    const int nunits = (N / 32) * 8;
    for (int u0 = first; u0 < nunits; u0 += NU * stride) {
        f32x4 acc0[NU], acc1[NU];
#pragma unroll
        for (int j = 0; j < NU; ++j) { acc0[j] = (f32x4){0.f, 0.f, 0.f, 0.f}; acc1[j] = (f32x4){0.f, 0.f, 0.f, 0.f}; }
#pragma unroll
        for (int k0 = 0; k0 < NKS; k0 += NBK) {
            bf16x8 af[NU][NBK], b0[NU][NBK], b1[NU][NBK];
#pragma unroll
            for (int j = 0; j < NU; ++j) { const int u = u0 + j * stride;
                if (u < nunits) { const int n0 = (u >> 3) * 32, r0 = row_base + 16 * (u & 7);
                    const bf16_t* ap = A + (size_t)(r0 + r) * KT + w * KW + 8 * q; const bf16_t* bp = Bt + (size_t)(n0 + r) * KT + w * KW + 8 * q;
#pragma unroll
                    for (int i = 0; i < NBK; ++i) { af[j][i] = *(const bf16x8*)(ap + 32 * (k0 + i)); b0[j][i] = *(const bf16x8*)(bp + 32 * (k0 + i)); b1[j][i] = *(const bf16x8*)(bp + (size_t)16 * KT + 32 * (k0 + i)); } } }
#pragma unroll
            for (int j = 0; j < NU; ++j) { if (u0 + j * stride < nunits) {
#pragma unroll
                for (int i = 0; i < NBK; ++i) { acc0[j] = __builtin_amdgcn_mfma_f32_16x16x32_bf16(af[j][i], b0[j][i], acc0[j], 0, 0, 0); acc1[j] = __builtin_amdgcn_mfma_f32_16x16x32_bf16(af[j][i], b1[j][i], acc1[j], 0, 0, 0); } } }
        }
#pragma unroll
        for (int j = 0; j < NU; ++j) { if (u0 + j * stride < nunits) {
#pragma unroll
            for (int rg = 0; rg < 4; ++rg) { red[((j * 8 + w) * 16 + 4 * q + rg) * 32 + r] = acc0[j][rg]; red[((j * 8 + w) * 16 + 4 * q + rg) * 32 + 16 + r] = acc1[j][rg]; } } }
        __syncthreads();
        if (w < NU && u0 + w * stride < nunits) {
            const int u = u0 + w * stride, n0 = (u >> 3) * 32, r0 = row_base + 16 * (u & 7);
            const int row = lane >> 2, c8 = (lane & 3) * 8;
            f32x4 v0 = (f32x4){0.f, 0.f, 0.f, 0.f}, v1 = (f32x4){0.f, 0.f, 0.f, 0.f};
#pragma unroll
            for (int ww = 0; ww < 8; ++ww) { const PG8_LAS f32x4* p = (const PG8_LAS f32x4*)(red + ((w * 8 + ww) * 16 + row) * 32 + c8); v0 += p[0]; v1 += p[1]; }
            E.mini(r0 + row, n0 + c8, v0, v1, lane);
        }
        __syncthreads();
    }
}
template <class Epi, int KT>
__device__ __forceinline__ void mini_gemm(int wave_idx, PG8_LAS unsigned char* lds, const bf16_t* A, const bf16_t* Bt, int N, int row_base, int first, int stride, const Epi& E) {
    int tid_ = mk_tid(wave_idx); asm volatile("" : "+v"(tid_));
    const int tid = tid_, w = __builtin_amdgcn_readfirstlane(tid >> 6), lane = tid & 63, r = lane & 15, q = lane >> 4;
    constexpr int KW = KT / 8, NKS = KW / 32, NB = NKS < 8 ? NKS : 8;
    PG8_LAS float* red = (PG8_LAS float*)lds;
    const int nunits = (N / 32) * 8;
    for (int u = first; u < nunits; u += stride) {
        const int n0 = (u >> 3) * 32, r0 = row_base + 16 * (u & 7);
        f32x4 acc0 = (f32x4){0.f, 0.f, 0.f, 0.f}, acc1 = (f32x4){0.f, 0.f, 0.f, 0.f};
        const bf16_t* ap = A + (size_t)(r0 + r) * KT + w * KW + 8 * q;
        const bf16_t* bp = Bt + (size_t)(n0 + r) * KT + w * KW + 8 * q;
#pragma unroll
        for (int k0 = 0; k0 < NKS; k0 += NB) {
            bf16x8 af[NB], b0[NB], b1[NB];
#pragma unroll
            for (int i = 0; i < NB; ++i) { af[i] = *(const bf16x8*)(ap + 32 * (k0 + i)); b0[i] = *(const bf16x8*)(bp + 32 * (k0 + i)); b1[i] = *(const bf16x8*)(bp + (size_t)16 * KT + 32 * (k0 + i)); }
#pragma unroll
            for (int i = 0; i < NB; ++i) { acc0 = __builtin_amdgcn_mfma_f32_16x16x32_bf16(af[i], b0[i], acc0, 0, 0, 0); acc1 = __builtin_amdgcn_mfma_f32_16x16x32_bf16(af[i], b1[i], acc1, 0, 0, 0); }
        }
#pragma unroll
        for (int rg = 0; rg < 4; ++rg) { red[(w * 16 + 4 * q + rg) * 32 + r] = acc0[rg]; red[(w * 16 + 4 * q + rg) * 32 + 16 + r] = acc1[rg]; }
        __syncthreads();
        if (tid < 64) {
            const int row = tid >> 2, c8 = (tid & 3) * 8;
            f32x4 v0 = (f32x4){0.f, 0.f, 0.f, 0.f}, v1 = (f32x4){0.f, 0.f, 0.f, 0.f};
#pragma unroll
            for (int ww = 0; ww < 8; ++ww) { const PG8_LAS f32x4* p = (const PG8_LAS f32x4*)(red + (ww * 16 + row) * 32 + c8); v0 += p[0]; v1 += p[1]; }
            E.mini(r0 + row, n0 + c8, v0, v1, lane);
        }
        __syncthreads();
    }
}
template <class Epi, class Sched, bool ALIGN_EPI = false, bool SP2 = false>
__device__ __forceinline__ void gemm_phase(int wave_idx, PG8_LAS unsigned char* lds, const Gemm g, const Sched& S, const Epi& E) {
    int tid_ = mk_tid(wave_idx); asm volatile("" : "+v"(tid_));
    const int tid = tid_, wid = __builtin_amdgcn_readfirstlane(tid >> 6), lane = tid & 63, wr = wid >> 2, wc = wid & 3, fr = lane & 15, fq = lane >> 4;
    int K_ = g.K; asm volatile("" : "+s"(K_));
    const int K = K_, nt = K / BK;
    unsigned voffA[2], voffB[2];
#pragma unroll
    for (int i = 0; i < 2; ++i) { int R, C; stage_rc(tid * 16 + i * 8192, R, C); const int Rb = Epi::PERM ? ((R & ~31) + perm32(R & 31)) : R;
        voffA[i] = (unsigned)(R * K + C) * 2u; voffB[i] = (unsigned)(Rb * K + C) * 2u; }
    const size_t kstep = (size_t)(BK * 2);
    const size_t hstep = (size_t)HALF * K * 2;
    const size_t tstep = 2 * hstep;
    const unsigned ldsw = (unsigned)wid * 1024u;
    const int aoff = lds_byte(wr * 64 + fr, fq * 8), boff = lds_byte(wc * 32 + fr, fq * 8);
#define PG8_SA(b, h) (((b) * 2 + (h)) * HTB)
#define PG8_SB(b, h) ((4 + (b) * 2 + (h)) * HTB)
#define PG8_STAGE(bufoff, gbase, voff) do { _Pragma("unroll") for (int _i = 0; _i < 2; ++_i) \
        __builtin_amdgcn_global_load_lds((const unsigned*)((const char*)(gbase) + (voff)[_i]), (PG8_LAS unsigned*)(lds + (bufoff) + ldsw + _i * 8192), 16, 0, 0); } while (0)
#define PG8_LDA(dst, b, h) do { _Pragma("unroll") for (int m = 0; m < 4; ++m) _Pragma("unroll") for (int k = 0; k < 2; ++k) dst[m][k] = *(const PG8_LAS bf16x8*)(lds + PG8_SA(b, h) + aoff + m * 2048 + k * 1024); } while (0)
#define PG8_LDB(dst, b, h) do { _Pragma("unroll") for (int n = 0; n < 2; ++n) _Pragma("unroll") for (int k = 0; k < 2; ++k) dst[n][k] = *(const PG8_LAS bf16x8*)(lds + PG8_SB(b, h) + boff + n * 2048 + k * 1024); } while (0)
#define PG8_MMA(ai, bj, At, Bt) do { __builtin_amdgcn_s_setprio(1); _Pragma("unroll") for (int m = 0; m < 4; ++m) _Pragma("unroll") for (int n = 0; n < 2; ++n) _Pragma("unroll") for (int k = 0; k < 2; ++k) \
        acc[ai][bj][m][n] = __builtin_amdgcn_mfma_f32_16x16x32_bf16(Bt[n][k], At[m][k], acc[ai][bj][m][n], 0, 0, 0); __builtin_amdgcn_s_setprio(0); } while (0)
#define PG8_WAIT_V(n) asm volatile("s_waitcnt vmcnt(" #n ")" ::: "memory")
#define PG8_WAIT_L(n) asm volatile("s_waitcnt lgkmcnt(" #n ")" ::: "memory")
#define PG8_BAR __builtin_amdgcn_s_barrier()
#define PG8_SCHED __builtin_amdgcn_sched_barrier(0)
    Unit cur, nxt; int ui = 0;
    if (!S.next(0, cur)) return;
    f32x4 acc[2][2][4][2];
#pragma unroll
    for (int a = 0; a < 2; ++a)
#pragma unroll
        for (int b = 0; b < 2; ++b)
#pragma unroll
            for (int m = 0; m < 4; ++m)
#pragma unroll
                for (int n = 0; n < 2; ++n) acc[a][b][m][n] = (f32x4){0.f, 0.f, 0.f, 0.f};
    bf16x8 At[4][2], B0[2][2], B1[2][2];
    const char* cA = (const char*)g.A + (size_t)cur.pm * tstep; const char* cB = (const char*)g.Bt + (size_t)cur.pn * tstep;
    S.a_ready(cur);
    if constexpr (SP2) {
        PG8_STAGE(PG8_SB(0, 0), cB, voffB); PG8_STAGE(PG8_SB(0, 1), cB + hstep, voffB); PG8_STAGE(PG8_SA(0, 0), cA, voffA); PG8_STAGE(PG8_SA(0, 1), cA + hstep, voffA);
        if (wr == 1) PG8_BAR;
        PG8_WAIT_V(2); PG8_BAR;
        PG8_STAGE(PG8_SB(1, 0), cB + kstep, voffB); PG8_STAGE(PG8_SA(1, 0), cA + kstep, voffA); PG8_STAGE(PG8_SB(1, 1), cB + hstep + kstep, voffB);
        PG8_WAIT_V(6); PG8_BAR;
    } else {
        PG8_STAGE(PG8_SB(0, 0), cB, voffB); PG8_STAGE(PG8_SA(0, 0), cA, voffA); PG8_STAGE(PG8_SB(0, 1), cB + hstep, voffB); PG8_STAGE(PG8_SA(0, 1), cA + hstep, voffA);
        if (wr == 1) PG8_BAR;
        PG8_WAIT_V(4); PG8_BAR;
        PG8_STAGE(PG8_SB(1, 0), cB + kstep, voffB); PG8_STAGE(PG8_SA(1, 0), cA + kstep, voffA); PG8_STAGE(PG8_SB(1, 1), cB + hstep + kstep, voffB);
        PG8_WAIT_V(6); PG8_BAR;
    }
    for (;;) {
        const bool has_next = S.next(ui + 1, nxt);
        if constexpr (Epi::NPRE > 0) {
            const float* pp = E.pre_base(cur, wr) + lane;
            __builtin_amdgcn_global_load_lds((const unsigned*)pp, (PG8_LAS unsigned*)(lds + PRE_OFF + wid * 512), 4, 0, 0);
            __builtin_amdgcn_global_load_lds((const unsigned*)(pp + 128), (PG8_LAS unsigned*)(lds + PRE_OFF + wid * 512 + 256), 4, 0, 0);
        }
        const char* nA = has_next ? (const char*)g.A + (size_t)nxt.pm * tstep : cA; const char* nB = has_next ? (const char*)g.Bt + (size_t)nxt.pn * tstep : cB;
        for (int t = 0; t < nt; t += 2) {
            const bool last = (t == nt - 2);
            const char* a1 = cA + (size_t)(t + 1) * kstep;
            const char* a2 = last ? nA : cA + (size_t)(t + 2) * kstep; const char* b2 = last ? nB : cB + (size_t)(t + 2) * kstep;
            const char* a3 = a2 + kstep; const char* b3 = b2 + kstep;
            if (last && has_next) S.a_ready(nxt);
            if constexpr (SP2) {
            PG8_LDB(B0, 0, 0); PG8_LDB(B1, 0, 1); PG8_SCHED; PG8_LDA(At, 0, 0); PG8_STAGE(PG8_SA(1, 1), a1 + hstep, voffA);
            PG8_WAIT_V(8); PG8_WAIT_L(0); PG8_BAR; PG8_MMA(0, 0, At, B0); PG8_MMA(0, 1, At, B1); PG8_BAR; PG8_SCHED;
            PG8_LDA(At, 0, 1); PG8_STAGE(PG8_SB(0, 0), b2, voffB); PG8_STAGE(PG8_SB(0, 1), b2 + hstep, voffB); PG8_STAGE(PG8_SA(0, 0), a2, voffA);
            PG8_WAIT_V(8); PG8_WAIT_L(0); PG8_BAR; PG8_MMA(1, 0, At, B0); PG8_MMA(1, 1, At, B1); PG8_BAR; PG8_SCHED;
            PG8_LDB(B0, 1, 0); PG8_LDB(B1, 1, 1); PG8_SCHED; PG8_LDA(At, 1, 0); PG8_STAGE(PG8_SA(0, 1), a2 + hstep, voffA);
            PG8_WAIT_V(8); PG8_WAIT_L(0); PG8_BAR; PG8_MMA(0, 0, At, B0); PG8_MMA(0, 1, At, B1); PG8_BAR; PG8_SCHED;
            PG8_LDA(At, 1, 1); PG8_STAGE(PG8_SB(1, 0), b3, voffB); PG8_STAGE(PG8_SB(1, 1), b3 + hstep, voffB); PG8_STAGE(PG8_SA(1, 0), a3, voffA);
            PG8_WAIT_V(8); PG8_WAIT_L(0); PG8_BAR; PG8_MMA(1, 0, At, B0); PG8_MMA(1, 1, At, B1); PG8_BAR; PG8_SCHED;
            } else {
            PG8_LDB(B0, 0, 0); PG8_SCHED; PG8_LDA(At, 0, 0); PG8_STAGE(PG8_SA(1, 1), a1 + hstep, voffA);
            PG8_WAIT_L(8); PG8_BAR; PG8_WAIT_L(0); PG8_MMA(0, 0, At, B0); PG8_BAR; PG8_SCHED;
            PG8_LDB(B1, 0, 1); PG8_STAGE(PG8_SB(0, 0), b2, voffB);
            PG8_BAR; PG8_WAIT_L(0); PG8_MMA(0, 1, At, B1); PG8_BAR;
            PG8_LDA(At, 0, 1); PG8_STAGE(PG8_SA(0, 0), a2, voffA);
            PG8_BAR; PG8_WAIT_L(0); PG8_MMA(1, 0, At, B0); PG8_BAR; PG8_SCHED;
            PG8_STAGE(PG8_SB(0, 1), b2 + hstep, voffB);
            PG8_WAIT_V(6); PG8_BAR; PG8_MMA(1, 1, At, B1); PG8_BAR;
            PG8_LDB(B0, 1, 0); PG8_SCHED; PG8_LDA(At, 1, 0); PG8_STAGE(PG8_SA(0, 1), a2 + hstep, voffA);
            PG8_WAIT_L(8); PG8_BAR; PG8_WAIT_L(0); PG8_MMA(0, 0, At, B0); PG8_BAR; PG8_SCHED;
            PG8_LDB(B1, 1, 1); PG8_STAGE(PG8_SB(1, 0), b3, voffB);
            PG8_BAR; PG8_WAIT_L(0); PG8_MMA(0, 1, At, B1); PG8_BAR;
            PG8_LDA(At, 1, 1); PG8_STAGE(PG8_SA(1, 0), a3, voffA);
            PG8_BAR; PG8_WAIT_L(0); PG8_MMA(1, 0, At, B0); PG8_BAR; PG8_SCHED;
            PG8_STAGE(PG8_SB(1, 1), b3 + hstep, voffB);
            PG8_WAIT_V(6); PG8_BAR; PG8_MMA(1, 1, At, B1); PG8_BAR;
            }
        }
        if constexpr (ALIGN_EPI) { if (wr == 0) PG8_BAR; }
        if constexpr (Epi::NPRE > 0) { E(acc, cur, wr, wc, fr, fq, (const PG8_LAS float*)(lds + PRE_OFF + wid * 512)); S.done(cur); } else
        if constexpr (!Epi::AFTER_DRAIN) { E(acc, cur, wr, wc, fr, fq); S.done(cur); }
        if (!has_next) break;
#pragma unroll
        for (int a = 0; a < 2; ++a)
#pragma unroll
            for (int b = 0; b < 2; ++b)
#pragma unroll
                for (int m = 0; m < 4; ++m)
#pragma unroll
                    for (int n = 0; n < 2; ++n) acc[a][b][m][n] = (f32x4){0.f, 0.f, 0.f, 0.f};
        cur = nxt; cA = nA; cB = nB; ++ui;
        if constexpr (ALIGN_EPI) { if (wr == 1) PG8_BAR; }
    }
    PG8_WAIT_V(0);
    if constexpr (!ALIGN_EPI) { if (wr == 0) PG8_BAR; }
    PG8_BAR;
    if constexpr (Epi::AFTER_DRAIN) { E.fused(acc, cur, wr, wc, fr, fq, lds, wid, lane); S.done(cur); }
#undef PG8_SA
#undef PG8_SB
#undef PG8_STAGE
#undef PG8_LDA
#undef PG8_LDB
#undef PG8_MMA
#undef PG8_WAIT_V
#undef PG8_WAIT_L
#undef PG8_BAR
#undef PG8_SCHED
}
}
#define GAS __attribute__((address_space(1)))
#define LAS __attribute__((address_space(3)))
typedef unsigned short bf16;
typedef unsigned v4u __attribute__((ext_vector_type(4)));
typedef float f32x4 __attribute__((ext_vector_type(4)));
typedef short bf16x8 __attribute__((ext_vector_type(8)));
typedef GAS unsigned gu32;
typedef GAS unsigned long long gu64;
#define RLX_AGENT __ATOMIC_RELAXED, __HIP_MEMORY_SCOPE_AGENT
#define LDS_WAIT() asm volatile("s_waitcnt lgkmcnt(0)" ::: "memory")
#define VM_WAIT() asm volatile("s_waitcnt vmcnt(0)" ::: "memory")
__device__ __forceinline__ unsigned long long rt() { return __builtin_amdgcn_s_memrealtime(); }
__device__ __forceinline__ unsigned f2bf(float f) { unsigned u = __builtin_bit_cast(unsigned, f); return (u + 0x7fffu + ((u >> 16) & 1u)) >> 16; }
typedef float f32x2_cv __attribute__((ext_vector_type(2))); typedef __bf16 bf16x2_cv __attribute__((ext_vector_type(2)));
__device__ __forceinline__ unsigned pk2(float lo, float hi) { const f32x2_cv v = {lo, hi}; return __builtin_bit_cast(unsigned, __builtin_convertvector(v, bf16x2_cv)); }
__device__ __forceinline__ unsigned f2bf_hw(float f) { return pk2(f, f) & 0xffffu; }

#define XB_TMO      128
#define XB_XCNT(j)  (256  + 64 * (j))
#define XB_XSUB(j)  (1280 + 64 * (j))
#define XB_XGEN(j)  (2304 + 64 * (j))
#define XB_TOP      3328
#define XB_TOPGEN   3392
#define XCD_BAR_WORDS 3456
#define XB_SPIN_CAP (1u << 18)

__device__ __forceinline__ unsigned xb_ld(unsigned* p)              { return __hip_atomic_load(p, __ATOMIC_RELAXED, __HIP_MEMORY_SCOPE_AGENT); }
__device__ __forceinline__ unsigned xb_add(unsigned* p, unsigned v) { return __hip_atomic_fetch_add(p, v, __ATOMIC_RELAXED, __HIP_MEMORY_SCOPE_AGENT); }
__device__ __forceinline__ unsigned xb_xcc_id() { return (unsigned)__builtin_amdgcn_s_getreg((3 << 11) | 20) & 0xFu; }
#define XB_SPIN(cond, bar) do { unsigned _sp = 0; while (cond) { __builtin_amdgcn_s_sleep(1); \
    if ((++_sp & 255u) == 0u) { if (xb_ld(&(bar)[XB_TMO])) break; if (_sp > XB_SPIN_CAP) { atomicAdd(&(bar)[XB_TMO], 1u); break; } } } } while (0)

struct XcdBarrier {
    unsigned* bar; unsigned x;
    volatile LAS unsigned* st;
};

__device__ __forceinline__ XcdBarrier xcd_barrier_post(unsigned* bar, volatile LAS unsigned* st) {
    XcdBarrier b; b.bar = bar; b.x = xb_xcc_id(); b.st = st;
    if (threadIdx.x == 0) (void)xb_add(&bar[XB_XCNT(b.x)], 1u);
    return b;
}
__device__ __forceinline__ void xcd_barrier_complete(unsigned* bar, unsigned x, unsigned& nloc, unsigned& nx) {
    const unsigned G = gridDim.x * gridDim.y * gridDim.z;
    unsigned sum, cnt, mine, sp = 0u;
    for (;;) {
        sum = 0u; cnt = 0u; mine = 0u;
#pragma unroll
        for (unsigned j = 0; j < 16; ++j) { const unsigned c = xb_ld(&bar[XB_XCNT(j)]); sum += c; cnt += (c > 0u) ? 1u : 0u; mine = (j == x) ? c : mine; }
        if (sum == G) break;
        __builtin_amdgcn_s_sleep(1);
        if ((++sp & 255u) == 0u) { if (xb_ld(&bar[XB_TMO])) break; if (sp > XB_SPIN_CAP) { atomicAdd(&bar[XB_TMO], 1u); break; } }
    }
    nloc = mine > 0u ? mine : 1u; nx = cnt > 0u ? cnt : 1u;
}

__device__ __forceinline__ void xcd_barrier(const XcdBarrier& b, int tid) {
    asm volatile("s_waitcnt vmcnt(0)" ::: "memory");
    __syncthreads();
    if (tid == 0) {
        unsigned* bar = b.bar;
        __builtin_amdgcn_s_waitcnt(0);
        unsigned nloc = b.st[0], nx = b.st[1];
        if (nloc == 0u) { xcd_barrier_complete(bar, b.x, nloc, nx); b.st[0] = nloc; b.st[1] = nx; }
        const unsigned old = xb_add(&bar[XB_XSUB(b.x)], 1u);
        const unsigned gen = old / nloc;
        if (old + 1u == (gen + 1u) * nloc) {
            __builtin_amdgcn_fence(__ATOMIC_RELEASE, "agent");
            asm volatile("s_waitcnt vmcnt(0)" ::: "memory");
            const unsigned og = xb_add(&bar[XB_TOP], 1u);
            const unsigned tg = og / nx;
            if (og + 1u == (tg + 1u) * nx) xb_add(&bar[XB_TOPGEN], 1u);
            else XB_SPIN(xb_ld(&bar[XB_TOPGEN]) == tg, bar);
            __builtin_amdgcn_fence(__ATOMIC_ACQUIRE, "agent");
            xb_add(&bar[XB_XGEN(b.x)], 1u);
            asm volatile("s_waitcnt vmcnt(0)" ::: "memory");
        } else {
            XB_SPIN(xb_ld(&bar[XB_XGEN(b.x)]) == gen, bar);
            __builtin_amdgcn_fence(__ATOMIC_ACQUIRE, "agent");
            asm volatile("s_waitcnt vmcnt(0)" ::: "memory");
        }
    }
    __syncthreads();
}

#define LB_SUB(j)  (64 * (j))
#define LB_GEN(j)  (1024 + 64 * (j))
#define LB_MISM    2048
__device__ __forceinline__ void xcd_local_barrier(const XcdBarrier& b, unsigned* lbar, int tid) {
    asm volatile("s_waitcnt vmcnt(0)" ::: "memory");
    __syncthreads();
    if (tid == 0) {
        __builtin_amdgcn_s_waitcnt(0);
        const unsigned nloc = b.st[0];
        const unsigned old = xb_add(&lbar[LB_SUB(b.x)], 1u);
        const unsigned gen = old / nloc;
        if (old + 1u == (gen + 1u) * nloc) xb_add(&lbar[LB_GEN(b.x)], 1u);
        else XB_SPIN(xb_ld(&lbar[LB_GEN(b.x)]) == gen, b.bar);
        __builtin_amdgcn_fence(__ATOMIC_ACQUIRE, "agent");
        asm volatile("s_waitcnt vmcnt(0)" ::: "memory");
    }
    __syncthreads();
}
typedef unsigned u32x2_t __attribute__((ext_vector_type(2)));
typedef unsigned u32x4_t __attribute__((ext_vector_type(4)));
typedef float f32x2_t __attribute__((ext_vector_type(2)));

constexpr int NWAVES = 8;
constexpr int NTOK_P = pg8::NTOK_P, NTOK = pg8::NTOK, MPAD = pg8::MPAD, ZC = pg8::ZC;
constexpr int DM = 1024, DFF = 4096, SEQ = 8192;
constexpr int ZQ = 3328, ZK = 4096, ZV = 4864, ZGA = 5632, ZGB = 6656;
using pg8::OFF_Y_P; using pg8::OFF_Y_S; using pg8::OFF_WKV_P; using pg8::OFF_WKV_S; using pg8::OUT_TOTAL;

constexpr size_t MiB = 1u << 20;
constexpr size_t WS_CTL = 0, CTL_ZERO_BYTES = 1 * MiB;
constexpr size_t WS_WIN = 1 * MiB, WS_WLORA = 16 * MiB, WS_WBR = 18 * MiB, WS_WBA = 20 * MiB, WS_WOUT = 21 * MiB, WS_WFF1 = 23 * MiB, WS_WFF2 = 31 * MiB, WS_WPG = 39 * MiB, WS_WPLE = 41 * MiB;
constexpr size_t WS_STAT = 42 * MiB;
constexpr size_t WS_LSE = 43 * MiB;
constexpr size_t WS_XB = 44 * MiB;
constexpr size_t WS_OBUF = 44 * MiB;
constexpr size_t WS_Z = 77 * MiB;
constexpr size_t WS_X1 = 77 * MiB, WS_X1B = 142 * MiB, WS_HDN = 175 * MiB, WS_T2 = 175 * MiB;
constexpr size_t WS_ALORA = 321 * MiB;
constexpr size_t WS_ATTN = 321 * MiB;
constexpr size_t WS_LW = 330 * MiB;
constexpr size_t WS_MIX = 330 * MiB;
constexpr size_t WS_PG = 363 * MiB;
constexpr size_t WS_AA = 395 * MiB;
constexpr size_t WS_RO = 395 * MiB;
constexpr size_t WS_GG = 428 * MiB;
constexpr size_t WS_GT = 461 * MiB;
constexpr size_t WS_PB = 494 * MiB, WS_GAM = 503 * MiB, WS_RK = 504 * MiB, WS_END = 505 * MiB;
static_assert(WS_Z + (size_t)MPAD * ZC * 2 <= WS_ALORA && WS_HDN + (size_t)MPAD * DFF * 2 <= WS_ALORA && WS_X1 + (size_t)MPAD * DM * 4 <= WS_X1B && WS_X1B + (size_t)MPAD * DM * 2 <= WS_HDN, "ws map");
static_assert(WS_LW + (size_t)MPAD * DM * 2 <= WS_PG && WS_PG + (size_t)4096 * 8192 <= WS_AA && WS_AA + (size_t)MPAD * DM * 2 <= WS_GG && WS_GG + (size_t)MPAD * DM * 2 <= WS_GT && WS_GT + (size_t)4096 * 8192 <= WS_PB && WS_PB + (size_t)MPAD * 256 * 2 <= WS_GAM, "ws map 2");
static_assert(WS_XB + (size_t)MPAD * DM * 2 <= WS_Z && WS_ALORA + (size_t)MPAD * 256 * 2 <= WS_LW && WS_LSE + (size_t)MPAD * 12 * 4 <= WS_XB && WS_STAT + (size_t)MPAD * 16 <= WS_LSE, "ws map 3");
constexpr int CW_TMO = 0, CW_CODE = 1, CW_BAR = 4096, CW_QUEUE = 8192, CW_QUEUE2 = 8192 + 64, CW_PROG = 12288, CW_XS = 16384, CW_LBAR = 20480;

constexpr int RING_OFF = 0, RING_BYTES = 131072;
constexpr int LDSCTL_OFF = RING_BYTES, MISC_OFF = LDSCTL_OFF + 320;
constexpr int LDS_BYTES = 147456;

struct Frame {
    LAS unsigned char* lds;
    volatile LAS unsigned* MISC;
    gu32* ctl;
    int tid, lane, wave;
    int vcu, G;
};

__device__ __forceinline__ float wave_sum(float v) {
#pragma unroll
    for (int o = 1; o < 64; o <<= 1) v += __shfl_xor(v, o);
    return v;
}
__device__ __forceinline__ float wave_max(float v) {
#pragma unroll
    for (int o = 1; o < 64; o <<= 1) v = fmaxf(v, __shfl_xor(v, o));
    return v;
}
__device__ __forceinline__ float bf2f(bf16 h) { return __uint_as_float((unsigned)h << 16); }
__device__ __forceinline__ float bflo(unsigned w) { return __uint_as_float(w << 16); }
__device__ __forceinline__ float bfhi(unsigned w) { return __uint_as_float(w & 0xffff0000u); }
__device__ __forceinline__ float sigm(float x) { return 1.0f / (1.0f + __expf(-x)); }

__device__ __forceinline__ void p0_transpose_item(const float* W, int K, int N, bf16* WT, const float* gain, LAS float* scr, int item, int lane) {
    const int nblk = N / 32, kb = item / nblk, nb = item % nblk, k0 = 64 * kb, n0 = 32 * nb;
    const int c = lane & 7;
    float v[32];
    const float* wp = W + (size_t)(k0 + (lane >> 5)) * N + n0 + (lane & 31);
#pragma unroll
    for (int i = 0; i < 32; ++i) v[i] = wp[(size_t)(2 * i) * N];
    f32x4 ga = (f32x4){1.f, 1.f, 1.f, 1.f}, gb = ga;
    if (gain) { ga = *(const f32x4*)(gain + k0 + 8 * c); gb = *(const f32x4*)(gain + k0 + 8 * c + 4); }
#pragma unroll
    for (int i = 0; i < 32; ++i) scr[(2 * i + (lane >> 5)) * 33 + (lane & 31)] = v[i];
    LDS_WAIT(); asm volatile("" ::: "memory");
#pragma unroll
    for (int j = 0; j < 4; ++j) { const int n = (lane >> 3) + 8 * j; const LAS float* s = scr + (8 * c) * 33 + n;
        v4u o; o.x = pk2(s[0 * 33] * ga.x, s[1 * 33] * ga.y); o.y = pk2(s[2 * 33] * ga.z, s[3 * 33] * ga.w); o.z = pk2(s[4 * 33] * gb.x, s[5 * 33] * gb.y); o.w = pk2(s[6 * 33] * gb.z, s[7 * 33] * gb.w);
        *(GAS v4u*)(WT + (size_t)(n0 + n) * K + k0 + 8 * c) = o; }
    LDS_WAIT(); asm volatile("" ::: "memory");
}

struct In {
    const float *x_prompt, *x_sample, *cache0, *cache1, *cache2, *state_wkv, *state_shift, *p_prompt, *p_sample, *norm_mix, *w_in, *shift_mu, *decay_w0, *decay_w2, *aaa_a0, *aaa_a2,
                *gate_g2, *k_k, *k_a, *r_k, *lnx_w, *lnx_b, *w_br, *w_ba, *w_out, *norm_mlp, *w_ff1, *w_ff2, *norm_ple, *w_ple, *w_pg, *norm_final;
};
struct Args { In in; float* out; unsigned char* ws; };

__device__ __forceinline__ void p0_prologue(Frame& F, const In& I, unsigned char* ws) {
    LAS float* scr = (LAS float*)(F.lds + RING_OFF + F.wave * 16384);
    const int gw = F.vcu * NWAVES + F.wave, NGW = F.G * NWAVES, lane = F.lane;
    constexpr int I_IN = (1024 / 64) * (7680 / 32);
    for (int it = gw; it < I_IN; it += NGW) p0_transpose_item(I.w_in, 1024, 7680, (bf16*)(ws + WS_WIN), I.norm_mix, scr, it, lane);
    {
        bf16* WL = (bf16*)(ws + WS_WLORA);
        const int gt = gw * 64 + lane, NGT = NGW * 64;
        for (int idx = gt; idx < 3072 * 32; idx += NGT) {
            const int n = idx >> 5, kc = (idx & 31) * 8, blk = n >> 10, nn = n & 1023;
            float v[8];
#pragma unroll
            for (int j = 0; j < 8; ++j) { const int k = kc + j; float x = 0.f;
                if (blk == 0) { if (k < 64) x = I.decay_w2[(size_t)k * 1024 + nn]; }
                else if (blk == 1) { if (k >= 64 && k < 128) x = I.aaa_a2[(size_t)(k - 64) * 1024 + nn]; }
                else { if (k >= 128) x = I.gate_g2[(size_t)(k - 128) * 1024 + nn]; }
                v[j] = x; }
            v4u o; o.x = pk2(v[0], v[1]); o.y = pk2(v[2], v[3]); o.z = pk2(v[4], v[5]); o.w = pk2(v[6], v[7]);
            *(GAS v4u*)(WL + (size_t)n * 256 + kc) = o;
        }
    }
    bf16* XB = (bf16*)(ws + WS_XB); float* stat = (float*)(ws + WS_STAT);
    for (int mb = gw; mb < MPAD; mb += 4 * NGW) {
        f32x4 v[4][4];
#pragma unroll
        for (int u = 0; u < 4; ++u) { const int m = mb + u * NGW;
#pragma unroll
            for (int j = 0; j < 4; ++j) v[u][j] = (f32x4){0.f, 0.f, 0.f, 0.f};
            if (m < NTOK) { const float* xrow = m < NTOK_P ? I.x_prompt + (size_t)m * DM : I.x_sample + (size_t)(m - NTOK_P) * DM; const GAS f32x4* xr = (const GAS f32x4*)xrow + lane;
#pragma unroll
                for (int j = 0; j < 4; ++j) v[u][j] = xr[64 * j]; } }
#pragma unroll
        for (int u = 0; u < 4; ++u) { const int m = mb + u * NGW;
            if (m < MPAD) {
                GAS unsigned long long* o8 = (GAS unsigned long long*)(XB + (size_t)m * DM) + lane;
                float s = 0.f;
#pragma unroll
                for (int j = 0; j < 4; ++j) s += (v[u][j].x * v[u][j].x + v[u][j].y * v[u][j].y) + (v[u][j].z * v[u][j].z + v[u][j].w * v[u][j].w);
                s = wave_sum(s);
                if (lane == 0) stat[m] = m < NTOK ? 1.0f / sqrtf(s * (1.0f / DM) + 1e-6f) : 0.f;
#pragma unroll
                for (int j = 0; j < 4; ++j) o8[64 * j] = (unsigned long long)pk2(v[u][j].x, v[u][j].y) | ((unsigned long long)pk2(v[u][j].z, v[u][j].w) << 32);
                if (lane < 3) stat[(size_t)(1 + lane) * MPAD + m] = 0.f;
            } }
    }
}
__device__ __forceinline__ void p0_late(Frame& F, const In& I, unsigned char* ws, int hw, int nhw, int it_lo, int it_hi, int m_lo, int m_hi) {
    LAS float* scr = (LAS float*)(F.lds + RING_OFF + F.wave * 16384);
    const int lane = F.lane;
    constexpr int I_SQ = (1024 / 64) * (1024 / 32), I_BA = (256 / 64) * (1024 / 32), I_F1 = (1024 / 64) * (4096 / 32), I_F2 = (4096 / 64) * (1024 / 32);
    constexpr int NITEMS = 3 * I_SQ + 2 * I_BA + I_F1 + I_F2;
    for (int it = it_lo + hw; it < (it_hi < NITEMS ? it_hi : NITEMS); it += nhw) {
        int r = it;
        if (r < I_SQ) { p0_transpose_item(I.w_br, 1024, 1024, (bf16*)(ws + WS_WBR), nullptr, scr, r, lane); continue; } r -= I_SQ;
        if (r < I_SQ) { p0_transpose_item(I.w_out, 1024, 1024, (bf16*)(ws + WS_WOUT), nullptr, scr, r, lane); continue; } r -= I_SQ;
        if (r < I_SQ) { p0_transpose_item(I.w_pg, 1024, 1024, (bf16*)(ws + WS_WPG), I.norm_ple, scr, r, lane); continue; } r -= I_SQ;
        if (r < I_BA) { p0_transpose_item(I.w_ba, 256, 1024, (bf16*)(ws + WS_WBA), nullptr, scr, r, lane); continue; } r -= I_BA;
        if (r < I_BA) { p0_transpose_item(I.w_ple, 256, 1024, (bf16*)(ws + WS_WPLE), nullptr, scr, r, lane); continue; } r -= I_BA;
        if (r < I_F1) { p0_transpose_item(I.w_ff1, 1024, 4096, (bf16*)(ws + WS_WFF1), I.norm_mlp, scr, r, lane); continue; } r -= I_F1;
        p0_transpose_item(I.w_ff2, 4096, 1024, (bf16*)(ws + WS_WFF2), nullptr, scr, r, lane);
    }
    bf16* PB = (bf16*)(ws + WS_PB);
    const int m_end = m_hi < MPAD ? m_hi : MPAD;
    for (int mb = m_lo + hw; mb < m_end; mb += 4 * nhw) {
        f32x4 pv[4];
#pragma unroll
        for (int u = 0; u < 4; ++u) { const int m = mb + u * nhw; pv[u] = (f32x4){0.f, 0.f, 0.f, 0.f};
            if (m < NTOK) { const float* prow = m < NTOK_P ? I.p_prompt + (size_t)m * 256 : I.p_sample + (size_t)(m - NTOK_P) * 256; pv[u] = ((const GAS f32x4*)prow)[lane]; } }
#pragma unroll
        for (int u = 0; u < 4; ++u) { const int m = mb + u * nhw;
            if (m < m_end) ((GAS unsigned long long*)(PB + (size_t)m * 256))[lane] = (unsigned long long)pk2(pv[u].x, pv[u].y) | ((unsigned long long)pk2(pv[u].z, pv[u].w) << 32); }
    }
}

struct LoraGroup {
    u32x2_t zr[8], zp; f32x4 pv0, pv4; int kind;
    __device__ __forceinline__ void load(const In& I, const bf16* Z, int grp, int c) {
        kind = 0; pv0 = (f32x4){0.f, 0.f, 0.f, 0.f}; pv4 = pv0; zp = (u32x2_t){0u, 0u};
#pragma unroll
        for (int i = 0; i < 8; ++i) zr[i] = (u32x2_t){0u, 0u};
        if (grp >= MPAD / 8) return;
        const int m0 = grp * 8;
        if (m0 >= NTOK) { kind = 3; return; }
        const bf16* zb = Z + (size_t)m0 * ZC + 3072 + c;
#pragma unroll
        for (int i = 0; i < 8; ++i) zr[i] = *(const u32x2_t*)(zb + (size_t)i * ZC);
        if (m0 >= NTOK_P) { kind = 2; const float* sp = I.state_shift + (size_t)((m0 - NTOK_P) >> 2) * 3328 + 3072 + c; pv0 = *(const f32x4*)sp; pv4 = *(const f32x4*)(sp + 3328); }
        else { kind = 1; if ((m0 & (SEQ - 1)) != 0) zp = *(const u32x2_t*)(zb - ZC); }
    }
    __device__ __forceinline__ void finish(bf16* AL, int grp, int c, const f32x4 mu) const {
        if (kind == 0) return;
        GAS unsigned long long* ao = (GAS unsigned long long*)(AL + (size_t)grp * 8 * 256 + c);
        if (kind == 3) {
#pragma unroll
            for (int i = 0; i < 8; ++i) ao[(size_t)i * 64] = 0ull;
            return;
        }
        const bool ident = c >= 64 && c < 128; const float ka = c < 64 ? 2.0f : 1.0f, kb = c < 64 ? -1.0f : 0.0f;
#pragma unroll
        for (int i = 0; i < 8; ++i) {
            const f32x4 z = (f32x4){bflo(zr[i].x), bfhi(zr[i].x), bflo(zr[i].y), bfhi(zr[i].y)};
            const u32x2_t q = i > 0 ? zr[i > 0 ? i - 1 : 0] : zp;
            f32x4 pr = (f32x4){bflo(q.x), bfhi(q.x), bflo(q.y), bfhi(q.y)};
            if (kind == 2) { if (i == 0) pr = pv0; if (i == 4) pr = pv4; }
            f32x4 zs; zs.x = z.x + (pr.x - z.x) * mu.x; zs.y = z.y + (pr.y - z.y) * mu.y; zs.z = z.z + (pr.z - z.z) * mu.z; zs.w = z.w + (pr.w - z.w) * mu.w;
            float r[4];
#pragma unroll
            for (int e = 0; e < 4; ++e) { const float sg = __builtin_amdgcn_rcpf(1.0f + __expf(-ka * zs[e])); const float t = ka * sg + kb; r[e] = ident ? zs[e] : t; }
            ao[(size_t)i * 64] = (unsigned long long)pk2(r[0], r[1]) | ((unsigned long long)pk2(r[2], r[3]) << 32);
        }
    }
};
__device__ __forceinline__ void p2a_all(Frame& F, const In& I, unsigned char* ws, float* out) {
    const int gw = F.vcu * NWAVES + F.wave, NGW = F.G * NWAVES, lane = F.lane;
    const bf16* Z = (const bf16*)(ws + WS_Z); bf16* AL = (bf16*)(ws + WS_ALORA);
    const int c = 4 * lane;
    const f32x4 mu = *(const f32x4*)(I.shift_mu + 3072 + c);
    constexpr int NKVP = 10752, NKV = NKVP + 768, NIT = NKV + 34 * 13, UN = 6, NGRP = MPAD / 8;
    for (int p = 0; gw + p * UN * NGW < NIT || gw + 2 * p * NGW < NGRP; ++p) {
        const int j0 = gw + p * UN * NGW, g0 = gw + 2 * p * NGW;
        int g1 = g0 + NGW;
        if (NGW * 8 == NTOK_P) { const int cls = gw >> 8, wl_ = gw & 255;
            g1 = wl_ < 2 ? NTOK_P / 8 + 2 * cls + wl_ : (wl_ < 4 ? NTOK / 8 + 2 * cls + wl_ - 2 : NGRP); }
        u32x2_t zv[UN]; size_t doff[UN];
#pragma unroll
        for (int u = 0; u < UN; ++u) {
            const int j = j0 + u * NGW; zv[u] = (u32x2_t){0u, 0u}; doff[u] = 0;
            if (j < NIT) {
                size_t srow; int col;
                if (j < NKVP) { const int b = j / 5376, q = j % 5376, g = q < 256 ? 0 : (q < 1280 ? 1 : 2), q0 = q - (g == 0 ? 0 : (g == 1 ? 256 : 1280)), rr = q0 >> 1, kvsel = q0 & 1, keep = 128 << (2 * g);
                    srow = (size_t)b * SEQ + (SEQ - keep + rr); col = (kvsel ? ZV : ZK) + g * 256;
                    doff[u] = (g == 0 ? pg8::OFF_KVP0 : (g == 1 ? pg8::OFF_KVP1 : pg8::OFF_KVP2)) + ((size_t)(b * keep + rr) * 2 + kvsel) * 256; }
                else if (j < NKV) { const int jj = j - NKVP, sr = jj / 6, kg = jj % 6, kvsel = kg / 3, g = kg % 3;
                    srow = (size_t)NTOK_P + sr; col = (kvsel ? ZV : ZK) + g * 256;
                    doff[u] = (g == 0 ? pg8::OFF_KVS0 : (g == 1 ? pg8::OFF_KVS1 : pg8::OFF_KVS2)) + ((size_t)sr * 2 + kvsel) * 256; }
                else { const int jj = j - NKV, sr = jj / 13, cb = (jj % 13) * 256;
                    srow = sr < 2 ? (size_t)sr * SEQ + SEQ - 1 : (size_t)NTOK_P + (sr - 2) * 4 + 3; col = cb;
                    doff[u] = (sr < 2 ? pg8::OFF_SHIFT_P + (size_t)sr * 3328 : pg8::OFF_SHIFT_S + (size_t)(sr - 2) * 3328) + cb; }
                zv[u] = *(const u32x2_t*)(Z + srow * ZC + col + c);
            }
        }
        LoraGroup A, B; A.load(I, Z, g0, c); B.load(I, Z, g1, c);
        A.finish(AL, g0, c, mu); B.finish(AL, g1, c, mu);
#pragma unroll
        for (int u = 0; u < UN; ++u) if (j0 + u * NGW < NIT) *(f32x4*)(out + doff[u] + c) = (f32x4){bflo(zv[u].x), bfhi(zv[u].x), bflo(zv[u].y), bfhi(zv[u].y)};
    }
}

__device__ __forceinline__ float dpp_f(float v, const int ctrl, const int rmask) { (void)ctrl; (void)rmask; return v; }
#define DPP_ADD(v, ctrl, rmask) v += __builtin_bit_cast(float, __builtin_amdgcn_update_dpp(0, __builtin_bit_cast(int, v), ctrl, rmask, 0xf, false))
__device__ __forceinline__ float wave_sum_dpp(float v) {
    DPP_ADD(v, 0xb1, 0xf);
    DPP_ADD(v, 0x4e, 0xf);
    DPP_ADD(v, 0x114, 0xf);
    DPP_ADD(v, 0x118, 0xf);
    DPP_ADD(v, 0x142, 0xa);
    DPP_ADD(v, 0x143, 0xc);
    return __builtin_bit_cast(float, __builtin_amdgcn_readlane(__builtin_bit_cast(int, v), 63));
}

constexpr int SCAN_TB = 8;
constexpr int SC_NC = 64, SC_L = 128;
struct ScanC { float mu_r, mu_k, mu_v, kk_c, ka_c, rk_c; };

template <int NB, bool NEED_R>
__device__ __forceinline__ void scan_prep(const bf16* Z, const bf16* LW, const bf16* AA, size_t m0, int col, int lane, const ScanC& c, float& pr, float& pk, float& pv, LAS float* wl) {
    LAS float* LA = wl; LAS float* LWv = wl + SCAN_TB * 64; LAS float* LB = wl + 2 * SCAN_TB * 64; LAS float* LK = wl + 3 * SCAN_TB * 64; LAS float* LR = wl + 4 * SCAN_TB * 64; LAS float* LV = wl + 5 * SCAN_TB * 64;
    LAS float* LS = wl + 6 * SCAN_TB * 64;
    float zr_[NB], zk_[NB], zv_[NB], lw_[NB], aa_[NB];
#pragma unroll
    for (int tt = 0; tt < NB; ++tt) { const size_t m = m0 + tt;
        const bf16* zrow = Z + m * ZC; const bf16* lrow = LW + m * 1024; const bf16* arow = AA + m * 1024; const unsigned uc = (unsigned)col;
        zr_[tt] = NEED_R ? bf2f(zrow[uc]) : 0.f; zk_[tt] = bf2f(zrow[uc + 1024u]); zv_[tt] = bf2f(zrow[uc + 2048u]);
        lw_[tt] = bf2f(lrow[uc]); aa_[tt] = bf2f(arow[uc]); }
#pragma unroll
    for (int tt = 0; tt < NB; ++tt) {
        const float zr = zr_[tt], zk = zk_[tt], zv = zv_[tt], aa = aa_[tt];
        const float k = zk + (pk - zk) * c.mu_k, v = zv + (pv - zv) * c.mu_v;
        pk = zk; pv = zv;
        const float w = __expf(lw_[tt]);
        const float kkv = k * c.kk_c;
        const float nrm = sqrtf(wave_sum_dpp(kkv * kkv));
        const float kk = kkv / fmaxf(nrm, 1e-12f);
        const float kp = k * (1.0f + (aa - 1.0f) * c.ka_c);
        LA[tt * 64 + lane] = -kk; LWv[tt * 64 + lane] = w; LB[tt * 64 + lane] = kk * aa; LK[tt * 64 + lane] = kp; LV[tt * 64 + lane] = v;
        if (NEED_R) { const float r = zr + (pr - zr) * c.mu_r; pr = zr; const float rk = wave_sum_dpp(r * kp * c.rk_c); LR[tt * 64 + lane] = r; if (lane == 0) LS[tt] = rk; }
    }
}

__device__ __forceinline__ void scan_pass1(Frame& F, const In& I, unsigned char* ws, float* pq, int unit, LAS float* wl) {
    const int lane = F.lane;
    const int seq = unit / SC_NC, ch = unit % SC_NC, b = seq >> 4, h = seq & 15;
    const int col = h * 64 + lane;
    const size_t row0 = (size_t)b * SEQ + (size_t)ch * SC_L;
    const bf16* Z = (const bf16*)(ws + WS_Z); const bf16* LW = (const bf16*)(ws + WS_LW); const bf16* AA = (const bf16*)(ws + WS_AA);
    ScanC c; c.mu_r = 0.f; c.mu_k = I.shift_mu[1024 + col]; c.mu_v = I.shift_mu[2048 + col]; c.kk_c = I.k_k[col]; c.ka_c = I.k_a[col]; c.rk_c = 0.f;
    float pr = 0.f, pk = 0.f, pv = 0.f;
    if (ch > 0) { pk = bf2f(Z[(row0 - 1) * ZC + 1024 + col]); pv = bf2f(Z[(row0 - 1) * ZC + 2048 + col]); }
    f32x2_t sP[32], sQ[32];
    { int ln = lane; asm volatile("" : "+v"(ln));
#pragma unroll
    for (int j = 0; j < 32; ++j) { sP[j] = (f32x2_t){(2 * j == ln) ? 1.f : 0.f, (2 * j + 1 == ln) ? 1.f : 0.f}; sQ[j] = (f32x2_t){0.f, 0.f}; } }
    LAS float* LA = wl; LAS float* LWv = wl + SCAN_TB * 64; LAS float* LB = wl + 2 * SCAN_TB * 64; LAS float* LK = wl + 3 * SCAN_TB * 64; LAS float* LV = wl + 5 * SCAN_TB * 64;
    for (int t0 = 0; t0 < SC_L; t0 += SCAN_TB) {
        scan_prep<SCAN_TB, false>(Z, LW, AA, row0 + t0, col, lane, c, pr, pk, pv, wl);
        LDS_WAIT(); asm volatile("" ::: "memory");
#pragma unroll 1
        for (int tt = 0; tt < SCAN_TB; ++tt) {
            const float vv = LV[tt * 64 + lane];
            const LAS f32x4* a4 = (const LAS f32x4*)(LA + tt * 64); const LAS f32x4* w4 = (const LAS f32x4*)(LWv + tt * 64); const LAS f32x4* b4 = (const LAS f32x4*)(LB + tt * 64);
            const LAS f32x4* k4 = (const LAS f32x4*)(LK + tt * 64);
            f32x2_t p0 = {0.f, 0.f}, p1 = {0.f, 0.f}, q0 = {0.f, 0.f}, q1 = {0.f, 0.f};
            f32x4 av[4], an[4];
#pragma unroll
            for (int i = 0; i < 4; ++i) av[i] = a4[i];
#pragma unroll
            for (int g = 0; g < 4; ++g) {
                if (g < 3) {
#pragma unroll
                    for (int i = 0; i < 4; ++i) an[i] = a4[4 * (g + 1) + i]; }
                __builtin_amdgcn_sched_barrier(0);
#pragma unroll
                for (int i = 0; i < 4; ++i) { const int j = 4 * g + i; const f32x2_t lo = __builtin_shufflevector(av[i], av[i], 0, 1), hi = __builtin_shufflevector(av[i], av[i], 2, 3);
                    p0 += sP[2 * j] * lo; p1 += sP[2 * j + 1] * hi; q0 += sQ[2 * j] * lo; q1 += sQ[2 * j + 1] * hi; }
#pragma unroll
                for (int i = 0; i < 4; ++i) av[i] = an[i];
            }
            const float saP = (p0.x + p0.y) + (p1.x + p1.y), saQ = (q0.x + q0.y) + (q1.x + q1.y);
            const f32x2_t saP2 = {saP, saP}, saQ2 = {saQ, saQ}, vv2 = {vv, vv};
            f32x4 wv[2], bv[2], kv[2], wn[2], bn[2], kn[2];
#pragma unroll
            for (int i = 0; i < 2; ++i) { wv[i] = w4[i]; bv[i] = b4[i]; kv[i] = k4[i]; }
#pragma unroll
            for (int g = 0; g < 8; ++g) {
                if (g < 7) {
#pragma unroll
                    for (int i = 0; i < 2; ++i) { wn[i] = w4[2 * (g + 1) + i]; bn[i] = b4[2 * (g + 1) + i]; kn[i] = k4[2 * (g + 1) + i]; } }
                __builtin_amdgcn_sched_barrier(0);
#pragma unroll
                for (int i = 0; i < 2; ++i) { const int j = 2 * g + i;
                    const f32x2_t wlo = __builtin_shufflevector(wv[i], wv[i], 0, 1), whi = __builtin_shufflevector(wv[i], wv[i], 2, 3);
                    const f32x2_t blo = __builtin_shufflevector(bv[i], bv[i], 0, 1), bhi = __builtin_shufflevector(bv[i], bv[i], 2, 3);
                    const f32x2_t klo = __builtin_shufflevector(kv[i], kv[i], 0, 1), khi = __builtin_shufflevector(kv[i], kv[i], 2, 3);
                    sP[2 * j] = sP[2 * j] * wlo + saP2 * blo; sP[2 * j + 1] = sP[2 * j + 1] * whi + saP2 * bhi;
                    sQ[2 * j] = sQ[2 * j] * wlo + (saQ2 * blo + vv2 * klo); sQ[2 * j + 1] = sQ[2 * j + 1] * whi + (saQ2 * bhi + vv2 * khi); }
#pragma unroll
                for (int i = 0; i < 2; ++i) { wv[i] = wn[i]; bv[i] = bn[i]; kv[i] = kn[i]; }
            }
        }
        LDS_WAIT(); asm volatile("" ::: "memory");
    }
    float* dP = pq + (size_t)unit * 8192 + (size_t)lane * 64; float* dQ = dP + 4096;
#pragma unroll
    for (int j = 0; j < 16; ++j) { *(f32x4*)(dP + 4 * j) = (f32x4){sP[2 * j].x, sP[2 * j].y, sP[2 * j + 1].x, sP[2 * j + 1].y}; *(f32x4*)(dQ + 4 * j) = (f32x4){sQ[2 * j].x, sQ[2 * j].y, sQ[2 * j + 1].x, sQ[2 * j + 1].y}; }
}

template <bool STORE> __device__ __forceinline__ void scan_chain(Frame& F, float* pq, float* out, int seq, int ct) {
    const int lane = F.lane, a = lane & 15, q = lane >> 4;
    float* base = pq + (size_t)seq * SC_NC * 8192;
    const size_t qoff = (size_t)(16 * ct + a) * 64 + 4 * q, poff = (size_t)(4 * q) * 64 + a;
    f32x4 st[4], qn[4]; float pn[64];
#pragma unroll
    for (int rt2 = 0; rt2 < 4; ++rt2) st[rt2] = *(const f32x4*)(base + 4096 + qoff + 16 * rt2);
#pragma unroll
    for (int rt2 = 0; rt2 < 4; ++rt2) qn[rt2] = *(const f32x4*)(base + 8192 + 4096 + qoff + 16 * rt2);
#pragma unroll
    for (int rt = 0; rt < 4; ++rt)
#pragma unroll
        for (int rg = 0; rg < 4; ++rg)
#pragma unroll
            for (int rt2 = 0; rt2 < 4; ++rt2) pn[(rt * 4 + rg) * 4 + rt2] = base[8192 + poff + (size_t)(16 * rt + rg) * 64 + 16 * rt2];
    for (int c = 1; c < SC_NC; ++c) {
        float* P = base + (size_t)c * 8192; float* Q = P + 4096;
        f32x4 acc[4]; float pc[64];
#pragma unroll
        for (int rt2 = 0; rt2 < 4; ++rt2) acc[rt2] = qn[rt2];
#pragma unroll
        for (int i = 0; i < 64; ++i) pc[i] = pn[i];
        if (c + 1 < SC_NC) {
#pragma unroll
            for (int rt2 = 0; rt2 < 4; ++rt2) qn[rt2] = *(const f32x4*)(Q + 8192 + qoff + 16 * rt2);
#pragma unroll
            for (int rt = 0; rt < 4; ++rt)
#pragma unroll
                for (int rg = 0; rg < 4; ++rg)
#pragma unroll
                    for (int rt2 = 0; rt2 < 4; ++rt2) pn[(rt * 4 + rg) * 4 + rt2] = P[8192 + poff + (size_t)(16 * rt + rg) * 64 + 16 * rt2];
        }
#pragma unroll
        for (int rt2 = 0; rt2 < 4; ++rt2) if (STORE) *(f32x4*)(Q - 8192 + qoff + 16 * rt2) = st[rt2];
#pragma unroll
        for (int rt = 0; rt < 4; ++rt)
#pragma unroll
            for (int rg = 0; rg < 4; ++rg)
#pragma unroll
                for (int rt2 = 0; rt2 < 4; ++rt2) acc[rt2] = __builtin_amdgcn_mfma_f32_16x16x4f32(pc[(rt * 4 + rg) * 4 + rt2], st[rt][rg], acc[rt2], 0, 0, 0);
#pragma unroll
        for (int rt2 = 0; rt2 < 4; ++rt2) st[rt2] = acc[rt2];
    }
    float* dst = out + OFF_WKV_P + (size_t)seq * 4096;
#pragma unroll
    for (int rt2 = 0; rt2 < 4; ++rt2) { if (STORE) *(f32x4*)(dst + qoff + 16 * rt2) = st[rt2]; else asm volatile("" :: "v"(st[rt2])); }
}

template <int NB>
__device__ __forceinline__ void scan_out(Frame& F, const In& I, unsigned char* ws, size_t row0, int T, int h, const float* init, float* fin, float pr, float pk, float pv, LAS float* wl) {
    const int lane = F.lane;
    const int col = h * 64 + lane;
    const bf16* Z = (const bf16*)(ws + WS_Z); const bf16* LW = (const bf16*)(ws + WS_LW); const bf16* AA = (const bf16*)(ws + WS_AA); const bf16* GG = (const bf16*)(ws + WS_GG);
    bf16* RO = (bf16*)(ws + WS_RO);
    ScanC c; c.mu_r = I.shift_mu[col]; c.mu_k = I.shift_mu[1024 + col]; c.mu_v = I.shift_mu[2048 + col]; c.kk_c = I.k_k[col]; c.ka_c = I.k_a[col]; c.rk_c = I.r_k[col];
    const float lnw_c = I.lnx_w[col], lnb_c = I.lnx_b[col];
    f32x2_t s[32];
    if (init) { const f32x4* sp = (const f32x4*)(init + (size_t)lane * 64);
#pragma unroll
        for (int j = 0; j < 16; ++j) { const f32x4 v = sp[j]; s[2 * j] = (f32x2_t){v.x, v.y}; s[2 * j + 1] = (f32x2_t){v.z, v.w}; } }
    else {
#pragma unroll
        for (int j = 0; j < 32; ++j) s[j] = (f32x2_t){0.f, 0.f}; }
    LAS float* LA = wl; LAS float* LWv = wl + SCAN_TB * 64; LAS float* LB = wl + 2 * SCAN_TB * 64; LAS float* LK = wl + 3 * SCAN_TB * 64; LAS float* LR = wl + 4 * SCAN_TB * 64; LAS float* LV = wl + 5 * SCAN_TB * 64;
    LAS float* LS = wl + 6 * SCAN_TB * 64;
    for (int t0 = 0; t0 < T; t0 += NB) {
        scan_prep<NB, true>(Z, LW, AA, row0 + t0, col, lane, c, pr, pk, pv, wl);
        LDS_WAIT(); asm volatile("" ::: "memory");
#pragma unroll 1
        for (int tt = 0; tt < NB; ++tt) {
            const size_t m = row0 + t0 + tt;
            const float vv = LV[tt * 64 + lane];
            const float gg = bf2f(GG[m * 1024 + col]);
            const LAS f32x4* a4 = (const LAS f32x4*)(LA + tt * 64); const LAS f32x4* w4 = (const LAS f32x4*)(LWv + tt * 64); const LAS f32x4* b4 = (const LAS f32x4*)(LB + tt * 64);
            const LAS f32x4* k4 = (const LAS f32x4*)(LK + tt * 64); const LAS f32x4* r4 = (const LAS f32x4*)(LR + tt * 64);
            f32x2_t p0 = {0.f, 0.f}, p1 = {0.f, 0.f};
            f32x4 av[4], an[4];
#pragma unroll
            for (int i = 0; i < 4; ++i) av[i] = a4[i];
#pragma unroll
            for (int g = 0; g < 4; ++g) {
                if (g < 3) {
#pragma unroll
                    for (int i = 0; i < 4; ++i) an[i] = a4[4 * (g + 1) + i]; }
                __builtin_amdgcn_sched_barrier(0);
#pragma unroll
                for (int i = 0; i < 4; ++i) { const int j = 4 * g + i; const f32x2_t lo = __builtin_shufflevector(av[i], av[i], 0, 1), hi = __builtin_shufflevector(av[i], av[i], 2, 3);
                    p0 += s[2 * j] * lo; p1 += s[2 * j + 1] * hi; }
#pragma unroll
                for (int i = 0; i < 4; ++i) av[i] = an[i];
            }
            const float sa = (p0.x + p0.y) + (p1.x + p1.y);
            const f32x2_t sa2 = {sa, sa}, vv2 = {vv, vv};
            f32x2_t y0 = {0.f, 0.f}, y1 = {0.f, 0.f};
            f32x4 wv[2], bv[2], kv[2], rv[2], wn[2], bn[2], kn[2], rn[2];
#pragma unroll
            for (int i = 0; i < 2; ++i) { wv[i] = w4[i]; bv[i] = b4[i]; kv[i] = k4[i]; rv[i] = r4[i]; }
#pragma unroll
            for (int g = 0; g < 8; ++g) {
                if (g < 7) {
#pragma unroll
                    for (int i = 0; i < 2; ++i) { wn[i] = w4[2 * (g + 1) + i]; bn[i] = b4[2 * (g + 1) + i]; kn[i] = k4[2 * (g + 1) + i]; rn[i] = r4[2 * (g + 1) + i]; } }
                __builtin_amdgcn_sched_barrier(0);
#pragma unroll
                for (int i = 0; i < 2; ++i) { const int j = 2 * g + i;
                    const f32x2_t wlo = __builtin_shufflevector(wv[i], wv[i], 0, 1), whi = __builtin_shufflevector(wv[i], wv[i], 2, 3);
                    const f32x2_t blo = __builtin_shufflevector(bv[i], bv[i], 0, 1), bhi = __builtin_shufflevector(bv[i], bv[i], 2, 3);
                    const f32x2_t klo = __builtin_shufflevector(kv[i], kv[i], 0, 1), khi = __builtin_shufflevector(kv[i], kv[i], 2, 3);
                    const f32x2_t rlo = __builtin_shufflevector(rv[i], rv[i], 0, 1), rhi = __builtin_shufflevector(rv[i], rv[i], 2, 3);
                    s[2 * j] = s[2 * j] * wlo + (sa2 * blo + vv2 * klo); s[2 * j + 1] = s[2 * j + 1] * whi + (sa2 * bhi + vv2 * khi);
                    y0 += s[2 * j] * rlo; y1 += s[2 * j + 1] * rhi; }
#pragma unroll
                for (int i = 0; i < 2; ++i) { wv[i] = wn[i]; bv[i] = bn[i]; kv[i] = kn[i]; rv[i] = rn[i]; }
            }
            const float y = (y0.x + y0.y) + (y1.x + y1.y);
            const float mean = wave_sum_dpp(y) * (1.0f / 64.0f), d = y - mean;
            const float var = wave_sum_dpp(d * d) * (1.0f / 64.0f);
            const float yn = d * (1.0f / sqrtf(var + 64e-5f)) * lnw_c + lnb_c;
            const float o = (yn + LS[tt] * vv) * gg;
            RO[m * 1024 + col] = (bf16)pk2(o, o);
        }
        LDS_WAIT(); asm volatile("" ::: "memory");
    }
    if (fin) { float* dst = fin + (size_t)lane * 64;
#pragma unroll
        for (int j = 0; j < 16; ++j) *(f32x4*)(dst + 4 * j) = (f32x4){s[2 * j].x, s[2 * j].y, s[2 * j + 1].x, s[2 * j + 1].y}; }
}

__device__ __forceinline__ void attn_sample_item(Frame& F, const In& I, unsigned char* ws, int item, LAS float* wl) {
    const int lane = F.lane;
    const int h = item & 3, g = (item >> 2) % 3, nt = item / 12, n = nt >> 2, t = nt & 3;
    const int d = g == 0 ? 1 : (g == 1 ? 4 : 16), L = g == 0 ? 128 : (g == 1 ? 512 : 2048);
    const float* cache = g == 0 ? I.cache0 : (g == 1 ? I.cache1 : I.cache2);
    const bf16* Z = (const bf16*)(ws + WS_Z);
    const size_t mq = (size_t)(NTOK_P + nt);
    const int hc = g * 256 + h * 64;
    wl[lane] = bf2f(Z[mq * ZC + ZQ + hc + lane]) * 0.125f;
    LDS_WAIT(); asm volatile("" ::: "memory");
    float sc[3];
#pragma unroll
    for (int jj = 0; jj < 3; ++jj) {
        const int j = lane + 64 * jj;
        float s = -1e30f;
        if (j <= 128) {
            const int idx = L + t - d * j;
            float acc = 0.f;
            if (idx >= L) { const bf16* kr = Z + (size_t)(NTOK_P + n * 4 + idx - L) * ZC + ZK + hc;
#pragma unroll
                for (int e8 = 0; e8 < 8; ++e8) { const v4u kv = *(const v4u*)(kr + 8 * e8); const LAS f32x4* qq = (const LAS f32x4*)(wl + 8 * e8); const f32x4 q0 = qq[0], q1 = qq[1];
                    acc += bflo(kv.x) * q0.x + bfhi(kv.x) * q0.y + bflo(kv.y) * q0.z + bfhi(kv.y) * q0.w + bflo(kv.z) * q1.x + bfhi(kv.z) * q1.y + bflo(kv.w) * q1.z + bfhi(kv.w) * q1.w; } }
            else { const float* kr = cache + (((size_t)n * L + idx) * 2 + 0) * 256 + h * 64;
#pragma unroll
                for (int e4 = 0; e4 < 16; ++e4) { const f32x4 kv = *(const f32x4*)(kr + 4 * e4); const f32x4 q0 = ((const LAS f32x4*)wl)[e4];
                    acc += kv.x * q0.x + kv.y * q0.y + kv.z * q0.z + kv.w * q0.w; } }
            s = acc;
        }
        sc[jj] = s;
    }
    const float mx = wave_max(fmaxf(fmaxf(sc[0], sc[1]), sc[2]));
    float den = 0.f;
#pragma unroll
    for (int jj = 0; jj < 3; ++jj) { const int j = lane + 64 * jj; const float p = (j <= 128) ? __expf(sc[jj] - mx) : 0.f; den += p; if (j <= 128) wl[64 + j] = p; }
    den = wave_sum(den);
    LDS_WAIT(); asm volatile("" ::: "memory");
    float o = 0.f;
    {
#pragma unroll
        for (int j = 0; j < 4; ++j) { const int idx = L + t - d * j; float v;
            if (idx >= L) v = bf2f(Z[(size_t)(NTOK_P + n * 4 + idx - L) * ZC + ZV + hc + lane]); else v = cache[(((size_t)n * L + idx) * 2 + 1) * 256 + h * 64 + lane];
            o += wl[64 + j] * v; }
        const float* cv = cache + ((size_t)n * L * 2 + 1) * 256 + h * 64 + lane;
#pragma unroll 1
        for (int j0 = 4; j0 < 124; j0 += 40) {
            float v[40];
#pragma unroll
            for (int u = 0; u < 40; ++u) v[u] = cv[(size_t)(L + t - d * (j0 + u)) * 512];
#pragma unroll
            for (int u = 0; u < 40; ++u) o += wl[64 + j0 + u] * v[u];
        }
#pragma unroll
        for (int j = 124; j <= 128; ++j) o += wl[64 + j] * cv[(size_t)(L + t - d * j) * 512];
    }
    bf16* OB = (bf16*)(ws + WS_OBUF); float* LSE = (float*)(ws + WS_LSE);
    OB[mq * 768 + hc + lane] = (bf16)pk2(o / den, o / den);
    if (lane == 0) LSE[mq * 12 + g * 4 + h] = mx + __logf(den);
    LDS_WAIT(); asm volatile("" ::: "memory");
}

constexpr int AQ_PITCH = 144, AK_PITCH = 144, AV_PITCH = 144;
constexpr int A_QS = 0, A_KS = 128 * AQ_PITCH, A_VT = A_KS + 256 * AK_PITCH, A_END = A_VT + 256 * AV_PITCH;
static_assert(A_END <= RING_BYTES, "attention LDS");
typedef short s16x4 __attribute__((ext_vector_type(4)));
typedef short v4i16_tr __attribute__((ext_vector_type(4)));
struct AttnRaw { v4u q[2], k[4], v[4]; };
__device__ __forceinline__ void attn_prompt_load(Frame& F, unsigned char* ws, int unit, AttnRaw& R) {
    const int tid = F.tid;
    const int sub = unit & 63, bgh = unit >> 6, h = bgh & 3, g = (bgh >> 2) % 3, b = bgh / 12;
    const int dsh = 2 * g, d = 1 << dsh, nblk = 64 >> dsh;
    const int r = sub / nblk, blk = sub % nblk;
    const bf16* Z = (const bf16*)(ws + WS_Z);
    const int hc = g * 256 + h * 64;
    const size_t rowb = (size_t)b * SEQ;
#pragma unroll
    for (int k = 0; k < 2; ++k) { const int ch = tid + 512 * k, i = ch >> 3, c8 = ch & 7; const int pos = r + d * (128 * blk + i);
        R.q[k] = *(const v4u*)(Z + (rowb + pos) * ZC + ZQ + hc + 8 * c8); }
#pragma unroll
    for (int k = 0; k < 4; ++k) { const int ch = tid + 512 * k, j = ch >> 3, c8 = ch & 7; const int pos = r + d * (128 * (blk - 1) + j);
        R.k[k] = (v4u){0u, 0u, 0u, 0u}; R.v[k] = (v4u){0u, 0u, 0u, 0u};
        if (pos >= 0) { R.k[k] = *(const v4u*)(Z + (rowb + pos) * ZC + ZK + hc + 8 * c8); R.v[k] = *(const v4u*)(Z + (rowb + pos) * ZC + ZV + hc + 8 * c8); } }
}
__device__ __forceinline__ void attn_prompt_unit(Frame& F, unsigned char* ws, int unit, const AttnRaw& R, unsigned next_unit, int next_slot) {
    const int tid = F.tid, lane = F.lane, w = F.wave;
    const int sub = unit & 63, bgh = unit >> 6, h = bgh & 3, g = (bgh >> 2) % 3, b = bgh / 12;
    const int dsh = 2 * g, d = 1 << dsh, nblk = 64 >> dsh;
    const int r = sub / nblk, blk = sub % nblk;
    const int hc = g * 256 + h * 64;
    LAS unsigned char* lds = F.lds + RING_OFF;
    const size_t rowb = (size_t)b * SEQ;
#pragma unroll
    for (int k = 0; k < 2; ++k) { const int ch = tid + 512 * k, i = ch >> 3, c8 = ch & 7; *(LAS v4u*)(lds + A_QS + i * AQ_PITCH + 16 * c8) = R.q[k]; }
#pragma unroll
    for (int k = 0; k < 4; ++k) { const int ch = tid + 512 * k, j = ch >> 3, c8 = ch & 7;
        *(LAS v4u*)(lds + A_KS + j * AK_PITCH + 16 * c8) = R.k[k];
        *(LAS v4u*)(lds + A_VT + j * AV_PITCH + 16 * c8) = R.v[k]; }
    __syncthreads();
    const int l15 = lane & 15, lq = lane >> 4;
    bf16x8 qf[2];
#pragma unroll
    for (int es = 0; es < 2; ++es) qf[es] = *(const LAS bf16x8*)(lds + A_QS + (16 * w + l15) * AQ_PITCH + es * 64 + 16 * lq);
    f32x4 sacc[9];
#pragma unroll
    for (int kt = 0; kt < 9; ++kt) {
        f32x4 a = (f32x4){0.f, 0.f, 0.f, 0.f};
#pragma unroll
        for (int es = 0; es < 2; ++es) { const bf16x8 kf = *(const LAS bf16x8*)(lds + A_KS + (16 * (w + kt) + l15) * AK_PITCH + es * 64 + 16 * lq);
            a = __builtin_amdgcn_mfma_f32_16x16x32_bf16(kf, qf[es], a, 0, 0, 0); }
        sacc[kt] = a;
    }
    const int qi = 16 * w + l15;
    float mx = -1e30f;
#pragma unroll
    for (int kt = 0; kt < 9; ++kt)
#pragma unroll
        for (int rg = 0; rg < 4; ++rg) { const int kj = 16 * (w + kt) + 4 * lq + rg; const int dist = qi + 128 - kj;
            const bool ok = (dist >= 0) && (dist <= 128) && (blk > 0 || kj >= 128);
            const float sv = ok ? sacc[kt][rg] * 0.125f : -1e30f; sacc[kt][rg] = sv; mx = fmaxf(mx, sv); }
    mx = fmaxf(mx, __shfl_xor(mx, 16)); mx = fmaxf(mx, __shfl_xor(mx, 32));
    float den = 0.f;
#pragma unroll
    for (int kt = 0; kt < 9; ++kt)
#pragma unroll
        for (int rg = 0; rg < 4; ++rg) { const float p = __expf(sacc[kt][rg] - mx); sacc[kt][rg] = p; den += p; }
    den += __shfl_xor(den, 16); den += __shfl_xor(den, 32);
    f32x4 oacc[4];
#pragma unroll
    for (int et = 0; et < 4; ++et) oacc[et] = (f32x4){0.f, 0.f, 0.f, 0.f};
#pragma unroll
    for (int ks = 0; ks < 5; ++ks) {
        const int k0 = 2 * ks, k1 = 2 * ks + 1;
        u32x4_t pw;
        pw.x = pk2(sacc[k0][0], sacc[k0][1]); pw.y = pk2(sacc[k0][2], sacc[k0][3]);
        if (k1 < 9) { pw.z = pk2(sacc[k1 < 9 ? k1 : 8][0], sacc[k1 < 9 ? k1 : 8][1]); pw.w = pk2(sacc[k1 < 9 ? k1 : 8][2], sacc[k1 < 9 ? k1 : 8][3]); } else { pw.z = 0u; pw.w = 0u; }
        const bf16x8 pf = __builtin_bit_cast(bf16x8, pw);
#pragma unroll
        for (int et = 0; et < 4; ++et) {
            const int qp = l15 >> 2, pp = l15 & 3;
            const s16x4 lo = __builtin_bit_cast(s16x4, __builtin_amdgcn_ds_read_tr16_b64_v4i16((LAS v4i16_tr*)(lds + A_VT + (16 * (w + k0) + 4 * lq + qp) * AV_PITCH + (16 * et + 4 * pp) * 2)));
            s16x4 hi = (s16x4){0, 0, 0, 0};
            if (k1 < 9) hi = __builtin_bit_cast(s16x4, __builtin_amdgcn_ds_read_tr16_b64_v4i16((LAS v4i16_tr*)(lds + A_VT + (16 * (w + (k1 < 9 ? k1 : 8)) + 4 * lq + qp) * AV_PITCH + (16 * et + 4 * pp) * 2)));
            const bf16x8 vf = (bf16x8){lo[0], lo[1], lo[2], lo[3], hi[0], hi[1], hi[2], hi[3]};
            oacc[et] = __builtin_amdgcn_mfma_f32_16x16x32_bf16(vf, pf, oacc[et], 0, 0, 0);
        }
    }
    const float rden = 1.0f / den;
    const size_t mq = rowb + (size_t)(r + d * (128 * blk + qi));
    bf16* OB = (bf16*)(ws + WS_OBUF); float* LSE = (float*)(ws + WS_LSE);
#pragma unroll
    for (int et = 0; et < 4; ++et) { const f32x4 o = oacc[et] * rden;
        *(GAS unsigned long long*)(OB + mq * 768 + hc + 16 * et + 4 * lq) = (unsigned long long)pk2(o[0], o[1]) | ((unsigned long long)pk2(o[2], o[3]) << 32); }
    if (lq == 0) LSE[mq * 12 + g * 4 + h] = mx + __logf(den);
    if (tid == 0) F.MISC[next_slot] = next_unit;
    __syncthreads();
}

__device__ __forceinline__ void p2d_attn_merge(Frame& F, unsigned char* ws) {
    const int gw = F.vcu * NWAVES + F.wave, NGW = F.G * NWAVES, lane = F.lane;
    const bf16* OB = (const bf16*)(ws + WS_OBUF); const float* LSE = (const float*)(ws + WS_LSE); bf16* AT = (bf16*)(ws + WS_ATTN);
    const int c = 4 * lane, h = lane >> 4;
    const bool cls_map = NGW * 8 == NTOK_P; const int cls_w = NGW / 8 > 0 ? NGW / 8 : 1, cls = gw / cls_w, wl_ = gw - cls * cls_w;
    const int npass = cls_map ? 3 : (MPAD + 4 * NGW - 1) / (4 * NGW);
    for (int pass = 0; pass < npass; ++pass) {
        int mrow[4];
#pragma unroll
        for (int u = 0; u < 4; ++u) { mrow[u] = MPAD;
            if (!cls_map) mrow[u] = gw + (4 * pass + u) * NGW;
            else if (pass < 2) mrow[u] = gw * 8 + 4 * pass + u;
            else if (u == 0 && wl_ < 16) mrow[u] = NTOK_P + 16 * cls + wl_;
            else if (u == 0 && wl_ < 32) mrow[u] = NTOK + 16 * cls + wl_ - 16; }
        float l[4][3]; u32x2_t ob[4][3];
#pragma unroll
        for (int u = 0; u < 4; ++u) { const int m = mrow[u];
#pragma unroll
            for (int g = 0; g < 3; ++g) { l[u][g] = 0.f; ob[u][g] = (u32x2_t){0u, 0u}; }
            if (m < NTOK) {
#pragma unroll
                for (int g = 0; g < 3; ++g) { l[u][g] = LSE[(size_t)m * 12 + 4 * g + h]; ob[u][g] = *(const u32x2_t*)(OB + (size_t)m * 768 + 256 * g + c); } } }
#pragma unroll
        for (int u = 0; u < 4; ++u) { const int m = mrow[u];
            if (m < MPAD) {
                unsigned long long o = 0ull;
                if (m < NTOK) {
                    const float l0 = l[u][0], l1 = l[u][1], l2 = l[u][2];
                    const u32x2_t o0 = ob[u][0], o1 = ob[u][1], o2 = ob[u][2];
                    const float mx = fmaxf(fmaxf(l0, l1), l2);
                    float a0 = __expf(l0 - mx), a1 = __expf(l1 - mx), a2 = __expf(l2 - mx);
                    const float rs = 1.0f / (a0 + a1 + a2); a0 *= rs; a1 *= rs; a2 *= rs;
                    const float v0 = a0 * bflo(o0.x) + a1 * bflo(o1.x) + a2 * bflo(o2.x), v1 = a0 * bfhi(o0.x) + a1 * bfhi(o1.x) + a2 * bfhi(o2.x);
                    const float v2 = a0 * bflo(o0.y) + a1 * bflo(o1.y) + a2 * bflo(o2.y), v3 = a0 * bfhi(o0.y) + a1 * bfhi(o1.y) + a2 * bfhi(o2.y);
                    o = (unsigned long long)pk2(v0, v1) | ((unsigned long long)pk2(v2, v3) << 32);
                }
                *(GAS unsigned long long*)(AT + (size_t)m * 256 + c) = o;
            } }
    }
}

__device__ __forceinline__ void p8_final(Frame& F, const In& I, unsigned char* ws, float* out, bool sample_only = false) {
    const int gw = F.vcu * NWAVES + F.wave, NGW = F.G * NWAVES, lane = F.lane;
    const bf16* X3 = (const bf16*)(ws + WS_X1); const float* ss3 = (const float*)(ws + WS_STAT) + 3 * (size_t)MPAD;
    f32x4 nf[4];
#pragma unroll
    for (int j = 0; j < 4; ++j) nf[j] = ((const f32x4*)I.norm_final)[lane + 64 * j];
    const bool cls_map = NGW * 8 == NTOK_P;
    const int cls_w = NGW / 8 > 0 ? NGW / 8 : 1, cls = gw / cls_w, wl_ = gw - cls * cls_w;
    const int npass = cls_map ? 3 : (NTOK + 4 * NGW - 1) / (4 * NGW);
    for (int pass = (sample_only && cls_map) ? 2 : 0; pass < npass; ++pass) {
        int mrow[4];
#pragma unroll
        for (int u = 0; u < 4; ++u) { mrow[u] = -1;
            if (!cls_map) { const int m = gw + (4 * pass + u) * NGW; mrow[u] = m < NTOK ? m : -1; }
            else if (pass < 2) mrow[u] = gw * 8 + 4 * pass + u;
            else if (u == 0 && wl_ < 16) mrow[u] = NTOK_P + 16 * cls + wl_; }
        u32x2_t v[4][4]; float q[4];
#pragma unroll
        for (int u = 0; u < 4; ++u) { const int m = mrow[u]; q[u] = 1.f;
#pragma unroll
            for (int j = 0; j < 4; ++j) v[u][j] = (u32x2_t){0u, 0u};
            if (m >= 0) { q[u] = ss3[m]; const u32x2_t* xr = (const u32x2_t*)(X3 + (size_t)m * DM) + lane;
#pragma unroll
                for (int j = 0; j < 4; ++j) v[u][j] = xr[64 * j]; } }
#pragma unroll
        for (int u = 0; u < 4; ++u) { const int m = mrow[u];
            if (m >= 0) {
                const float rs = 1.0f / sqrtf(q[u] * (1.0f / DM) + 1e-6f);
                f32x4* orow = (f32x4*)(out + (m < NTOK_P ? OFF_Y_P + (size_t)m * DM : OFF_Y_S + (size_t)(m - NTOK_P) * DM)) + lane;
#pragma unroll
                for (int j = 0; j < 4; ++j) orow[64 * j] = (f32x4){bflo(v[u][j].x), bfhi(v[u][j].x), bflo(v[u][j].y), bfhi(v[u][j].y)} * rs * nf[j];
            } }
    }
}
constexpr int PA_P = 144;
constexpr int PA_AT = 0, PA_RT = 9216, PA_BT = 18432, PA_KT = 27648;
constexpr int PA_AC = 36864, PA_BGC = 46080, PA_KGC = 55296, PA_VC = 64512;
constexpr int PA_NT = 73728;
constexpr int PA_N01 = 82944;
constexpr int PA_MKA = 85504, PA_NR = 94720, PA_MKR = 103936;
constexpr int PA_TR = 113152;
constexpr int PA_XU = 118272;
constexpr int PA_ND2 = 127488;
constexpr int PA_TT = PA_AT, PA_W1 = PA_BT, PA_U0 = PA_KT;
static_assert(PA_ND2 + 2560 <= RING_BYTES && PA_XU + 9216 <= PA_ND2, "pass A LDS");
constexpr int CH = 64;
constexpr int NUNIT = 32 * (SEQ / CH);
typedef __attribute__((address_space(3))) unsigned char* ldsp_t;
__device__ __forceinline__ bf16x8 lfrag(ldsp_t base, int row, int kbyte) { return *(const LAS bf16x8*)(base + row * PA_P + kbyte); }
typedef short s16x4_t __attribute__((ext_vector_type(4)));
__device__ __forceinline__ bf16x8 cat4(s16x4_t lo, s16x4_t hi) { return (bf16x8){lo[0], lo[1], lo[2], lo[3], hi[0], hi[1], hi[2], hi[3]}; }
__device__ __forceinline__ unsigned short f2bf16(float f) { return (unsigned short)pk2(f, f); }
__device__ __forceinline__ float dppsum16(float v) {
    DPP_ADD(v, 0xb1, 0xf); DPP_ADD(v, 0x4e, 0xf); DPP_ADD(v, 0x141, 0xf); DPP_ADD(v, 0x140, 0xf); return v; }

struct PaBufs { bf16* Pg; bf16* Qg; bf16* Gg; bf16* Yb; float* gam; float* rk; };

struct PaRaw { unsigned short zr[8], zk[8], zv[8], lw[8], aa[8]; unsigned short pr, pk, pv; float mu_r, mu_k, mu_v, kk_c, ka_c, rk_c; };
__device__ __forceinline__ void pa_load(PaRaw& R, const In& I, const bf16* Z, const bf16* LW, const bf16* AA, int unit, int w, int c) {
    const int seq = unit >> 7, ch = unit & 127, b = seq >> 4, h = seq & 15;
    const size_t m0 = (size_t)b * SEQ + (size_t)ch * CH + 8 * w; const unsigned uc = (unsigned)(h * 64 + c);
#pragma unroll
    for (int tt = 0; tt < 8; ++tt) { const bf16* zrow = Z + (m0 + tt) * ZC;
        R.zr[tt] = zrow[uc]; R.zk[tt] = zrow[uc + 1024u]; R.zv[tt] = zrow[uc + 2048u]; R.lw[tt] = LW[(m0 + tt) * 1024 + uc]; R.aa[tt] = AA[(m0 + tt) * 1024 + uc]; }
    if (ch == 0 && w == 0) { R.pr = 0; R.pk = 0; R.pv = 0; }
    else { const bf16* zrow = Z + (m0 - 1) * ZC; R.pr = zrow[uc]; R.pk = zrow[uc + 1024u]; R.pv = zrow[uc + 2048u]; }
    R.mu_r = I.shift_mu[uc]; R.mu_k = I.shift_mu[1024u + uc]; R.mu_v = I.shift_mu[2048u + uc]; R.kk_c = I.k_k[uc]; R.ka_c = I.k_a[uc]; R.rk_c = I.r_k[uc];
}

__device__ __forceinline__ void passA_unit(Frame& F, const In& I, const PaBufs& B, int unit, PaRaw& R, int next_unit, const bf16* Zc, const bf16* LWc, const bf16* AAc) {
    int lane = F.lane; asm volatile("" : "+v"(lane));
    const int w = F.wave; int r = lane & 15, q = lane >> 4;
    const int seq = unit >> 7, ch = unit & 127, bb_ = seq >> 4, h = seq & 15;
    const size_t row0 = (size_t)bb_ * SEQ + (size_t)ch * CH;
    ldsp_t L = F.lds + RING_OFF;
#ifdef PROBE_PA_REP
#define REP_BEGIN(n) _Pragma("unroll 1") for (int rep_ = 0; rep_ < ((n) == PROBE_PA_REP ? 2 : 1); ++rep_) {
#define REP_END() }
#else
#define REP_BEGIN(n) {
#define REP_END() }
#endif
#define PA_RELAUNDER() do { asm volatile("" : "+v"(lane)); r = lane & 15; q = lane >> 4; } while (0)
    REP_BEGIN(1)
    {
        const int c = lane, col = h * 64 + c;
        const float mu_r = R.mu_r, mu_k = R.mu_k, mu_v = R.mu_v, kk_c = R.kk_c, ka_c = R.ka_c, rk_c = R.rk_c;
        float rr[8], kkn[8], kp[8], bb[8], vv[8], lw[8], ll[8], s1[8], s2[8], kkv[8];
        float pr = bf2f(R.pr), pk = bf2f(R.pk), pv = bf2f(R.pv), run = 0.f;
#pragma unroll
        for (int tt = 0; tt < 8; ++tt) {
            const float zr = bf2f(R.zr[tt]), zk = bf2f(R.zk[tt]), zv = bf2f(R.zv[tt]), aa = bf2f(R.aa[tt]);
            const float rv = zr + (pr - zr) * mu_r, kv = zk + (pk - zk) * mu_k; vv[tt] = zv + (pv - zv) * mu_v; pr = zr; pk = zk; pv = zv;
            kkv[tt] = kv * kk_c; kp[tt] = kv * (1.0f + (aa - 1.0f) * ka_c); rr[tt] = rv; bb[tt] = aa;
            s1[tt] = kkv[tt] * kkv[tt]; s2[tt] = rv * kp[tt] * rk_c;
            lw[tt] = bf2f(R.lw[tt]); run += lw[tt]; ll[tt] = run;
        }
#define PA_DPP8(x, ctrl, rmask) _Pragma("unroll") for (int tt = 0; tt < 8; ++tt) DPP_ADD(x[tt], ctrl, rmask)
        PA_DPP8(s1, 0xb1, 0xf); PA_DPP8(s2, 0xb1, 0xf); PA_DPP8(s1, 0x4e, 0xf); PA_DPP8(s2, 0x4e, 0xf); PA_DPP8(s1, 0x114, 0xf); PA_DPP8(s2, 0x114, 0xf);
        PA_DPP8(s1, 0x118, 0xf); PA_DPP8(s2, 0x118, 0xf); PA_DPP8(s1, 0x142, 0xa); PA_DPP8(s2, 0x142, 0xa); PA_DPP8(s1, 0x143, 0xc); PA_DPP8(s2, 0x143, 0xc);
#undef PA_DPP8
#pragma unroll
        for (int tt = 0; tt < 8; ++tt) {
            const float n2 = __builtin_bit_cast(float, __builtin_amdgcn_readlane(__builtin_bit_cast(int, s1[tt]), 63)), rk = __builtin_bit_cast(float, __builtin_amdgcn_readlane(__builtin_bit_cast(int, s2[tt]), 63));
            kkn[tt] = kkv[tt] / fmaxf(sqrtf(n2), 1e-12f); bb[tt] = kkn[tt] * bb[tt];
            if (lane == 0) B.rk[(row0 + 8 * w + tt) * 16 + h] = rk;
        }
        LAS float* pre = (LAS float*)(L + PA_NT);
        pre[w * 64 + c] = run;
        __syncthreads();
        float off = 0.f, tot = 0.f;
#pragma unroll
        for (int ww = 0; ww < 8; ++ww) { const float p = pre[ww * 64 + c]; tot += p; if (ww < w) off += p; }
        const float etot = __expf(tot);
        if (w == 0) B.gam[(size_t)unit * 64 + c] = etot;
        unsigned short a_[8], r_[8], b_[8], k_[8], bg_[8], kg_[8], v_[8];
        float e1 = __expf(off);
#pragma unroll
        for (int tt = 0; tt < 8; ++tt) {
            const float Lc = off + ll[tt], e3 = __expf(Lc), e2 = __expf(-Lc), eg = etot * e2;
            a_[tt] = f2bf16(-kkn[tt] * e1); r_[tt] = f2bf16(rr[tt] * e3); b_[tt] = f2bf16(bb[tt] * e2); k_[tt] = f2bf16(kp[tt] * e2);
            bg_[tt] = f2bf16(bb[tt] * eg); kg_[tt] = f2bf16(kp[tt] * eg); v_[tt] = f2bf16(vv[tt]);
            e1 = e3;
            const int t = 8 * w + tt;
            *(LAS unsigned short*)(L + PA_AT + t * PA_P + 2 * c) = a_[tt]; *(LAS unsigned short*)(L + PA_RT + t * PA_P + 2 * c) = r_[tt];
            *(LAS unsigned short*)(L + PA_BT + t * PA_P + 2 * c) = b_[tt]; *(LAS unsigned short*)(L + PA_KT + t * PA_P + 2 * c) = k_[tt];
        }
#define PK8(x) (v4u){(unsigned)x[0] | ((unsigned)x[1] << 16), (unsigned)x[2] | ((unsigned)x[3] << 16), (unsigned)x[4] | ((unsigned)x[5] << 16), (unsigned)x[6] | ((unsigned)x[7] << 16)}
        *(LAS v4u*)(L + PA_AC + c * PA_P + 16 * w) = PK8(a_); *(LAS v4u*)(L + PA_BGC + c * PA_P + 16 * w) = PK8(bg_);
        *(LAS v4u*)(L + PA_KGC + c * PA_P + 16 * w) = PK8(kg_); *(LAS v4u*)(L + PA_VC + c * PA_P + 16 * w) = PK8(v_);
#undef PK8
    }
    __syncthreads(); PA_RELAUNDER();
    REP_END()
    REP_BEGIN(2)
    {
        const int job = w >> 1, half = w & 1;
        ldsp_t Am = L + (job < 2 ? PA_AT : PA_RT), Bm = L + ((job & 1) ? PA_KT : PA_BT);
#pragma unroll
        for (int t2 = 0; t2 < 2; ++t2) {
            const int tt = 2 * half + t2;
            const bf16x8 a0 = lfrag(Am, 16 * tt + r, 16 * q), a1 = lfrag(Am, 16 * tt + r, 64 + 16 * q);
#pragma unroll
            for (int it = 0; it < 4; ++it) {
                f32x4 acc = (f32x4){0.f, 0.f, 0.f, 0.f};
                if (job == 0) {
                    if (it <= tt) { const bf16x8 b0 = lfrag(Bm, 16 * it + r, 16 * q), b1 = lfrag(Bm, 16 * it + r, 64 + 16 * q);
                        acc = __builtin_amdgcn_mfma_f32_16x16x32_bf16(a0, b0, acc, 0, 0, 0); acc = __builtin_amdgcn_mfma_f32_16x16x32_bf16(a1, b1, acc, 0, 0, 0); }
                    const int i = 16 * it + r;
#pragma unroll
                    for (int rg = 0; rg < 4; ++rg) { const int t = 16 * tt + 4 * q + rg; if (!(i < t)) acc[rg] = 0.f; }
                    *(LAS u32x2_t*)(L + PA_NT + i * PA_P + (16 * tt + 4 * q) * 2) = (u32x2_t){pk2(acc[0], acc[1]), pk2(acc[2], acc[3])};
                    if (it == tt) *(LAS f32x4*)(L + (tt < 2 ? PA_N01 + tt * 1280 : PA_ND2 + (tt - 2) * 1280) + r * 80 + 16 * q) = acc;
                } else {
                    if (it <= tt) { const bf16x8 b0 = lfrag(Bm, 16 * it + r, 16 * q), b1 = lfrag(Bm, 16 * it + r, 64 + 16 * q);
                        acc = __builtin_amdgcn_mfma_f32_16x16x32_bf16(b0, a0, acc, 0, 0, 0); acc = __builtin_amdgcn_mfma_f32_16x16x32_bf16(b1, a1, acc, 0, 0, 0); }
                    const int t = 16 * tt + r;
#pragma unroll
                    for (int rg = 0; rg < 4; ++rg) { const int i = 16 * it + 4 * q + rg; const bool keep = (job == 1) ? (i < t) : (i <= t); if (!keep) acc[rg] = 0.f; }
                    ldsp_t Om = L + (job == 1 ? PA_MKA : (job == 2 ? PA_NR : PA_MKR));
                    *(LAS u32x2_t*)(Om + t * PA_P + (16 * it + 4 * q) * 2) = (u32x2_t){pk2(acc[0], acc[1]), pk2(acc[2], acc[3])};
                }
            }
        }
    }
    __syncthreads(); PA_RELAUNDER();
    REP_END()
    REP_BEGIN(3)
    if (w == 0) {
        const int blk = lane >> 4, i = lane & 15;
        f32x2_t tr[8];
#pragma unroll
        for (int p2 = 0; p2 < 8; ++p2) tr[p2] = (f32x2_t){(2 * p2 == i) ? 1.f : 0.f, (2 * p2 + 1 == i) ? 1.f : 0.f};
        const LAS float* nb = (const LAS float*)(L + (blk < 2 ? PA_N01 + blk * 1280 : PA_ND2 + (blk - 2) * 1280));
#pragma unroll
        for (int j = 0; j < 15; ++j) {
            const LAS float* nbj = nb;
            if (j > 2) { const float dep = ((j - 3) & 1) ? tr[(j - 3) >> 1].y : tr[(j - 3) >> 1].x; asm volatile("" : "+v"(nbj) : "v"(dep)); } else asm volatile("" : "+v"(nbj));
            f32x4 cur[4];
#pragma unroll
            for (int q4 = (j + 1) / 4; q4 < 4; ++q4) cur[q4] = *(const LAS f32x4*)(nbj + j * 20 + 4 * q4);
            const float sc = (j & 1) ? tr[j >> 1].y : tr[j >> 1].x;
            const f32x2_t sc2 = {sc, sc};
#pragma unroll
            for (int p2 = (j + 1) >> 1; p2 < 8; ++p2) tr[p2] += sc2 * ((p2 & 1) ? __builtin_shufflevector(cur[p2 >> 1], cur[p2 >> 1], 2, 3) : __builtin_shufflevector(cur[p2 >> 1], cur[p2 >> 1], 0, 1));
        }
        unsigned tp[8];
#pragma unroll
        for (int p2 = 0; p2 < 8; ++p2) { tp[p2] = pk2(tr[p2].x, tr[p2].y);
            *(LAS unsigned short*)(L + PA_TT + (16 * blk + 2 * p2) * PA_P + (16 * blk + i) * 2) = (unsigned short)(tp[p2] & 0xffffu);
            *(LAS unsigned short*)(L + PA_TT + (16 * blk + 2 * p2 + 1) * PA_P + (16 * blk + i) * 2) = (unsigned short)(tp[p2] >> 16); }
        *(LAS v4u*)(L + PA_TR + blk * 768 + i * 48) = (v4u){tp[0], tp[1], tp[2], tp[3]}; *(LAS v4u*)(L + PA_TR + blk * 768 + i * 48 + 16) = (v4u){tp[4], tp[5], tp[6], tp[7]};
    } else if (w == 1) {
        const int t = lane;
#pragma unroll
        for (int bb2 = 0; bb2 < 4; ++bb2) if (bb2 != (t >> 4)) { *(LAS v4u*)(L + PA_TT + t * PA_P + 32 * bb2) = (v4u){0u, 0u, 0u, 0u}; *(LAS v4u*)(L + PA_TT + t * PA_P + 32 * bb2 + 16) = (v4u){0u, 0u, 0u, 0u}; }
    } else if (w >= 4) {
        const int vt = w - 4;
        const bf16x8 a0 = lfrag(L + PA_VC, 16 * vt + r, 16 * q), a1 = lfrag(L + PA_VC, 16 * vt + r, 64 + 16 * q);
#pragma unroll
        for (int tt = 0; tt < 4; ++tt) {
            const bf16x8 b0 = lfrag(L + PA_MKA, 16 * tt + r, 16 * q), b1 = lfrag(L + PA_MKA, 16 * tt + r, 64 + 16 * q);
            f32x4 acc = (f32x4){0.f, 0.f, 0.f, 0.f};
            acc = __builtin_amdgcn_mfma_f32_16x16x32_bf16(b0, a0, acc, 0, 0, 0); acc = __builtin_amdgcn_mfma_f32_16x16x32_bf16(b1, a1, acc, 0, 0, 0);
            *(LAS u32x2_t*)(L + PA_XU + (16 * vt + r) * PA_P + (16 * tt + 4 * q) * 2) = (u32x2_t){pk2(acc[0], acc[1]), pk2(acc[2], acc[3])};
        }
    }
    __syncthreads(); PA_RELAUNDER();
    REP_END()
    REP_BEGIN(4)
#pragma unroll
    for (int lev = 1; lev <= 3; ++lev) {
        if (w + lev <= 3) {
            const int a = w, b = w + lev;
            f32x4 m = (f32x4){0.f, 0.f, 0.f, 0.f};
            if (a == 0) m = __builtin_amdgcn_mfma_f32_16x16x32_bf16(lfrag(L + PA_NT, 16 * a + r, 16 * q), lfrag(L + PA_TT, 16 * b + r, 16 * q), m, 0, 0, 0);
            if (a >= 1 || b >= 2) m = __builtin_amdgcn_mfma_f32_16x16x32_bf16(lfrag(L + PA_NT, 16 * a + r, 64 + 16 * q), lfrag(L + PA_TT, 16 * b + r, 64 + 16 * q), m, 0, 0, 0);
            const u32x4_t mp = (u32x4_t){pk2(m[0], m[1]), pk2(m[2], m[3]), 0u, 0u};
            const s16x4_t alo = *(const LAS s16x4_t*)(L + PA_TR + a * 768 + r * 48 + (4 * q) * 2);
            f32x4 acc = (f32x4){0.f, 0.f, 0.f, 0.f};
            acc = __builtin_amdgcn_mfma_f32_16x16x32_bf16(cat4(alo, (s16x4_t){0, 0, 0, 0}), __builtin_bit_cast(bf16x8, mp), acc, 0, 0, 0);
            *(LAS u32x2_t*)(L + PA_TT + (16 * b + r) * PA_P + (16 * a + 4 * q) * 2) = (u32x2_t){pk2(acc[0], acc[1]), pk2(acc[2], acc[3])};
        }
        __syncthreads(); PA_RELAUNDER();
    }
    REP_END()
    if (next_unit < NUNIT) pa_load(R, I, Zc, LWc, AAc, next_unit, w, lane);
    REP_BEGIN(5)
    {
        const int rt = w & 3;
        ldsp_t Am = L + (w < 4 ? PA_AC : PA_XU), Om = L + (w < 4 ? PA_W1 : PA_U0);
        const bf16x8 a0 = lfrag(Am, 16 * rt + r, 16 * q), a1 = lfrag(Am, 16 * rt + r, 64 + 16 * q);
#pragma unroll
        for (int tt = 0; tt < 4; ++tt) {
            const bf16x8 b0 = lfrag(L + PA_TT, 16 * tt + r, 16 * q), b1 = lfrag(L + PA_TT, 16 * tt + r, 64 + 16 * q);
            f32x4 acc = (f32x4){0.f, 0.f, 0.f, 0.f};
            acc = __builtin_amdgcn_mfma_f32_16x16x32_bf16(b0, a0, acc, 0, 0, 0); acc = __builtin_amdgcn_mfma_f32_16x16x32_bf16(b1, a1, acc, 0, 0, 0);
            *(LAS u32x2_t*)(Om + (16 * rt + r) * PA_P + (16 * tt + 4 * q) * 2) = (u32x2_t){pk2(acc[0], acc[1]), pk2(acc[2], acc[3])};
        }
    }
    __syncthreads(); PA_RELAUNDER();
    REP_END()
    REP_BEGIN(6)
    if (w < 4) {
        const int kt = w;
        {
            const bf16x8 a0 = lfrag(L + PA_W1, 16 * kt + r, 16 * q), a1 = lfrag(L + PA_W1, 16 * kt + r, 64 + 16 * q);
#pragma unroll
            for (int k2 = 0; k2 < 4; ++k2) {
                const bf16x8 b0 = lfrag(L + PA_BGC, 16 * k2 + r, 16 * q), b1 = lfrag(L + PA_BGC, 16 * k2 + r, 64 + 16 * q);
                f32x4 acc = (f32x4){0.f, 0.f, 0.f, 0.f};
                acc = __builtin_amdgcn_mfma_f32_16x16x32_bf16(a0, b0, acc, 0, 0, 0); acc = __builtin_amdgcn_mfma_f32_16x16x32_bf16(a1, b1, acc, 0, 0, 0);
                *(LAS u32x2_t*)(L + PA_AC + (16 * k2 + r) * PA_P + (32 * (kt >> 1) + 8 * q + 4 * (kt & 1)) * 2) = (u32x2_t){pk2(acc[0], acc[1]), pk2(acc[2], acc[3])};
            }
        }
        {
            const bf16x8 a0 = lfrag(L + PA_BGC, 16 * kt + r, 16 * q), a1 = lfrag(L + PA_BGC, 16 * kt + r, 64 + 16 * q), a2 = lfrag(L + PA_KGC, 16 * kt + r, 16 * q), a3 = lfrag(L + PA_KGC, 16 * kt + r, 64 + 16 * q);
#pragma unroll
            for (int vt = 0; vt < 4; ++vt) {
                const bf16x8 b0 = lfrag(L + PA_U0, 16 * vt + r, 16 * q), b1 = lfrag(L + PA_U0, 16 * vt + r, 64 + 16 * q), b2 = lfrag(L + PA_VC, 16 * vt + r, 16 * q), b3 = lfrag(L + PA_VC, 16 * vt + r, 64 + 16 * q);
                f32x4 acc = (f32x4){0.f, 0.f, 0.f, 0.f};
                acc = __builtin_amdgcn_mfma_f32_16x16x32_bf16(a0, b0, acc, 0, 0, 0); acc = __builtin_amdgcn_mfma_f32_16x16x32_bf16(a1, b1, acc, 0, 0, 0);
                acc = __builtin_amdgcn_mfma_f32_16x16x32_bf16(a2, b2, acc, 0, 0, 0); acc = __builtin_amdgcn_mfma_f32_16x16x32_bf16(a3, b3, acc, 0, 0, 0);
                *(LAS u32x2_t*)(L + PA_NT + (16 * vt + r) * PA_P + (16 * kt + 4 * q) * 2) = (u32x2_t){pk2(acc[0], acc[1]), pk2(acc[2], acc[3])};
            }
        }
    } else {
        const int xt = w - 4;
        {
            const bf16x8 a0 = lfrag(L + PA_W1, 16 * xt + r, 16 * q), a1 = lfrag(L + PA_W1, 16 * xt + r, 64 + 16 * q);
#pragma unroll
            for (int tt = 0; tt < 4; ++tt) {
                const bf16x8 b0 = lfrag(L + PA_NR, 16 * tt + r, 16 * q), b1 = lfrag(L + PA_NR, 16 * tt + r, 64 + 16 * q);
                const u32x2_t rv = *(const LAS u32x2_t*)(L + PA_RT + (16 * tt + r) * PA_P + (16 * xt + 4 * q) * 2);
                f32x4 acc = (f32x4){bflo(rv.x), bfhi(rv.x), bflo(rv.y), bfhi(rv.y)};
                acc = __builtin_amdgcn_mfma_f32_16x16x32_bf16(a0, b0, acc, 0, 0, 0); acc = __builtin_amdgcn_mfma_f32_16x16x32_bf16(a1, b1, acc, 0, 0, 0);
                *(LAS u32x2_t*)(L + PA_MKA + (16 * tt + r) * PA_P + (16 * xt + 4 * q) * 2) = (u32x2_t){pk2(acc[0], acc[1]), pk2(acc[2], acc[3])};
            }
        }
        {
            const bf16x8 a0 = lfrag(L + PA_U0, 16 * xt + r, 16 * q), a1 = lfrag(L + PA_U0, 16 * xt + r, 64 + 16 * q), a2 = lfrag(L + PA_VC, 16 * xt + r, 16 * q), a3 = lfrag(L + PA_VC, 16 * xt + r, 64 + 16 * q);
#pragma unroll
            for (int tt = 0; tt < 4; ++tt) {
                const bf16x8 b0 = lfrag(L + PA_NR, 16 * tt + r, 16 * q), b1 = lfrag(L + PA_NR, 16 * tt + r, 64 + 16 * q), b2 = lfrag(L + PA_MKR, 16 * tt + r, 16 * q), b3 = lfrag(L + PA_MKR, 16 * tt + r, 64 + 16 * q);
                f32x4 acc = (f32x4){0.f, 0.f, 0.f, 0.f};
                acc = __builtin_amdgcn_mfma_f32_16x16x32_bf16(a0, b0, acc, 0, 0, 0); acc = __builtin_amdgcn_mfma_f32_16x16x32_bf16(a1, b1, acc, 0, 0, 0);
                acc = __builtin_amdgcn_mfma_f32_16x16x32_bf16(a2, b2, acc, 0, 0, 0); acc = __builtin_amdgcn_mfma_f32_16x16x32_bf16(a3, b3, acc, 0, 0, 0);
                *(LAS u32x2_t*)(L + PA_XU + (16 * tt + r) * PA_P + (16 * xt + 4 * q) * 2) = (u32x2_t){pk2(acc[0], acc[1]), pk2(acc[2], acc[3])};
            }
        }
    }
    __syncthreads(); PA_RELAUNDER();
    {
        const int row = 8 * w + (lane >> 3), cb = (lane & 7) * 16;
        *(v4u*)((char*)(B.Pg + (size_t)unit * 4096) + row * 128 + cb) = *(const LAS v4u*)(L + PA_AC + row * PA_P + cb);
        *(v4u*)((char*)(B.Qg + (size_t)unit * 4096) + row * 128 + cb) = *(const LAS v4u*)(L + PA_NT + row * PA_P + cb);
        *(v4u*)((char*)(B.Gg + (size_t)unit * 4096) + row * 128 + cb) = *(const LAS v4u*)(L + PA_MKA + row * PA_P + cb);
        *(v4u*)((char*)(B.Yb + (size_t)unit * 4096) + row * 128 + cb) = *(const LAS v4u*)(L + PA_XU + row * PA_P + cb);
    }
    __syncthreads();
    REP_END()
#undef PA_RELAUNDER
#undef REP_BEGIN
#undef REP_END
}

struct ChOp { bf16x8 pf[4][2]; u32x2_t qv[4]; f32x4 g4[4]; };
__device__ __forceinline__ void ch_load(ChOp& o, const PaBufs& B, size_t unit, int ct, int a, int q) {
    const bf16* Pg = B.Pg + unit * 4096; const bf16* Qg = B.Qg + unit * 4096; const float* gm = B.gam + unit * 64;
#pragma unroll
    for (int rt = 0; rt < 4; ++rt) {
        o.qv[rt] = *(const u32x2_t*)(Qg + (16 * ct + a) * 64 + 16 * rt + 4 * q); o.g4[rt] = *(const f32x4*)(gm + 16 * rt + 4 * q);
#pragma unroll
        for (int ks = 0; ks < 2; ++ks) o.pf[rt][ks] = *(const bf16x8*)(Pg + (16 * rt + a) * 64 + 32 * ks + 8 * q);
    }
}
template <bool STORE> __device__ __forceinline__ void ch_step(f32x4 (&st)[4], const ChOp& o, const PaBufs& B, size_t unit, int ct, int a, int q) {
    bf16x8 sf[2]; u32x2_t sb[4];
#pragma unroll
    for (int rt = 0; rt < 4; ++rt) sb[rt] = (u32x2_t){pk2(st[rt][0], st[rt][1]), pk2(st[rt][2], st[rt][3])};
#pragma unroll
    for (int ks = 0; ks < 2; ++ks) sf[ks] = __builtin_bit_cast(bf16x8, (u32x4_t){sb[2 * ks].x, sb[2 * ks].y, sb[2 * ks + 1].x, sb[2 * ks + 1].y});
    bf16* Qg = B.Qg + unit * 4096;
#pragma unroll
    for (int rt = 0; rt < 4; ++rt) if (STORE) *(u32x2_t*)(Qg + (16 * ct + a) * 64 + 16 * rt + 4 * q) = sb[rt];
    f32x4 nw[4];
#pragma unroll
    for (int rt = 0; rt < 4; ++rt) {
        f32x4 acc = (f32x4){bflo(o.qv[rt].x), bfhi(o.qv[rt].x), bflo(o.qv[rt].y), bfhi(o.qv[rt].y)} + st[rt] * o.g4[rt];
#pragma unroll
        for (int ks = 0; ks < 2; ++ks) acc = __builtin_amdgcn_mfma_f32_16x16x32_bf16(o.pf[rt][ks], sf[ks], acc, 0, 0, 0);
        nw[rt] = acc;
    }
#pragma unroll
    for (int rt = 0; rt < 4; ++rt) st[rt] = nw[rt];
}
template <bool STORE> __device__ __forceinline__ void chain2(Frame& F, const PaBufs& B, float* out, int seq, int ct, unsigned* prog) {
    const int lane = F.lane, a = lane & 15, q = lane >> 4;
    f32x4 st[4];
#pragma unroll
    for (int rt = 0; rt < 4; ++rt) st[rt] = (f32x4){0.f, 0.f, 0.f, 0.f};
    const size_t u0 = (size_t)seq * (SEQ / CH);
    ChOp oa, ob, oc;
    ch_load(oa, B, u0, ct, a, q); ch_load(ob, B, u0 + 1, ct, a, q);
    int c = 0;
    for (; c + 3 <= SEQ / CH - 2; c += 3) {
        ch_load(oc, B, u0 + c + 2, ct, a, q); ch_step<STORE>(st, oa, B, u0 + c, ct, a, q);
        ch_load(oa, B, u0 + c + 3, ct, a, q); ch_step<STORE>(st, ob, B, u0 + c + 1, ct, a, q);
        ch_load(ob, B, u0 + c + 4, ct, a, q); ch_step<STORE>(st, oc, B, u0 + c + 2, ct, a, q);
    }
    ch_step<STORE>(st, oa, B, u0 + c, ct, a, q); ch_step<STORE>(st, ob, B, u0 + c + 1, ct, a, q);
    float* dst = out + OFF_WKV_P + (size_t)seq * 4096 + (size_t)(16 * ct + a) * 64 + 4 * q;
#pragma unroll
    for (int rt = 0; rt < 4; ++rt) { if (STORE) *(f32x4*)(dst + 16 * rt) = st[rt]; else asm volatile("" :: "v"(st[rt])); }
}

struct ChOp3 { bf16x8 pf[4][2]; u32x2_t qv[4]; };
__device__ __forceinline__ void ch_load3(ChOp3& o, const PaBufs& B, size_t unit, int ct, int a, int q) {
    const bf16* Pg = B.Pg + unit * 4096; const bf16* Qg = B.Qg + unit * 4096;
#pragma unroll
    for (int rt = 0; rt < 4; ++rt) {
        o.qv[rt] = *(const u32x2_t*)(Qg + (16 * ct + a) * 64 + 16 * rt + 4 * q);
#pragma unroll
        for (int ks = 0; ks < 2; ++ks) o.pf[rt][ks] = *(const bf16x8*)(Pg + (16 * rt + a) * 64 + 32 * ks + 8 * q);
    }
}
__device__ __forceinline__ void ch_gam_stage(LAS float* tbl, const float* gm, int lane) {
    f32x4 v[16];
#pragma unroll
    for (int i = 0; i < 16; ++i) v[i] = *(const f32x4*)(gm + (size_t)(i * 64 + lane) * 4);
#pragma unroll
    for (int i = 0; i < 16; ++i) *(LAS f32x4*)(tbl + (i * 64 + lane) * 4) = v[i];
}
__device__ __forceinline__ void ch_gam_read(f32x4 (&g)[4], const LAS float* tbl, int c, int q) {
#pragma unroll
    for (int rt = 0; rt < 4; ++rt) g[rt] = *(const LAS f32x4*)(tbl + (c & 63) * 64 + 16 * rt + 4 * q);
}
__device__ __forceinline__ void ch_step3(f32x4 (&st)[4], const ChOp3& o, const f32x4 (&g4)[4], const PaBufs& B, size_t unit, int ct, int a, int q) {
    bf16x8 sf[2]; u32x2_t sb[4];
#pragma unroll
    for (int rt = 0; rt < 4; ++rt) sb[rt] = (u32x2_t){pk2(st[rt][0], st[rt][1]), pk2(st[rt][2], st[rt][3])};
#pragma unroll
    for (int ks = 0; ks < 2; ++ks) sf[ks] = __builtin_bit_cast(bf16x8, (u32x4_t){sb[2 * ks].x, sb[2 * ks].y, sb[2 * ks + 1].x, sb[2 * ks + 1].y});
    bf16* Qg = B.Qg + unit * 4096;
#pragma unroll
    for (int rt = 0; rt < 4; ++rt) *(u32x2_t*)(Qg + (16 * ct + a) * 64 + 16 * rt + 4 * q) = sb[rt];
    f32x4 nw[4];
#pragma unroll
    for (int rt = 0; rt < 4; ++rt) nw[rt] = (f32x4){bflo(o.qv[rt].x), bfhi(o.qv[rt].x), bflo(o.qv[rt].y), bfhi(o.qv[rt].y)} + st[rt] * g4[rt];
#pragma unroll
    for (int rt = 0; rt < 4; ++rt) nw[rt] = __builtin_amdgcn_mfma_f32_16x16x32_bf16(o.pf[rt][0], sf[0], nw[rt], 0, 0, 0);
#pragma unroll
    for (int rt = 0; rt < 4; ++rt) nw[rt] = __builtin_amdgcn_mfma_f32_16x16x32_bf16(o.pf[rt][1], sf[1], nw[rt], 0, 0, 0);
#pragma unroll
    for (int rt = 0; rt < 4; ++rt) st[rt] = nw[rt];
}
__device__ __forceinline__ void chain3(Frame& F, const PaBufs& B, float* out, int seq, int ct, LAS float* tbl) {
    const int lane = F.lane, a = lane & 15, q = lane >> 4;
    constexpr int NS = SEQ / CH;
    f32x4 st[4];
#pragma unroll
    for (int rt = 0; rt < 4; ++rt) st[rt] = (f32x4){0.f, 0.f, 0.f, 0.f};
    const size_t u0 = (size_t)seq * NS;
    const float* gm0 = B.gam + u0 * 64;
    ch_gam_stage(tbl, gm0, lane);
    ChOp3 o0, o1, o2, o3; f32x4 g[4];
    ch_load3(o0, B, u0, ct, a, q); ch_load3(o1, B, u0 + 1, ct, a, q); ch_load3(o2, B, u0 + 2, ct, a, q);
#define CH_CL(i) (u0 + ((i) < NS ? (i) : NS - 1))
#pragma unroll 1
    for (int c = 0; c < NS; c += 4) {
        const bool rs = c >= 16 && c < 80; const int cq = c & ~15, sub = (c & 15) >> 2;
        f32x4 gv = (f32x4){0.f, 0.f, 0.f, 0.f};
        if (rs) gv = *(const f32x4*)(gm0 + (size_t)(cq + 48) * 64 + (sub * 64 + lane) * 4);
        ch_load3(o3, B, CH_CL(c + 3), ct, a, q); ch_gam_read(g, tbl, c, q);     ch_step3(st, o0, g, B, u0 + c, ct, a, q);
        ch_load3(o0, B, CH_CL(c + 4), ct, a, q); ch_gam_read(g, tbl, c + 1, q); ch_step3(st, o1, g, B, u0 + c + 1, ct, a, q);
        ch_load3(o1, B, CH_CL(c + 5), ct, a, q); ch_gam_read(g, tbl, c + 2, q); ch_step3(st, o2, g, B, u0 + c + 2, ct, a, q);
        ch_load3(o2, B, CH_CL(c + 6), ct, a, q); ch_gam_read(g, tbl, c + 3, q); ch_step3(st, o3, g, B, u0 + c + 3, ct, a, q);
        if (rs) *(LAS f32x4*)(tbl + ((cq + 48) & 63) * 64 + (sub * 64 + lane) * 4) = gv;
    }
#undef CH_CL
    float* dst = out + OFF_WKV_P + (size_t)seq * 4096 + (size_t)(16 * ct + a) * 64 + 4 * q;
#pragma unroll
    for (int rt = 0; rt < 4; ++rt) *(f32x4*)(dst + 16 * rt) = st[rt];
}

struct FinOp { bf16x8 g0, g1; u32x2_t y0[4], zv[4], zp[4], gv[4]; float rk; };
__device__ __forceinline__ void wkv_finish_unit(Frame& F, const In& I, unsigned char* ws, const PaBufs& B, bf16* RO, int unit) {
    const int lane = F.lane, r = lane & 15, q = lane >> 4;
    const int seq = unit >> 7, ch = unit & 127, bb_ = seq >> 4, h = seq & 15;
    const size_t row0 = (size_t)bb_ * SEQ + (size_t)ch * CH;
    const bf16* Z = (const bf16*)(ws + WS_Z); const bf16* GG = (const bf16*)(ws + WS_GG);
    const bf16* Sg = B.Qg + (size_t)unit * 4096; const bf16* Gg = B.Gg + (size_t)unit * 4096;
    auto fin_load = [&](FinOp& o, int tt) {
        const size_t m = row0 + 16 * tt + r;
        o.g0 = *(const bf16x8*)(Gg + (16 * tt + r) * 64 + 8 * q); o.g1 = *(const bf16x8*)(Gg + (16 * tt + r) * 64 + 32 + 8 * q);
        const bool first = (m & (SEQ - 1)) == 0;
#pragma unroll
        for (int vt = 0; vt < 4; ++vt) { const int c = h * 64 + 16 * vt + 4 * q;
            o.y0[vt] = *(const u32x2_t*)(B.Yb + (size_t)unit * 4096 + (16 * tt + r) * 64 + 16 * vt + 4 * q);
            o.zv[vt] = *(const u32x2_t*)(Z + m * ZC + 2048 + c);
            o.zp[vt] = (u32x2_t){0u, 0u};
            if (r == 0 && !first) o.zp[vt] = *(const u32x2_t*)(Z + (m - 1) * ZC + 2048 + c);
            o.gv[vt] = *(const u32x2_t*)(GG + m * 1024 + c); }
        o.rk = B.rk[m * 16 + h];
    };
    bf16x8 sfr[4][2];
#pragma unroll
    for (int vt = 0; vt < 4; ++vt)
#pragma unroll
        for (int ks = 0; ks < 2; ++ks) sfr[vt][ks] = *(const bf16x8*)(Sg + (16 * vt + r) * 64 + 32 * ks + 8 * q);
    const f32x4 mu[4] = {*(const f32x4*)(I.shift_mu + 2048 + h * 64 + 4 * q), *(const f32x4*)(I.shift_mu + 2048 + h * 64 + 16 + 4 * q), *(const f32x4*)(I.shift_mu + 2048 + h * 64 + 32 + 4 * q), *(const f32x4*)(I.shift_mu + 2048 + h * 64 + 48 + 4 * q)};
    auto fin_compute = [&](const FinOp& o, int tt) {
        const size_t m = row0 + 16 * tt + r;
        f32x4 y[4];
#pragma unroll
        for (int vt = 0; vt < 4; ++vt) {
            f32x4 acc = (f32x4){bflo(o.y0[vt].x), bfhi(o.y0[vt].x), bflo(o.y0[vt].y), bfhi(o.y0[vt].y)};
            if (ch > 0) { acc = __builtin_amdgcn_mfma_f32_16x16x32_bf16(sfr[vt][0], o.g0, acc, 0, 0, 0); acc = __builtin_amdgcn_mfma_f32_16x16x32_bf16(sfr[vt][1], o.g1, acc, 0, 0, 0); }
            y[vt] = acc;
        }
        float sm = 0.f;
#pragma unroll
        for (int vt = 0; vt < 4; ++vt) sm += (y[vt][0] + y[vt][1]) + (y[vt][2] + y[vt][3]);
        sm += __shfl_xor(sm, 16); sm += __shfl_xor(sm, 32);
        const float mean = sm * (1.0f / 64.0f);
        float sq = 0.f;
#pragma unroll
        for (int vt = 0; vt < 4; ++vt) { y[vt] = y[vt] - mean; sq += (y[vt][0] * y[vt][0] + y[vt][1] * y[vt][1]) + (y[vt][2] * y[vt][2] + y[vt][3] * y[vt][3]); }
        sq += __shfl_xor(sq, 16); sq += __shfl_xor(sq, 32);
        const float rs = 1.0f / sqrtf(sq * (1.0f / 64.0f) + 64e-5f);
        const float rk = o.rk;
#pragma unroll
        for (int vt = 0; vt < 4; ++vt) {
            const int c = h * 64 + 16 * vt + 4 * q;
            const u32x2_t zv = o.zv[vt]; u32x2_t zp = o.zp[vt];
            float v0 = bflo(zv.x), v1 = bfhi(zv.x), v2 = bflo(zv.y), v3 = bfhi(zv.y);
            zp.x = (unsigned)__builtin_amdgcn_update_dpp((int)zp.x, (int)zv.x, 0x111, 0xf, 0xf, false); zp.y = (unsigned)__builtin_amdgcn_update_dpp((int)zp.y, (int)zv.y, 0x111, 0xf, 0xf, false);
            const float p0 = bflo(zp.x), p1 = bfhi(zp.x), p2 = bflo(zp.y), p3 = bfhi(zp.y);
            v0 += (p0 - v0) * mu[vt].x; v1 += (p1 - v1) * mu[vt].y; v2 += (p2 - v2) * mu[vt].z; v3 += (p3 - v3) * mu[vt].w;
            const f32x4 lw4 = *(const f32x4*)(I.lnx_w + c), lb4 = *(const f32x4*)(I.lnx_b + c);
            const u32x2_t gv = o.gv[vt];
            const float o0 = (y[vt][0] * rs * lw4.x + lb4.x + rk * v0) * bflo(gv.x), o1 = (y[vt][1] * rs * lw4.y + lb4.y + rk * v1) * bfhi(gv.x);
            const float o2 = (y[vt][2] * rs * lw4.z + lb4.z + rk * v2) * bflo(gv.y), o3 = (y[vt][3] * rs * lw4.w + lb4.w + rk * v3) * bfhi(gv.y);
            *(u32x2_t*)(RO + m * 1024 + c) = (u32x2_t){pk2(o0, o1), pk2(o2, o3)};
        }
    };
    FinOp oa, ob;
    fin_load(oa, 0); fin_load(ob, 1); fin_compute(oa, 0); fin_load(oa, 2); fin_compute(ob, 1); fin_load(ob, 3); fin_compute(oa, 2); fin_compute(ob, 3);
}
#define HELPERS_OFF_CHAIN 1
#ifndef P1_SP2
#define P1_SP2 true
#endif

__global__ void __launch_bounds__(NWAVES * 64, 2) mk_fwd(Args args) {
    extern __shared__ __attribute__((aligned(16))) unsigned char lds[];
    Frame F;
    F.lds = (LAS unsigned char*)lds;
    F.MISC = (volatile LAS unsigned*)(F.lds + MISC_OFF);
    F.tid = threadIdx.x; F.lane = F.tid & 63; F.wave = __builtin_amdgcn_readfirstlane(F.tid >> 6);
    const int wave_idx = F.wave;
    F.G = gridDim.x; { const int bx = blockIdx.x; F.vcu = (F.G % 8 == 0) ? (bx % 8) * (F.G / 8) + bx / 8 : bx; }
    unsigned char* ws = args.ws; float* out = args.out; const In& I = args.in;
    F.ctl = (gu32*)(ws + WS_CTL);
    for (int u = F.tid; u < (LDS_BYTES - LDSCTL_OFF) / 4; u += NWAVES * 64) ((LAS unsigned*)(F.lds + LDSCTL_OFF))[u] = 0u;
    __syncthreads();
    XcdBarrier bar = xcd_barrier_post((unsigned*)(F.ctl + CW_BAR), F.MISC + 8);
    unsigned* const lbar = (unsigned*)(F.ctl + CW_LBAR);
    if (threadIdx.x == 0 && (bar.x != (blockIdx.x & 7u) || (gridDim.x & 7u) != 0u || gridDim.x * NWAVES * 8u != (unsigned)NTOK_P)) (void)xb_add(&lbar[LB_MISM], 1u);
#define GRID_BAR() do { xcd_barrier(bar, mk_tid(wave_idx)); int t_ = mk_tid(wave_idx); asm volatile("" : "+v"(t_)); F.tid = t_; F.lane = t_ & 63; F.wave = wave_idx; } while (0)
#define GROUP_BAR() do { if (F.MISC[10] != 0u) xcd_local_barrier(bar, lbar, mk_tid(wave_idx)); else xcd_barrier(bar, mk_tid(wave_idx)); int t_ = mk_tid(wave_idx); asm volatile("" : "+v"(t_)); F.tid = t_; F.lane = t_ & 63; F.wave = wave_idx; } while (0)
    const int bx = (int)blockIdx.x;
#ifdef PROBE_HALF
#define GP_SEL(n) ((n) == PROBE_HALF || (PROBE_HALF == 3 && (n) == 4) || (PROBE_HALF == 8 && (n) == 9))
#define GP_G(n) (GP_SEL(n) ? F.G / 2 : F.G)
#define GP_C(n) (GP_SEL(n) ? (bx < F.G / 2 ? bx : (1 << 28)) : bx)
#else
#define GP_G(n) F.G
#define GP_C(n) bx
#endif
    bf16* XB = (bf16*)(ws + WS_XB); bf16* Zb = (bf16*)(ws + WS_Z); float* stat = (float*)(ws + WS_STAT);
    float* ss1 = stat + MPAD; float* ss2 = stat + 2 * (size_t)MPAD; float* ss3 = stat + 3 * (size_t)MPAD;

    p0_prologue(F, I, ws);
#ifdef P0LATE_IN_P0
    p0_late(F, I, ws, F.vcu * NWAVES + F.wave, F.G * NWAVES, 0, 1 << 30, 0, 1 << 30);
#endif
#ifdef PROBE_P0
    __syncthreads(); p0_prologue(F, I, ws);
#endif
    GRID_BAR();
    if (F.tid == 0) F.MISC[10] = (xb_ld(&lbar[LB_MISM]) == 0u && F.MISC[9] == 8u && F.MISC[8] * 8u == gridDim.x) ? 1u : 0u;
    __syncthreads();
    constexpr int LATE_SPLIT_IT = 2944, LATE_SPLIT_M = 8320;
    {
        pg8::Gemm g{XB, (const bf16*)(ws + WS_WIN), MPAD, ZC, DM}; pg8::StaticOrder S; S.init(MPAD, ZC, GP_G(1), GP_C(1));
        pg8::EpiZ E{Zb, stat, out};
        pg8::gemm_phase<pg8::EpiZ, pg8::StaticOrder, true, true>(wave_idx, F.lds + RING_OFF, g, S, E);
#ifdef PROBE_P1
        VM_WAIT(); __syncthreads();
        pg8::gemm_phase<pg8::EpiZ, pg8::StaticOrder, true, true>(wave_idx, F.lds + RING_OFF, g, S, E);
#endif
    }
    GRID_BAR();
    p2a_all(F, I, ws, out);
#ifdef PROBE_P2A
    for (int rep = 0; rep < 4; ++rep) { asm volatile("" ::: "memory"); p2a_all(F, I, ws, out); }
#endif
    GROUP_BAR();
    {
        pg8::Gemm g{(const bf16*)(ws + WS_ALORA), (const bf16*)(ws + WS_WLORA), NTOK_P, 3072, 256}; pg8::StaticOrder S; S.init(NTOK_P, 3072, GP_G(2), GP_C(2));
        pg8::EpiLora E{(bf16*)(ws + WS_LW), (bf16*)(ws + WS_AA), (bf16*)(ws + WS_GG), I.decay_w0, I.aaa_a0};
        pg8::mini_gemm_nu<pg8::EpiLora, 256, 3>(wave_idx, F.lds + RING_OFF, g.A, g.Bt, g.N, NTOK_P, GP_C(2), GP_G(2), E);
        pg8::gemm_phase<pg8::EpiLora, pg8::StaticOrder, true, true>(wave_idx, F.lds + RING_OFF, g, S, E);
#ifdef PROBE_P2B
        VM_WAIT(); __syncthreads();
        pg8::gemm_phase<pg8::EpiLora, pg8::StaticOrder, true, true>(wave_idx, F.lds + RING_OFF, g, S, E);
#endif
    }
    GROUP_BAR();
    PaBufs PB_; PB_.Pg = (bf16*)(ws + WS_PG); PB_.Gg = (bf16*)(ws + WS_GT); PB_.Yb = (bf16*)(out + OFF_Y_P); PB_.Qg = PB_.Yb + (size_t)NTOK_P * 1024; PB_.gam = (float*)(ws + WS_GAM); PB_.rk = (float*)(ws + WS_RK);
    {
        const bf16* Zc = (const bf16*)(ws + WS_Z); const bf16* LWc = (const bf16*)(ws + WS_LW); const bf16* AAc = (const bf16*)(ws + WS_AA);
        PaRaw raw;
#ifdef PROBE_PASSA
#pragma unroll 1
        for (int rep = 0; rep < 2; ++rep) {
#endif
        const bool pa_cls = F.G * NWAVES * 8 == NTOK_P;
        auto pa_unit = [&](int k) -> int {
            if (pa_cls) { if (k >= 16) return NUNIT; const int c = bx & 7, j = bx >> 3; return (((c >> 2) * 16 + k) * 128) + 32 * (c & 3) + j; }
            const long u = (long)bx + (long)k * F.G; return u < NUNIT ? (int)u : NUNIT; };
        if (pa_unit(0) < NUNIT) pa_load(raw, I, Zc, LWc, AAc, pa_unit(0), F.wave, F.lane);
        for (int k = 0; pa_unit(k) < NUNIT; ++k) passA_unit(F, I, PB_, pa_unit(k), raw, pa_unit(k + 1), Zc, LWc, AAc);
#ifdef PROBE_PASSA
        }
#endif
    }
    GRID_BAR();
    {
        LAS float* wl = (LAS float*)(F.lds + RING_OFF + F.wave * 16384);
        const int NCH = 128, NCW = 1;
#ifdef HELPERS_OFF_CHAIN
        const int nhw = (F.G - NCH) * NWAVES;
#else
        const int nhw = NCH * (NWAVES - NCW) + (F.G - NCH) * NWAVES;
#endif
        int hw = -1;
        const bool xmap = F.G == 256;
        const bool is_chain = xmap ? (bx & 4) == 0 : bx < NCH;
        const int ridx = xmap ? (bx >> 3) * 4 + (bx & 3) : (bx < NCH ? bx : bx - NCH);
        if (is_chain) { if (F.wave < NCW) {
            const int cseq = xmap ? (bx & 3) * 8 + (bx >> 5) : ridx >> 2, cct = xmap ? (bx >> 3) & 3 : ridx & 3;
            chain3(F, PB_, out, cseq, cct, wl); } }
        else hw = ridx * NWAVES + F.wave;
        if (hw >= 0) {
#ifndef P0LATE_IN_P0
            p0_late(F, I, ws, hw, nhw, 0, 1 << 30, 0, 1 << 30);
#endif
#ifdef PROBE_SAMPLE
            for (int rep = 0; rep < 2; ++rep)
#endif
            for (int item = hw; item < 1536 + 512; item += nhw) {
                if (item < 1536) attn_sample_item(F, I, ws, item, wl);
                else { const int q = item - 1536, n = q >> 4, h = q & 15; const float* sp = I.state_shift + (size_t)n * 3328 + h * 64 + F.lane;
                    scan_out<4>(F, I, ws, (size_t)(NTOK_P + n * 4), 4, h, I.state_wkv + (size_t)q * 4096, out + OFF_WKV_S + (size_t)q * 4096, sp[0], sp[1024], sp[2048], wl); }
            }

        }
        __syncthreads();
        gu32* queue = F.ctl + CW_QUEUE;
        {
            AttnRaw ra, rb;
            if (F.tid == 0) F.MISC[16] = __hip_atomic_fetch_add(queue, 1u, RLX_AGENT);
            __syncthreads();
            int cur = (int)F.MISC[16];
            if (cur < 1536) attn_prompt_load(F, ws, cur, ra);
            if (F.tid == 0) F.MISC[17] = __hip_atomic_fetch_add(queue, 1u, RLX_AGENT);
            __syncthreads();
            int nxt = (int)F.MISC[17];
            for (int par = 0; cur < 1536; par ^= 1) {
                unsigned n2 = 0u;
                if (F.tid == 0) n2 = __hip_atomic_fetch_add(queue, 1u, RLX_AGENT);
                if (nxt < 1536) attn_prompt_load(F, ws, nxt, rb);
                attn_prompt_unit(F, ws, cur, ra, n2, 16 + par);
                ra = rb; cur = nxt; nxt = (int)F.MISC[16 + par];
            }
        }
    }
    GRID_BAR();
    {
        if (F.G * NWAVES * 8 == NTOK_P) {
            const int c = bx & 7, j = bx >> 3, bb = c >> 2, ch = 32 * (c & 3) + j;
            wkv_finish_unit(F, I, ws, PB_, (bf16*)(ws + WS_RO), (bb * 16 + F.wave) * 128 + ch);
            wkv_finish_unit(F, I, ws, PB_, (bf16*)(ws + WS_RO), (bb * 16 + F.wave + 8) * 128 + ch);
        } else
        for (int i = bx * NWAVES + F.wave; i < NUNIT; i += F.G * NWAVES) {
            const int h = 8 * ((i >> 3) & 1) + (i & 7), rest = i >> 4, ch = rest & 127, bb = rest >> 7;
            wkv_finish_unit(F, I, ws, PB_, (bf16*)(ws + WS_RO), (bb * 16 + h) * 128 + ch);
        }
        p2d_attn_merge(F, ws);
    }
    GROUP_BAR();
    {
        pg8::Gemm g{(const bf16*)(ws + WS_RO), (const bf16*)(ws + WS_WBR), NTOK_P, DM, DM}; pg8::StaticOrder S; S.init(NTOK_P, DM, GP_G(3), GP_C(3));
        pg8::EpiGate<false> E{(bf16*)(ws + WS_MIX), Zb, ZGA};
        pg8::mini_gemm<pg8::EpiGate<false>, 1024>(wave_idx, F.lds + RING_OFF, g.A, g.Bt, g.N, NTOK_P, GP_C(3), GP_G(3), E);
        pg8::gemm_phase<pg8::EpiGate<false>, pg8::StaticOrder, true, true>(wave_idx, F.lds + RING_OFF, g, S, E);
    }
    VM_WAIT(); __syncthreads();
    {
        pg8::Gemm g{(const bf16*)(ws + WS_ATTN), (const bf16*)(ws + WS_WBA), NTOK_P, DM, 256}; pg8::StaticOrder S; S.init(NTOK_P, DM, GP_G(4), GP_C(4));
        pg8::EpiGate<true> E{(bf16*)(ws + WS_MIX), Zb, ZGB};
        pg8::mini_gemm<pg8::EpiGate<true>, 256>(wave_idx, F.lds + RING_OFF, g.A, g.Bt, g.N, NTOK_P, GP_C(4), GP_G(4), E);
        pg8::gemm_phase<pg8::EpiGate<true>, pg8::StaticOrder, true, true>(wave_idx, F.lds + RING_OFF, g, S, E);
    }
    GROUP_BAR();
    {
        pg8::Gemm g{(const bf16*)(ws + WS_MIX), (const bf16*)(ws + WS_WOUT), NTOK_P, DM, DM}; pg8::StaticOrder S; S.init(NTOK_P, DM, GP_G(5), GP_C(5));
        pg8::EpiRes<0> E{(bf16*)(ws + WS_X1B), ss1, I.x_prompt, I.x_sample};
        pg8::mini_gemm<pg8::EpiRes<0>, 1024>(wave_idx, F.lds + RING_OFF, g.A, g.Bt, g.N, NTOK_P, GP_C(5), GP_G(5), E);
        pg8::gemm_phase<pg8::EpiRes<0>, pg8::StaticOrder, true, true>(wave_idx, F.lds + RING_OFF, g, S, E);
    }
    GROUP_BAR();
    {
        pg8::Gemm g{(const bf16*)(ws + WS_X1B), (const bf16*)(ws + WS_WFF1), NTOK_P, DFF, DM}; pg8::StaticOrder S; S.init(NTOK_P, DFF, GP_G(6), GP_C(6));
        pg8::EpiFF1 E{(bf16*)(ws + WS_HDN), ss1};
        pg8::mini_gemm_nu<pg8::EpiFF1, 1024, 4>(wave_idx, F.lds + RING_OFF, g.A, g.Bt, g.N, NTOK_P, GP_C(6), GP_G(6), E);
        pg8::gemm_phase<pg8::EpiFF1, pg8::StaticOrder, true, true>(wave_idx, F.lds + RING_OFF, g, S, E);
#ifdef PROBE_P5
        VM_WAIT(); __syncthreads();
        pg8::gemm_phase<pg8::EpiFF1, pg8::StaticOrder, true, true>(wave_idx, F.lds + RING_OFF, g, S, E);
#endif
    }
    GROUP_BAR();
    {
        pg8::Gemm g{(const bf16*)(ws + WS_HDN), (const bf16*)(ws + WS_WFF2), NTOK_P, DM, DFF}; pg8::StaticOrder S; S.init(NTOK_P, DM, GP_G(7), GP_C(7));
        pg8::EpiRes<1> E{(bf16*)(ws + WS_X1B), ss2, nullptr, nullptr};
        pg8::mini_gemm<pg8::EpiRes<1>, 4096>(wave_idx, F.lds + RING_OFF, g.A, g.Bt, g.N, NTOK_P, GP_C(7), GP_G(7), E);
        pg8::gemm_phase<pg8::EpiRes<1>, pg8::StaticOrder, true, true>(wave_idx, F.lds + RING_OFF, g, S, E);
    }
    GROUP_BAR();
    {
        pg8::Gemm g{(const bf16*)(ws + WS_PB), (const bf16*)(ws + WS_WPLE), NTOK_P, DM, 256}; pg8::StaticOrder S; S.init(NTOK_P, DM, GP_G(8), GP_C(8));
        pg8::EpiT2 E{(bf16*)(ws + WS_T2)};
        pg8::mini_gemm<pg8::EpiT2, 256>(wave_idx, F.lds + RING_OFF, g.A, g.Bt, g.N, NTOK_P, GP_C(8), GP_G(8), E);
        pg8::gemm_phase<pg8::EpiT2, pg8::StaticOrder, true, true>(wave_idx, F.lds + RING_OFF, g, S, E);
    }
    VM_WAIT(); __syncthreads();
    {
        pg8::Gemm g{(const bf16*)(ws + WS_X1B), (const bf16*)(ws + WS_WPG), NTOK_P, DM, DM}; pg8::StaticOrder S; S.init(NTOK_P, DM, GP_G(9), GP_C(9));
        pg8::EpiPle E{(const bf16*)(ws + WS_X1B), (bf16*)(ws + WS_X1), (const bf16*)(ws + WS_T2), ss2, ss3};
        pg8::mini_gemm<pg8::EpiPle, 1024>(wave_idx, F.lds + RING_OFF, g.A, g.Bt, g.N, NTOK_P, GP_C(9), GP_G(9), E);
        if (F.G * 64 == NTOK_P) {
            auto grp_bar = [&]() { if (F.MISC[10] != 0u) xcd_local_barrier(bar, lbar, mk_tid(wave_idx)); else xcd_barrier(bar, mk_tid(wave_idx)); };
            pg8::EpiPleF<decltype(grp_bar)> EF{E, I.norm_final, out + OFF_Y_P, grp_bar};
            pg8::gemm_phase<pg8::EpiPleF<decltype(grp_bar)>, pg8::StaticOrder, true, true>(wave_idx, F.lds + RING_OFF, g, S, EF);
            { int t_ = mk_tid(wave_idx); asm volatile("" : "+v"(t_)); F.tid = t_; F.lane = t_ & 63; F.wave = wave_idx; }
            p8_final(F, I, ws, out, true);
        } else {
            pg8::gemm_phase<pg8::EpiPle, pg8::StaticOrder, true, true>(wave_idx, F.lds + RING_OFF, g, S, E);
            GROUP_BAR();
            p8_final(F, I, ws, out);
        }
    }
#ifdef PROBE_P8
    p8_final(F, I, ws, out);
#endif
#undef GRID_BAR
}

extern "C" void kernel_launch(void* const* d_in, const int* in_sizes, int n_in, void* d_out, int out_size, void* d_ws, size_t ws_size, hipStream_t stream) {
    static int grid = 0;
    if (grid == 0) {
        if (n_in != 32 || (size_t)out_size != OUT_TOTAL || ws_size < WS_END) { fprintf(stderr, "kernel_launch: unexpected shapes: n_in %d out %d ws %zu\n", n_in, out_size, ws_size); grid = -1; return; }
        int dev = 0, cus = 0, per_cu = 0;
        if (hipGetDevice(&dev) != hipSuccess || hipDeviceGetAttribute(&cus, hipDeviceAttributeMultiprocessorCount, dev) != hipSuccess) { fprintf(stderr, "kernel_launch: device query failed\n"); grid = -1; return; }
        if (hipFuncSetAttribute((const void*)mk_fwd, hipFuncAttributeMaxDynamicSharedMemorySize, LDS_BYTES) != hipSuccess) { fprintf(stderr, "kernel_launch: hipFuncSetAttribute failed\n"); grid = -1; return; }
        if (hipOccupancyMaxActiveBlocksPerMultiprocessor(&per_cu, (const void*)mk_fwd, NWAVES * 64, LDS_BYTES) != hipSuccess || per_cu < 1) { fprintf(stderr, "kernel_launch: occupancy query says %d blocks per CU\n", per_cu); per_cu = 1; }
        (void)hipGetLastError();
        grid = cus;
    }
    if (grid < 0) return;
    if (hipMemsetAsync((char*)d_ws + WS_CTL, 0, CTL_ZERO_BYTES, stream) != hipSuccess) { fprintf(stderr, "kernel_launch: memset failed\n"); return; }
    Args a{};
    const float** ip = (const float**)&a.in;
    for (int i = 0; i < 32; ++i) ip[i] = (const float*)d_in[i];
    a.out = (float*)d_out; a.ws = (unsigned char*)d_ws;
    void* kargs[] = {&a};
    hipError_t e = hipLaunchCooperativeKernel((const void*)mk_fwd, dim3(grid), dim3(NWAVES * 64), kargs, LDS_BYTES, stream);
    if (e != hipSuccess) fprintf(stderr, "kernel_launch: cooperative launch failed: %s (grid %d)\n", hipGetErrorString(e), grid);
}
```
